# Optimizing an MI355X kernel written in HIP

```python
import jax, jax.numpy as jnp
from jax import lax
import numpy as np

D_MODEL = 1024
BATCH = 16
SEQ = 4096
DEPTH = 1

CTX_LEN = 256
GRID_W = 64
D_MIX = D_MODEL
GLA_HEADS = 4
GLA_DK = 64
GLA_DV = 128
GLA_KEY = GLA_HEADS * GLA_DK
GLA_VAL = GLA_HEADS * GLA_DV
QKV_W = 2 * GLA_KEY + GLA_VAL
GATE_RANK = 16
GATE_NORMALIZER = 16.0
GLA_CHUNK = 64
CONV_K = 3
CMLP_HEADS = 8
CMLP_WIDTH = D_MIX - GLA_VAL
CMLP_CHUNK = 128
D_IN = QKV_W + 2 * GATE_RANK + GLA_VAL + 2 * CMLP_WIDTH
D_FF = 2816
ADA_MODS = 9
EPS = 1e-6

kernel_name = "hybrid_gla_gmlp_macaron_dit_block"


def rmsnorm(x, g):
    xf = x.astype(jnp.float32)
    n = xf * lax.rsqrt(jnp.mean(xf * xf, axis=-1, keepdims=True) + EPS)
    return (n * g.astype(jnp.float32)).astype(x.dtype)


def modulate(x, shift, scale):
    return x * (1 + scale) + shift


def adaln(cond, w, b):
    return (jax.nn.silu(cond) @ w + b).reshape(cond.shape[0], ADA_MODS, 1, D_MODEL)


def swiglu(y, w_in, w_out):
    gate, up = jnp.split(y @ w_in, 2, axis=-1)
    return (jax.nn.silu(gate) * up) @ w_out


def grid_dwconv(z, w, rows, cols):
    B, T, C = z.shape
    img = z.reshape(B, rows, cols, C)
    y = lax.conv_general_dilated(img, w[:, :, None, :].astype(z.dtype), (1, 1), 'SAME',
                                 dimension_numbers=('NHWC', 'HWIO', 'NHWC'),
                                 feature_group_count=C)
    return y.reshape(B, T, C)


def log_decay(z, w, b):
    B, T = z.shape[:2]
    a = jax.nn.log_sigmoid((z @ w + b).astype(jnp.float32)) / GATE_NORMALIZER
    return a.reshape(B, T, GLA_HEADS, GLA_DK)


def gla_scan(q, k, v, g, s0):
    B, T, H, _ = q.shape
    DV = v.shape[-1]
    nc = T // GLA_CHUNK

    def to_chunks(a):
        return a.reshape(B, nc, GLA_CHUNK, H, a.shape[-1]).transpose(1, 0, 3, 2, 4)

    lower = jnp.tril(jnp.ones((GLA_CHUNK, GLA_CHUNK), dtype=bool))[:, :, None]

    def step(s, xs):
        qc, kc, vc, gc = xs
        b = jnp.cumsum(gc, axis=2)
        rel = b[:, :, :, None, :] - b[:, :, None, :, :]
        decay = jnp.exp(jnp.where(lower, rel, -jnp.inf))
        scores = jnp.einsum('bhid,bhjd,bhijd->bhij', qc, kc, decay)
        o = (jnp.einsum('bhij,bhjv->bhiv', scores, vc)
             + jnp.einsum('bhid,bhdv->bhiv', qc * jnp.exp(b), s))
        b_last = b[:, :, -1:, :]
        s = (jnp.exp(b_last)[:, :, 0, :, None] * s
             + jnp.einsum('bhjd,bhjv->bhdv', kc * jnp.exp(b_last - b), vc))
        return s, o

    s, o = lax.scan(step, s0, (to_chunks(q), to_chunks(k), to_chunks(v), to_chunks(g)))
    o = o.transpose(1, 0, 3, 2, 4).reshape(B, T, H, DV)
    return o.astype(v.dtype), s


def gla_bidirectional(ctx_in, lat_in):
    qc, kc, vc, gfc, gbc = ctx_in
    qx, kx, vx, gfx, gbx = lat_in
    B = qc.shape[0]
    flip = lambda a: a[:, ::-1]
    s0 = jnp.zeros((B, GLA_HEADS, GLA_DK, GLA_DV), jnp.float32)
    o_cf, s_f = gla_scan(qc, kc, vc, gfc, s0)
    o_cb, s_b = gla_scan(flip(qc), flip(kc), flip(vc), flip(gbc), s0)
    o_xf, _ = gla_scan(qx, kx, vx, gfx, s_f)
    o_xb, _ = gla_scan(flip(qx), flip(kx), flip(vx), flip(gbx), s_b)
    return o_cf + flip(o_cb), o_xf + flip(o_xb)


def mixer_inputs(y, w_in, conv_w, w_gf, b_gf, w_gb, b_gb, rows, cols):
    B, T = y.shape[:2]
    z = y @ w_in
    i1 = QKV_W
    i2 = i1 + GATE_RANK
    i3 = i2 + GATE_RANK
    i4 = i3 + GLA_VAL
    i5 = i4 + CMLP_WIDTH
    qkv, glr_f, glr_b, og, u, vs = jnp.split(z, [i1, i2, i3, i4, i5], axis=-1)
    qkv = jax.nn.silu(grid_dwconv(qkv, conv_w, rows, cols))
    q, k, v = jnp.split(qkv, [GLA_KEY, 2 * GLA_KEY], axis=-1)
    q = q.reshape(B, T, GLA_HEADS, GLA_DK) * (GLA_DK ** -0.5)
    k = k.reshape(B, T, GLA_HEADS, GLA_DK)
    v = v.reshape(B, T, GLA_HEADS, GLA_DV)
    gla_in = (q, k, v, log_decay(glr_f, w_gf, b_gf), log_decay(glr_b, w_gb, b_gb))
    return gla_in, og, u, vs


def chunk_mlp(u, vs, norm_g, w_s, b_s):
    B, T, C = vs.shape
    u = jax.nn.gelu(u)
    vs = rmsnorm(jax.nn.gelu(vs), norm_g)
    vh = vs.reshape(B, T // CMLP_CHUNK, CMLP_CHUNK, CMLP_HEADS, C // CMLP_HEADS)
    mixed = jnp.einsum('hij,bnjhd->bnihd', w_s, vh) + b_s.T[None, None, :, :, None]
    return u * mixed.reshape(B, T, C)


def merge_out(o_gla, og, u, vs, gla_g, cm_g, w_s, b_s, w_out):
    B, T = og.shape[:2]
    a = rmsnorm(o_gla, gla_g).reshape(B, T, GLA_VAL) * jax.nn.silu(og)
    bm = chunk_mlp(u, vs, cm_g, w_s, b_s)
    return jnp.concatenate([a, bm], axis=-1) @ w_out


def setup_inputs(seed: int = 0) -> dict:
    key = jax.random.key(seed)
    ks = jax.random.split(key, 32)
    f32 = jnp.float32
    L, D = DEPTH, D_MODEL

    def nrm(k, shape, scale):
        return jax.random.normal(k, shape, f32) * scale

    return {
        "x": nrm(ks[0], (BATCH, SEQ, D), 1.0),
        "c": nrm(ks[1], (BATCH, D), 1.0),
        "ctx": nrm(ks[2], (BATCH, CTX_LEN, D), 1.0),
        "c_ctx": nrm(ks[3], (D,), 1.0),
        "w_ada": nrm(ks[4], (L, D, ADA_MODS * D), 0.5 * D ** -0.5),
        "b_ada": nrm(ks[5], (L, ADA_MODS * D), 0.02),
        "norm1_g": 1.0 + nrm(ks[6], (L, D), 0.02),
        "ff1_in": nrm(ks[7], (L, D, 2 * D_FF), D ** -0.5),
        "ff1_out": nrm(ks[8], (L, D_FF, D), D_FF ** -0.5),
        "norm2_g": 1.0 + nrm(ks[9], (L, D), 0.02),
        "w_in": nrm(ks[10], (L, D, D_IN), D ** -0.5),
        "conv_w": nrm(ks[11], (L, CONV_K, CONV_K, QKV_W), 1.0 / CONV_K),
        "w_gate_f": nrm(ks[12], (L, GATE_RANK, GLA_KEY), GATE_RANK ** -0.5),
        "b_gate_f": nrm(ks[13], (L, GLA_KEY), 0.1),
        "w_gate_b": nrm(ks[14], (L, GATE_RANK, GLA_KEY), GATE_RANK ** -0.5),
        "b_gate_b": nrm(ks[15], (L, GLA_KEY), 0.1),
        "gla_norm_g": 1.0 + nrm(ks[16], (L, GLA_DV), 0.02),
        "cmlp_norm_g": 1.0 + nrm(ks[17], (L, CMLP_WIDTH), 0.02),
        "w_s": nrm(ks[18], (L, CMLP_HEADS, CMLP_CHUNK, CMLP_CHUNK), CMLP_CHUNK ** -0.5),
        "b_s": 1.0 + nrm(ks[19], (L, CMLP_HEADS, CMLP_CHUNK), 0.02),
        "w_out": nrm(ks[20], (L, D_MIX, D), D_MIX ** -0.5),
        "norm3_g": 1.0 + nrm(ks[21], (L, D), 0.02),
        "ff2_in": nrm(ks[22], (L, D, 2 * D_FF), D ** -0.5),
        "ff2_out": nrm(ks[23], (L, D_FF, D), D_FF ** -0.5),
        "final_g": 1.0 + nrm(ks[24], (D,), 0.02),
    }


def reference(x, c, ctx, c_ctx, w_ada, b_ada, norm1_g, ff1_in, ff1_out, norm2_g, w_in,
              conv_w, w_gate_f, b_gate_f, w_gate_b, b_gate_b, gla_norm_g, cmlp_norm_g,
              w_s, b_s, w_out, norm3_g, ff2_in, ff2_out, final_g):
    rows = x.shape[1] // GRID_W
    h = ctx
    for l in range(DEPTH):
        last = l == DEPTH - 1
        m_x = adaln(c, w_ada[l], b_ada[l])
        m_c = adaln(c_ctx[None], w_ada[l], b_ada[l])

        x = x + 0.5 * m_x[:, 2] * swiglu(
            modulate(rmsnorm(x, norm1_g[l]), m_x[:, 0], m_x[:, 1]), ff1_in[l], ff1_out[l])
        h = h + 0.5 * m_c[:, 2] * swiglu(
            modulate(rmsnorm(h, norm1_g[l]), m_c[:, 0], m_c[:, 1]), ff1_in[l], ff1_out[l])

        y_x = modulate(rmsnorm(x, norm2_g[l]), m_x[:, 3], m_x[:, 4])
        y_c = modulate(rmsnorm(h, norm2_g[l]), m_c[:, 3], m_c[:, 4])
        gla_x, og_x, u_x, vs_x = mixer_inputs(y_x, w_in[l], conv_w[l], w_gate_f[l], b_gate_f[l],
                                              w_gate_b[l], b_gate_b[l], rows, GRID_W)
        gla_c, og_c, u_c, vs_c = mixer_inputs(y_c, w_in[l], conv_w[l], w_gate_f[l], b_gate_f[l],
                                              w_gate_b[l], b_gate_b[l], 1, CTX_LEN)
        o_c, o_x = gla_bidirectional(gla_c, gla_x)
        mix_x = merge_out(o_x, og_x, u_x, vs_x, gla_norm_g[l], cmlp_norm_g[l],
                          w_s[l], b_s[l], w_out[l])
        x = x + m_x[:, 5] * mix_x

        x = x + 0.5 * m_x[:, 8] * swiglu(
            modulate(rmsnorm(x, norm3_g[l]), m_x[:, 6], m_x[:, 7]), ff2_in[l], ff2_out[l])

        if not last:
            mix_c = merge_out(o_c, og_c, u_c, vs_c, gla_norm_g[l], cmlp_norm_g[l],
                              w_s[l], b_s[l], w_out[l])
            h = h + m_c[:, 5] * mix_c
            h = h + 0.5 * m_c[:, 8] * swiglu(
                modulate(rmsnorm(h, norm3_g[l]), m_c[:, 6], m_c[:, 7]), ff2_in[l], ff2_out[l])
    return rmsnorm(x, final_g)
```

```cpp
#include <hip/hip_runtime.h>
#include <hip/hip_cooperative_groups.h>
#include <cstdio>
#include <cstdint>
namespace cg = cooperative_groups;
#ifndef MK_ONE_LAUNCH
#define MK_ONE_LAUNCH 1
#endif
#ifndef MK_DUP
#define MK_DUP 0
#endif
#ifndef MK_EXTRA_SYNC
#define MK_EXTRA_SYNC 0
#endif
namespace pg8 {
#define PG8_LAS __attribute__((address_space(3)))
typedef unsigned short bf16_t;
typedef short bf16x8 __attribute__((ext_vector_type(8)));
typedef float f32x4 __attribute__((ext_vector_type(4)));
typedef unsigned u32x4 __attribute__((ext_vector_type(4)));
constexpr int BM = 256, BK = 64, HALF = 128, HTB = HALF * BK * 2  , STAGE_BYTES = 8 * HTB, NXCD = 8, WGM = 8;

__host__ __device__ __forceinline__ int lds_byte(int r, int c) { const int st = (r >> 4) * 2 + (c >> 5), rr = r & 15, cc = c & 31, ob = rr * 64 + cc * 2; return st * 1024 + (ob ^ (((ob >> 9) & 1) << 5)); }
__host__ __device__ __forceinline__ void stage_rc(int b, int& R, int& C) { const int st = b / 1024, sb = b % 1024, swz = sb ^ (((sb >> 9) & 1) << 5); R = (st >> 1) * 16 + swz / 64; C = (st & 1) * 32 + (swz % 64) / 2; }
__host__ __device__ __forceinline__ int perm32(int rho) { const int n = rho >> 4, i = rho & 15; return 8 * (i >> 2) + 4 * n + (i & 3); }

struct Unit { int pm, pn; };
struct Gemm { const bf16_t* A; const bf16_t* Bt; int M, N, K; };

struct StaticOrder {
    int nM, nN, nwg, G, c;
    __host__ __device__ void init(int M, int N, int G_, int c_) { nM = M / BM; nN = N / BM; nwg = nM * nN; G = G_; c = c_; }
    __host__ __device__ bool next(int i, Unit& u) const {
        const long L = (long)i * G + c; if (L >= nwg) return false;
        int wgid = (int)L; { const int q = nwg / NXCD, r = nwg % NXCD, xcd = wgid % NXCD, off = wgid / NXCD; wgid = (xcd < r ? xcd * (q + 1) : r * (q + 1) + (xcd - r) * q) + off; }
        const int nig = WGM * nN, gid = wgid / nig, fm = gid * WGM, gsz = (nM - fm) < WGM ? (nM - fm) : WGM;
        u.pm = fm + ((wgid % nig) % gsz); u.pn = (wgid % nig) / gsz; return true;
    }
    __device__ __forceinline__ void a_ready(const Unit&) const {}
    __device__ __forceinline__ void done(const Unit&) const {}
};

typedef float f32x2_t __attribute__((ext_vector_type(2))); typedef __bf16 bf16x2_t __attribute__((ext_vector_type(2)));
__device__ __forceinline__ unsigned cvt_pk_bf16(float lo, float hi) { f32x2_t v = {lo, hi}; bf16x2_t b = __builtin_convertvector(v, bf16x2_t); return __builtin_bit_cast(unsigned, b); }
template <class Epi, class Sched, bool ALIGN_EPI = false, bool SP2 = false>
__device__ __forceinline__ void gemm_phase(PG8_LAS unsigned char* lds, const Gemm g, const Sched& S, const Epi& E) {
    const int tid = threadIdx.x, wid = __builtin_amdgcn_readfirstlane(tid >> 6), lane = tid & 63, wr = wid >> 2, wc = wid & 3, fr = lane & 15, fq = lane >> 4;
    const int K = g.K, nt = K / BK;
    unsigned voffA[2], voffB[2];
#pragma unroll
    for (int i = 0; i < 2; ++i) { int R, C; stage_rc(tid * 16 + i * 8192, R, C); const int Rb = Epi::PERM ? ((R & ~31) + perm32(R & 31)) : R;
        voffA[i] = (unsigned)(R * K + C) * 2u; voffB[i] = (unsigned)(Rb * K + C) * 2u; }
    const size_t kstep = (size_t)(BK * 2);
    const size_t hstep = (size_t)HALF * K * 2;
    const size_t tstep = 2 * hstep;
    const unsigned ldsw = (unsigned)wid * 1024u;
    const int aoff = lds_byte(wr * 64 + fr, fq * 8), boff = lds_byte(wc * 32 + fr, fq * 8);
#define PG8_SA(b, h) (((b) * 2 + (h)) * HTB)
#define PG8_SB(b, h) ((4 + (b) * 2 + (h)) * HTB)
#define PG8_STAGE(bufoff, gbase, voff) do { _Pragma("unroll") for (int _i = 0; _i < 2; ++_i) \
        __builtin_amdgcn_global_load_lds((const unsigned*)((const char*)(gbase) + (voff)[_i]), (PG8_LAS unsigned*)(lds + (bufoff) + ldsw + _i * 8192), 16, 0, 0); } while (0)
#define PG8_LDA(dst, b, h) do { _Pragma("unroll") for (int m = 0; m < 4; ++m) _Pragma("unroll") for (int k = 0; k < 2; ++k) dst[m][k] = *(const PG8_LAS bf16x8*)(lds + PG8_SA(b, h) + aoff + m * 2048 + k * 1024); } while (0)
#define PG8_LDB(dst, b, h) do { _Pragma("unroll") for (int n = 0; n < 2; ++n) _Pragma("unroll") for (int k = 0; k < 2; ++k) dst[n][k] = *(const PG8_LAS bf16x8*)(lds + PG8_SB(b, h) + boff + n * 2048 + k * 1024); } while (0)
#define PG8_MMA(ai, bj, At, Bt) do { __builtin_amdgcn_s_setprio(1); _Pragma("unroll") for (int m = 0; m < 4; ++m) _Pragma("unroll") for (int n = 0; n < 2; ++n) _Pragma("unroll") for (int k = 0; k < 2; ++k) \
        acc[ai][bj][m][n] = __builtin_amdgcn_mfma_f32_16x16x32_bf16(Bt[n][k], At[m][k], acc[ai][bj][m][n], 0, 0, 0); __builtin_amdgcn_s_setprio(0); } while (0)
#define PG8_WAIT_V(n) asm volatile("s_waitcnt vmcnt(" #n ")" ::: "memory")
#define PG8_WAIT_L(n) asm volatile("s_waitcnt lgkmcnt(" #n ")" ::: "memory")
#define PG8_BAR __builtin_amdgcn_s_barrier()
#define PG8_SCHED __builtin_amdgcn_sched_barrier(0)
    Unit cur, nxt; int ui = 0;
    if (!S.next(0, cur)) return;
    f32x4 acc[2][2][4][2];
#pragma unroll
    for (int a = 0; a < 2; ++a)
#pragma unroll
        for (int b = 0; b < 2; ++b)
#pragma unroll
            for (int m = 0; m < 4; ++m)
#pragma unroll
                for (int n = 0; n < 2; ++n) acc[a][b][m][n] = (f32x4){0.f, 0.f, 0.f, 0.f};
    bf16x8 At[4][2], B0[2][2], B1[2][2];
    const char* cA = (const char*)g.A + (size_t)cur.pm * tstep; const char* cB = (const char*)g.Bt + (size_t)cur.pn * tstep;
    S.a_ready(cur);
    if constexpr (SP2) {
        PG8_STAGE(PG8_SB(0, 0), cB, voffB); PG8_STAGE(PG8_SB(0, 1), cB + hstep, voffB); PG8_STAGE(PG8_SA(0, 0), cA, voffA); PG8_STAGE(PG8_SA(0, 1), cA + hstep, voffA);
        if (wr == 1) PG8_BAR;
        PG8_WAIT_V(2); PG8_BAR;
        PG8_STAGE(PG8_SB(1, 0), cB + kstep, voffB); PG8_STAGE(PG8_SA(1, 0), cA + kstep, voffA); PG8_STAGE(PG8_SB(1, 1), cB + hstep + kstep, voffB);
        PG8_WAIT_V(6); PG8_BAR;
    } else {
        PG8_STAGE(PG8_SB(0, 0), cB, voffB); PG8_STAGE(PG8_SA(0, 0), cA, voffA); PG8_STAGE(PG8_SB(0, 1), cB + hstep, voffB); PG8_STAGE(PG8_SA(0, 1), cA + hstep, voffA);
        if (wr == 1) PG8_BAR;
        PG8_WAIT_V(4); PG8_BAR;
        PG8_STAGE(PG8_SB(1, 0), cB + kstep, voffB); PG8_STAGE(PG8_SA(1, 0), cA + kstep, voffA); PG8_STAGE(PG8_SB(1, 1), cB + hstep + kstep, voffB);
        PG8_WAIT_V(6); PG8_BAR;
    }
    for (;;) {
        const bool has_next = S.next(ui + 1, nxt);
        const char* nA = has_next ? (const char*)g.A + (size_t)nxt.pm * tstep : cA; const char* nB = has_next ? (const char*)g.Bt + (size_t)nxt.pn * tstep : cB;
        asm volatile(".p2align 8" ::: "memory");
        for (int t = 0; t < nt; t += 2) {
            const bool last = (t == nt - 2);
            const char* a1 = cA + (size_t)(t + 1) * kstep;
            const char* a2 = last ? nA : cA + (size_t)(t + 2) * kstep; const char* b2 = last ? nB : cB + (size_t)(t + 2) * kstep;
            const char* a3 = a2 + kstep; const char* b3 = b2 + kstep;
            if (last && has_next) S.a_ready(nxt);
            if constexpr (SP2) {
            PG8_LDB(B0, 0, 0); PG8_LDB(B1, 0, 1); PG8_SCHED; PG8_LDA(At, 0, 0); PG8_STAGE(PG8_SA(1, 1), a1 + hstep, voffA);
            PG8_WAIT_V(8); PG8_WAIT_L(0); PG8_BAR; PG8_MMA(0, 0, At, B0); PG8_MMA(0, 1, At, B1); PG8_BAR; PG8_SCHED;
            PG8_LDA(At, 0, 1); PG8_STAGE(PG8_SB(0, 0), b2, voffB); PG8_STAGE(PG8_SB(0, 1), b2 + hstep, voffB); PG8_STAGE(PG8_SA(0, 0), a2, voffA);
            PG8_WAIT_V(8); PG8_WAIT_L(0); PG8_BAR; PG8_MMA(1, 0, At, B0); PG8_MMA(1, 1, At, B1); PG8_BAR; PG8_SCHED;
            PG8_LDB(B0, 1, 0); PG8_LDB(B1, 1, 1); PG8_SCHED; PG8_LDA(At, 1, 0); PG8_STAGE(PG8_SA(0, 1), a2 + hstep, voffA);
            PG8_WAIT_V(8); PG8_WAIT_L(0); PG8_BAR; PG8_MMA(0, 0, At, B0); PG8_MMA(0, 1, At, B1); PG8_BAR; PG8_SCHED;
            PG8_LDA(At, 1, 1); PG8_STAGE(PG8_SB(1, 0), b3, voffB); PG8_STAGE(PG8_SB(1, 1), b3 + hstep, voffB); PG8_STAGE(PG8_SA(1, 0), a3, voffA);
            PG8_WAIT_V(8); PG8_WAIT_L(0); PG8_BAR; PG8_MMA(1, 0, At, B0); PG8_MMA(1, 1, At, B1); PG8_BAR; PG8_SCHED;
            } else {
            PG8_LDB(B0, 0, 0); PG8_SCHED; PG8_LDA(At, 0, 0); PG8_STAGE(PG8_SA(1, 1), a1 + hstep, voffA);
            PG8_WAIT_L(8); PG8_BAR; PG8_WAIT_L(0); PG8_MMA(0, 0, At, B0); PG8_BAR; PG8_SCHED;
            PG8_LDB(B1, 0, 1); PG8_STAGE(PG8_SB(0, 0), b2, voffB);
            PG8_BAR; PG8_WAIT_L(0); PG8_MMA(0, 1, At, B1); PG8_BAR;
            PG8_LDA(At, 0, 1); PG8_STAGE(PG8_SA(0, 0), a2, voffA);
            PG8_BAR; PG8_WAIT_L(0); PG8_MMA(1, 0, At, B0); PG8_BAR; PG8_SCHED;
            PG8_STAGE(PG8_SB(0, 1), b2 + hstep, voffB);
            PG8_WAIT_V(6); PG8_BAR; PG8_MMA(1, 1, At, B1); PG8_BAR;
            PG8_LDB(B0, 1, 0); PG8_SCHED; PG8_LDA(At, 1, 0); PG8_STAGE(PG8_SA(0, 1), a2 + hstep, voffA);
            PG8_WAIT_L(8); PG8_BAR; PG8_WAIT_L(0); PG8_MMA(0, 0, At, B0); PG8_BAR; PG8_SCHED;
            PG8_LDB(B1, 1, 1); PG8_STAGE(PG8_SB(1, 0), b3, voffB);
            PG8_BAR; PG8_WAIT_L(0); PG8_MMA(0, 1, At, B1); PG8_BAR;
            PG8_LDA(At, 1, 1); PG8_STAGE(PG8_SA(1, 0), a3, voffA);
            PG8_BAR; PG8_WAIT_L(0); PG8_MMA(1, 0, At, B0); PG8_BAR; PG8_SCHED;
            PG8_STAGE(PG8_SB(1, 1), b3 + hstep, voffB);
            PG8_WAIT_V(6); PG8_BAR; PG8_MMA(1, 1, At, B1); PG8_BAR;
            }
        }
        if constexpr (ALIGN_EPI) { if (wr == 0) PG8_BAR; }
        if constexpr (!Epi::AFTER_DRAIN) { E(acc, cur, wr, wc, fr, fq); S.done(cur); }
        if (!has_next) break;
#pragma unroll
        for (int a = 0; a < 2; ++a)
#pragma unroll
            for (int b = 0; b < 2; ++b)
#pragma unroll
                for (int m = 0; m < 4; ++m)
#pragma unroll
                    for (int n = 0; n < 2; ++n) acc[a][b][m][n] = (f32x4){0.f, 0.f, 0.f, 0.f};
        cur = nxt; cA = nA; cB = nB; ++ui;
        if constexpr (ALIGN_EPI) { if (wr == 1) PG8_BAR; }
    }
    PG8_WAIT_V(0);
    if constexpr (!ALIGN_EPI) { if (wr == 0) PG8_BAR; }
    PG8_BAR;
    if constexpr (Epi::AFTER_DRAIN) { E.fused(acc, cur, wr, wc, fr, fq, lds, wid, lane); S.done(cur); }
#undef PG8_SA
#undef PG8_SB
#undef PG8_STAGE
#undef PG8_LDA
#undef PG8_LDB
#undef PG8_MMA
#undef PG8_WAIT_V
#undef PG8_WAIT_L
#undef PG8_BAR
#undef PG8_SCHED
}
}
using pg8::bf16_t; using pg8::bf16x8; using pg8::f32x4; using pg8::u32x4; using pg8::Unit; using pg8::cvt_pk_bf16;
typedef unsigned u32x2 __attribute__((ext_vector_type(2)));
#define DEV __device__ __forceinline__
constexpr int D = 1024, NB = 16, SEQ = 4096, MLAT = NB * SEQ, CTXL = 256, MCTX = NB * CTXL, MALL = MLAT + MCTX;
constexpr int DFF = 2816, NFF2 = 2 * DFF, ZW = 2816, NMOD = 9 * D;
constexpr int NU_LAT = NB * 64 * 4, NU_CTX = NB * 4 * 4, NU_ALL = NU_LAT + NU_CTX;
constexpr float EPS = 1e-6f;
constexpr int ZC_OG = 1024, ZC_U = 1536, ZC_VS = 2048, ZC_GLR = 2560;
constexpr size_t MiB = 1u << 20;
constexpr size_t WS_CTL = 0, WS_MOD = 64 * 1024;
static_assert(WS_MOD + 17 * 9216 * 4 <= (1u << 20), "MOD inside the zeroed region");
constexpr size_t WS_W1A = 2 * MiB, WS_W1B = 13 * MiB, WS_WIN = 19 * MiB, WS_WOUT = 25 * MiB, WS_W2A = 27 * MiB, WS_W2B = 38 * MiB, WS_WS = 44 * MiB;
constexpr size_t WS_DEC = 45 * MiB, WS_X1C = 48 * MiB, WS_XN = 64 * MiB, WS_ZH = 200 * MiB, WS_QT = 574 * MiB, WS_OI = 638 * MiB, WS_KV = 702 * MiB, WS_SB = 838 * MiB, WS_RSP = 966 * MiB, WS_RS2 = 969 * MiB, WS_RS3 = 974 * MiB, WS_SHW1 = 978 * MiB, WS_SHW2 = 979 * MiB, WS_END = 980 * MiB;
static_assert(WS_MOD + 17 * NMOD * 4 <= 2 * MiB && WS_RSP + (size_t)MALL * 8 * 4 <= WS_RS2 && WS_RS2 + (size_t)MALL * 16 * 4 <= WS_RS3 && WS_RS3 + (size_t)MLAT * 16 * 4 <= WS_SHW1 && WS_SHW1 + 17 * ZW * 4 <= WS_SHW2 && WS_SHW2 + 17 * NFF2 * 4 <= WS_END, "mod / row-stat / shift regions");
static_assert(WS_W1A + (size_t)NFF2 * D * 2 <= WS_W1B && WS_W1B + (size_t)D * DFF * 2 <= WS_WIN && WS_WIN + (size_t)ZW * D * 2 <= WS_WOUT && WS_WOUT + (size_t)D * D * 2 <= WS_W2A, "w map");
static_assert(WS_W2A + (size_t)NFF2 * D * 2 <= WS_W2B && WS_W2B + (size_t)D * DFF * 2 <= WS_WS && WS_WS + 8 * 128 * 128 * 2 <= WS_DEC && WS_DEC + (size_t)NU_ALL * 128 * 4 <= WS_X1C, "w map 2");
static_assert(WS_X1C + (size_t)MCTX * D * 4 <= WS_XN && WS_XN + (size_t)MALL * D * 2 <= WS_ZH && WS_ZH + (size_t)MALL * ZW * 2 <= WS_QT && WS_QT + (size_t)MLAT * 512 * 2 <= WS_OI, "act map");
static_assert(WS_OI + (size_t)MLAT * 512 * 2 <= WS_KV && WS_KV + (size_t)NU_ALL * 2 * 128 * 64 * 2 <= WS_SB && WS_SB + (size_t)NU_LAT * 2 * 128 * 64 * 2 <= WS_RSP, "act map 2");
static_assert(WS_KV + (size_t)MLAT * D * 2 <= WS_SB, "MIX overlays KV");
constexpr int LDS_BYTES = 147456;

DEV float bf_lo(unsigned w) { return __uint_as_float(w << 16); }
DEV float bf_hi(unsigned w) { return __uint_as_float(w & 0xffff0000u); }
DEV float silu_f(float x) { return x * __builtin_amdgcn_rcpf(1.f + __expf(-x)); }
DEV float gelu_f(float x) { const float t = 1.5957691216f * (x + 0.044715f * x * x * x); return x * __builtin_amdgcn_rcpf(1.f + __expf(-t)); }
DEV float wave_sum(float v) {
#pragma unroll
    for (int o = 1; o < 64; o <<= 1) v += __shfl_xor(v, o);
    return v;
}
#define LDS_WAIT() asm volatile("s_waitcnt lgkmcnt(0)" ::: "memory")
#define LBAR() do { asm volatile("s_waitcnt lgkmcnt(0)" ::: "memory"); __builtin_amdgcn_s_barrier(); asm volatile("" ::: "memory"); } while (0)
DEV void unpack8(const u32x4 w, float (&f)[8]) { f[0] = bf_lo(w.x); f[1] = bf_hi(w.x); f[2] = bf_lo(w.y); f[3] = bf_hi(w.y); f[4] = bf_lo(w.z); f[5] = bf_hi(w.z); f[6] = bf_lo(w.w); f[7] = bf_hi(w.w); }
DEV u32x4 pack8(const float (&f)[8]) { u32x4 w; w.x = cvt_pk_bf16(f[0], f[1]); w.y = cvt_pk_bf16(f[2], f[3]); w.z = cvt_pk_bf16(f[4], f[5]); w.w = cvt_pk_bf16(f[6], f[7]); return w; }
DEV f32x4 mfma16(bf16x8 a, bf16x8 b, f32x4 c) { return __builtin_amdgcn_mfma_f32_16x16x32_bf16(a, b, c, 0, 0, 0); }

DEV int prow(int n, int ln) { return 8 * (ln >> 2) + 4 * n + (ln & 3); }
DEV u32x4 pack8v(const f32x4 a, const f32x4 b) { u32x4 w; w.x = cvt_pk_bf16(a[0], a[1]); w.y = cvt_pk_bf16(a[2], a[3]); w.z = cvt_pk_bf16(b[0], b[1]); w.w = cvt_pk_bf16(b[2], b[3]); return w; }
DEV float row_rstd(const float* rs, int row, int fq) {
    const f32x4 p = *(const f32x4*)(rs + (size_t)row * 16 + fq * 4); float s = (p.x + p.y) + (p.z + p.w);
    s += __shfl_xor(s, 16); s += __shfl_xor(s, 32); return rsqrtf(s * (1.f / D) + EPS);
}
template <bool FUSED> struct EpiSwiGLU {
    static constexpr bool PERM = true, AFTER_DRAIN = false;
    bf16_t* H; const float* rs; const float* shw;
    DEV void operator()(const f32x4 (&acc)[2][2][4][2], const Unit& u, int wr, int wc, int fr, int fq) const {
        asm volatile("" : "+v"(fr), "+v"(fq));
        const int row0 = u.pm * 256 + wr * 64 + fr, col0 = u.pn * 128 + wc * 32 + 8 * fq;
        f32x4 sg[2], su[2];
        if (FUSED) { const int b = u.pm >> 4; const float* sp = shw + (size_t)b * NFF2 + u.pn * 256 + wc * 32 + 8 * fq;
            sg[0] = *(const f32x4*)sp; sg[1] = *(const f32x4*)(sp + 4); su[0] = *(const f32x4*)(sp + 128); su[1] = *(const f32x4*)(sp + 132); }
#pragma unroll
        for (int ai = 0; ai < 2; ++ai)
#pragma unroll
            for (int m = 0; m < 4; ++m) {
                const int row = row0 + ai * 128 + m * 16;
                float rstd = 1.f; if (FUSED) rstd = row_rstd(rs, row, fq);
                float h[8];
#pragma unroll
                for (int n = 0; n < 2; ++n)
#pragma unroll
                    for (int j = 0; j < 4; ++j) { float g = acc[ai][0][m][n][j], up = acc[ai][1][m][n][j]; if (FUSED) { g = g * rstd + sg[n][j]; up = up * rstd + su[n][j]; } h[4 * n + j] = silu_f(g) * up; }
                *(u32x4*)(H + (size_t)row * DFF + col0) = pack8(h);
            }
    }
};
template <int GATE_I, bool HALF, bool WITH_XN, int SCALE_I> struct EpiResid {
    static constexpr bool PERM = true, AFTER_DRAIN = false;
    const float* res_lat; const float* res_ctx; float* out_lat; float* out_ctx; const float* mod;
    bf16_t* xn; const float* g; float* rs;
    static constexpr int gate_i = GATE_I, scale_i = SCALE_I; static constexpr float coef = HALF ? 0.5f : 1.0f; static constexpr bool has_xn = WITH_XN;
    DEV void operator()(const f32x4 (&acc)[2][2][4][2], const Unit& u, int wr, int wc, int fr, int fq) const {
        asm volatile("" : "+v"(fr), "+v"(fq));
        const bool lat = u.pm < MLAT / 256; const int b = lat ? (u.pm >> 4) : 16;
        const float* res = lat ? res_lat : res_ctx; float* out = lat ? out_lat : out_ctx;
        const int grow0 = u.pm * 256 + wr * 64 + fr, row0 = (lat ? grow0 : grow0 - MLAT), col0 = u.pn * 256 + wc * 32 + 8 * fq;
        float ss[8];
#pragma unroll
        for (int i = 0; i < 8; ++i) ss[i] = 0.f;
#pragma unroll
        for (int bj = 0; bj < 2; ++bj) {
            f32x4 gv[2], gs[2];
#pragma unroll
            for (int n = 0; n < 2; ++n) { gv[n] = *(const f32x4*)(mod + (size_t)b * NMOD + gate_i * D + col0 + bj * 128 + 4 * n) * coef;
                if (has_xn) gs[n] = *(const f32x4*)(g + col0 + bj * 128 + 4 * n) * (*(const f32x4*)(mod + (size_t)b * NMOD + scale_i * D + col0 + bj * 128 + 4 * n) + 1.f); }
#pragma unroll
            for (int ai = 0; ai < 2; ++ai)
#pragma unroll
                for (int m = 0; m < 4; ++m) {
                    const size_t p = (size_t)(row0 + ai * 128 + m * 16) * D + col0 + bj * 128;
                    const f32x4 r0 = *(const f32x4*)(res + p), r1 = *(const f32x4*)(res + p + 4);
                    const f32x4 o0 = r0 + gv[0] * acc[ai][bj][m][0], o1 = r1 + gv[1] * acc[ai][bj][m][1];
                    *(f32x4*)(out + p) = o0; *(f32x4*)(out + p + 4) = o1;
                    if (has_xn) { ss[ai * 4 + m] += (o0[0] * o0[0] + o0[1] * o0[1]) + (o0[2] * o0[2] + o0[3] * o0[3]) + (o1[0] * o1[0] + o1[1] * o1[1]) + (o1[2] * o1[2] + o1[3] * o1[3]);
                        *(u32x4*)(xn + (size_t)(grow0 + ai * 128 + m * 16) * D + col0 + bj * 128) = pack8v(o0 * gs[0], o1 * gs[1]); }
                }
        }
        if (has_xn) {
#pragma unroll
            for (int i = 0; i < 8; ++i) { float v = ss[i]; v += __shfl_xor(v, 16); v += __shfl_xor(v, 32); if (fq == 0) rs[(size_t)(grow0 + (i >> 2) * 128 + (i & 3) * 16) * 16 + u.pn * 4 + wc] = v; }
        }
    }
};
struct EpiZ {
    static constexpr bool PERM = true, AFTER_DRAIN = false;
    bf16_t* Z; float* rowss; const float* rs; const float* shw;
    DEV void operator()(const f32x4 (&acc)[2][2][4][2], const Unit& u, int wr, int wc, int fr, int fq) const {
        asm volatile("" : "+v"(fr), "+v"(fq));
        const int pn = u.pn; const int act = (pn < 4 || pn >= 10) ? 0 : (pn < 6 ? 1 : 2); const bool stat = (pn == 8 || pn == 9);
        const int row0 = u.pm * 256 + wr * 64 + fr, col0 = pn * 256 + wc * 32 + 8 * fq; const int b = u.pm < MLAT / 256 ? (u.pm >> 4) : 16;
        f32x4 sw[2][2];
#pragma unroll
        for (int bj = 0; bj < 2; ++bj)
#pragma unroll
            for (int n = 0; n < 2; ++n) sw[bj][n] = *(const f32x4*)(shw + (size_t)b * ZW + col0 + bj * 128 + 4 * n);
#pragma unroll
        for (int ai = 0; ai < 2; ++ai)
#pragma unroll
            for (int m = 0; m < 4; ++m) {
                const int row = row0 + ai * 128 + m * 16; float ss = 0.f; const float rstd = row_rstd(rs, row, fq);
#pragma unroll
                for (int bj = 0; bj < 2; ++bj) {
                    float v[8];
#pragma unroll
                    for (int n = 0; n < 2; ++n)
#pragma unroll
                        for (int j = 0; j < 4; ++j) { float x = acc[ai][bj][m][n][j] * rstd + sw[bj][n][j]; if (act == 1) x = silu_f(x); else if (act == 2) x = gelu_f(x); v[4 * n + j] = x; ss += x * x; }
                    *(u32x4*)(Z + (size_t)row * ZW + col0 + bj * 128) = pack8(v);
                }
                if (stat) { ss += __shfl_xor(ss, 16); ss += __shfl_xor(ss, 32); if (fq == 0) rowss[(size_t)row * 8 + (pn - 8) * 4 + wc] = ss; }
            }
    }
};

struct Args { const float* in[25]; float* out; unsigned char* ws; int ph_lo, ph_hi; };
enum { I_X = 0, I_C, I_CTX, I_CCTX, I_WADA, I_BADA, I_N1G, I_FF1IN, I_FF1OUT, I_N2G, I_WIN, I_CONVW, I_WGF, I_BGF, I_WGB, I_BGB, I_GLAG, I_CMG, I_WS, I_BS, I_WOUT, I_N3G, I_FF2IN, I_FF2OUT, I_FING };

DEV void transpose_item(const float* W, int K, int N, bf16_t* WT, int n0, int drow0, int k0, float* scr, int lane) {
    float tv[32];
#pragma unroll
    for (int i = 0; i < 32; ++i) tv[i] = W[(size_t)(k0 + 2 * i + (lane >> 5)) * N + n0 + (lane & 31)];
#pragma unroll
    for (int i = 0; i < 32; ++i) scr[(2 * i + (lane >> 5)) * 33 + (lane & 31)] = tv[i];
    LDS_WAIT();
    const int c = lane & 7;
#pragma unroll
    for (int j = 0; j < 4; ++j) { const int n = (lane >> 3) + 8 * j; const float* s = scr + (8 * c) * 33 + n;
        u32x4 o; o.x = cvt_pk_bf16(s[0 * 33], s[1 * 33]); o.y = cvt_pk_bf16(s[2 * 33], s[3 * 33]); o.z = cvt_pk_bf16(s[4 * 33], s[5 * 33]); o.w = cvt_pk_bf16(s[6 * 33], s[7 * 33]);
        *(u32x4*)(WT + (size_t)(drow0 + n) * K + k0 + 8 * c) = o; }
    LDS_WAIT();
}
DEV int ffin_rowmap(int n0) { const int up = n0 >= DFF, j = up ? n0 - DFF : n0; return (j >> 7) * 256 + up * 128 + (j & 127); }
DEV int win_rowmap(int n0) { return n0 < 1024 ? n0 : (n0 < 1056 ? n0 - 1024 + ZC_GLR : n0 - 1056 + ZC_OG); }
DEV void p0_prep(const Args& a, unsigned char* lds, int gw, int NGW, int wave, int lane) {
    unsigned char* ws = a.ws;
    float* scr = (float*)(lds + wave * 16384);
    constexpr int I_A = (D / 64) * (NFF2 / 32), I_B = (DFF / 64) * (D / 32), I_IN = (D / 64) * (2592 / 32), I_O = (D / 64) * (D / 32), I_ADA = (NMOD / 16) * 8;
    constexpr int NIT = 2 * I_A + 2 * I_B + I_IN + I_O + I_ADA;
    for (int it = gw; it < NIT; it += NGW) {
        int r = it;
        if (r < I_ADA) {
            const int cgi = r % (NMOD / 16), kc = r / (NMOD / 16), n0 = cgi * 16, k0 = kc * 128, col = lane & 15, kq = lane >> 4;
            for (int idx = lane; idx < 17 * 128; idx += 64) { const int b = idx >> 7, k = idx & 127; const float cv = (b < 16) ? a.in[I_C][b * D + k0 + k] : a.in[I_CCTX][k0 + k]; scr[idx] = silu_f(cv); }
            const float* wp = a.in[I_WADA] + (size_t)(k0 + kq * 32) * NMOD + n0 + col;
            float acc[17];
#pragma unroll
            for (int b = 0; b < 17; ++b) acc[b] = 0.f;
            LDS_WAIT();
#pragma unroll 1
            for (int kb = 0; kb < 2; ++kb) {
                float wv[16];
#pragma unroll
                for (int kk = 0; kk < 16; ++kk) wv[kk] = wp[(size_t)(kb * 16 + kk) * NMOD];
#pragma unroll
                for (int kk = 0; kk < 16; ++kk) {
#pragma unroll
                    for (int b = 0; b < 17; ++b) acc[b] += scr[b * 128 + kq * 32 + kb * 16 + kk] * wv[kk]; }
            }
            LDS_WAIT();
            float* mod = (float*)(ws + WS_MOD);
            const float bias = (kc == 0) ? a.in[I_BADA][n0 + col] : 0.f;
#pragma unroll
            for (int b = 0; b < 17; ++b) { float v = acc[b]; v += __shfl_xor(v, 16); v += __shfl_xor(v, 32); if (kq == 0) atomicAdd(mod + b * NMOD + n0 + col, v + bias); }
            continue;
        }
        r -= I_ADA;
        if (r < I_A) { const int nb = r % (NFF2 / 32), kb = r / (NFF2 / 32); transpose_item(a.in[I_FF1IN], D, NFF2, (bf16_t*)(ws + WS_W1A), nb * 32, ffin_rowmap(nb * 32), kb * 64, scr, lane); continue; } r -= I_A;
        if (r < I_A) { const int nb = r % (NFF2 / 32), kb = r / (NFF2 / 32); transpose_item(a.in[I_FF2IN], D, NFF2, (bf16_t*)(ws + WS_W2A), nb * 32, ffin_rowmap(nb * 32), kb * 64, scr, lane); continue; } r -= I_A;
        if (r < I_B) { const int nb = r % (D / 32), kb = r / (D / 32); transpose_item(a.in[I_FF1OUT], DFF, D, (bf16_t*)(ws + WS_W1B), nb * 32, nb * 32, kb * 64, scr, lane); continue; } r -= I_B;
        if (r < I_B) { const int nb = r % (D / 32), kb = r / (D / 32); transpose_item(a.in[I_FF2OUT], DFF, D, (bf16_t*)(ws + WS_W2B), nb * 32, nb * 32, kb * 64, scr, lane); continue; } r -= I_B;
        if (r < I_IN) { const int nb = r % (2592 / 32), kb = r / (2592 / 32); transpose_item(a.in[I_WIN], D, 2592, (bf16_t*)(ws + WS_WIN), nb * 32, win_rowmap(nb * 32), kb * 64, scr, lane); continue; } r -= I_IN;
        { const int nb = r % (D / 32), kb = r / (D / 32); transpose_item(a.in[I_WOUT], D, D, (bf16_t*)(ws + WS_WOUT), nb * 32, nb * 32, kb * 64, scr, lane); }
    }
    const int gt = gw * 64 + lane, NGT = NGW * 64;
    for (int i = gt; i < 8 * 128 * 128 / 2; i += NGT) { const float2 v = ((const float2*)a.in[I_WS])[i]; ((unsigned*)(ws + WS_WS))[i] = cvt_pk_bf16(v.x, v.y); }
    for (int i = gt; i < (ZW - 2592) * D / 2; i += NGT) ((unsigned*)(ws + WS_WIN + (size_t)2592 * D * 2))[i] = 0u;
}

DEV void norm_mod_phase(const float* src_lat, const float* src_ctx, int nrows, const float* g, const float* mod, int shift_i, int scale_i, bf16_t* XN, int gw, int NGW, int lane) {
    for (int row = 2 * gw; row < nrows; row += 2 * NGW) {
        const bool lat = row < MLAT; const int b = lat ? (row >> 12) : 16;
        const f32x4* xr = (const f32x4*)(lat ? src_lat + (size_t)row * D : src_ctx + (size_t)(row - MLAT) * D) + lane;
        f32x4 v[2][4], gm[4], sh[4];
#pragma unroll
        for (int r = 0; r < 2; ++r)
#pragma unroll
            for (int j = 0; j < 4; ++j) v[r][j] = __builtin_nontemporal_load(&xr[r * 256 + 64 * j]);
        const f32x4* gp = (const f32x4*)g + lane; const f32x4* scp = (const f32x4*)(mod + (size_t)b * NMOD + scale_i * D) + lane; const f32x4* shp = (const f32x4*)(mod + (size_t)b * NMOD + shift_i * D) + lane;
#pragma unroll
        for (int j = 0; j < 4; ++j) { gm[j] = gp[64 * j] * (scp[64 * j] + 1.f); sh[j] = shp[64 * j]; }
#pragma unroll
        for (int r = 0; r < 2; ++r) {
            float s = 0.f;
#pragma unroll
            for (int j = 0; j < 4; ++j) s += (v[r][j].x * v[r][j].x + v[r][j].y * v[r][j].y) + (v[r][j].z * v[r][j].z + v[r][j].w * v[r][j].w);
            const float rstd = rsqrtf(wave_sum(s) * (1.f / D) + EPS);
            u32x2* o8 = (u32x2*)(XN + (size_t)(row + r) * D) + lane;
#pragma unroll
            for (int j = 0; j < 4; ++j) { const f32x4 y = (v[r][j] * rstd) * gm[j] + sh[j]; u32x2 w; w.x = cvt_pk_bf16(y.x, y.y); w.y = cvt_pk_bf16(y.z, y.w); o8[64 * j] = w; }
        }
    }
}
DEV void final_norm_phase(float* xo, const float* g, int gw, int NGW, int lane) {
    const f32x4* gp = (const f32x4*)g + lane;
    f32x4 gm[4];
#pragma unroll
    for (int j = 0; j < 4; ++j) gm[j] = gp[64 * j];
    for (int row = 2 * gw; row < MLAT; row += 2 * NGW) {
        f32x4* xr = (f32x4*)(xo + (size_t)row * D) + lane;
        f32x4 v[2][4];
#pragma unroll
        for (int r = 0; r < 2; ++r)
#pragma unroll
            for (int j = 0; j < 4; ++j) v[r][j] = xr[r * 256 + 64 * j];
#pragma unroll
        for (int r = 0; r < 2; ++r) {
            float s = 0.f;
#pragma unroll
            for (int j = 0; j < 4; ++j) s += (v[r][j].x * v[r][j].x + v[r][j].y * v[r][j].y) + (v[r][j].z * v[r][j].z + v[r][j].w * v[r][j].w);
            const float rstd = rsqrtf(wave_sum(s) * (1.f / D) + EPS);
#pragma unroll
            for (int j = 0; j < 4; ++j) __builtin_nontemporal_store((v[r][j] * rstd) * gm[j], &xr[r * 256 + 64 * j]);
        }
    }
}

DEV void shiftw_phase(const bf16_t* Wt, int N, const float* mod, int shift_i, float* shw, int gw, int NGW, int lane) {
    for (int n = gw; n < N; n += NGW) {
        float wv[16]; { float f[8]; unpack8(*(const u32x4*)(Wt + (size_t)n * D + lane * 16), f);
#pragma unroll
            for (int j = 0; j < 8; ++j) wv[j] = f[j];
            unpack8(*(const u32x4*)(Wt + (size_t)n * D + lane * 16 + 8), f);
#pragma unroll
            for (int j = 0; j < 8; ++j) wv[8 + j] = f[j]; }
        float mine = 0.f;
#pragma unroll 6
        for (int b = 0; b < 17; ++b) {
            const f32x4* sp = (const f32x4*)(mod + (size_t)b * NMOD + shift_i * D + lane * 16); float s = 0.f;
#pragma unroll
            for (int q = 0; q < 4; ++q) { const f32x4 v = sp[q]; s += (v.x * wv[4 * q] + v.y * wv[4 * q + 1]) + (v.z * wv[4 * q + 2] + v.w * wv[4 * q + 3]); }
            s = wave_sum(s); if (lane == b) mine = s;
        }
        if (lane < 17) shw[(size_t)lane * N + n] = mine;
    }
}

DEV void conv_phase(const bf16_t* Z, const float* cw, bf16_t* QKV, int G) {
    const int gt = blockIdx.x * 512 + threadIdx.x, cgi = gt & 127, ch0 = cgi * 8;
    float w[9][8];
#pragma unroll
    for (int t = 0; t < 9; ++t) { const f32x4 a = *(const f32x4*)(cw + t * 1024 + ch0), b = *(const f32x4*)(cw + t * 1024 + ch0 + 4); w[t][0] = a.x; w[t][1] = a.y; w[t][2] = a.z; w[t][3] = a.w; w[t][4] = b.x; w[t][5] = b.y; w[t][6] = b.z; w[t][7] = b.w; }
    const float qs = (ch0 < 256) ? 0.125f : 1.f;
    const u32x4 zero4 = {0u, 0u, 0u, 0u};
    for (int sid = gt >> 7; sid < NB * 64; sid += (G * 512) >> 7) {
        const int cc = sid & 63, b = sid >> 6; const bool hasL = cc > 0, hasR = cc < 63;
        const bf16_t* zp = Z + (size_t)(b * SEQ + cc) * ZW + ch0;
        bf16_t* op = QKV + (size_t)(b * SEQ + cc) * D + ch0;
        float win[3][3][8];
        u32x4 raw[3];
#define CV_LOAD(r_) do { const bf16_t* q_ = zp + (size_t)(r_) * 64 * ZW; const bool v_ = (r_) < 64; \
        raw[0] = (v_ && hasL) ? *(const u32x4*)(q_ - ZW) : zero4; raw[1] = v_ ? *(const u32x4*)q_ : zero4; raw[2] = (v_ && hasR) ? *(const u32x4*)(q_ + ZW) : zero4; } while (0)
#define CV_UNPACK(slot_) do { unpack8(raw[0], win[slot_][0]); unpack8(raw[1], win[slot_][1]); unpack8(raw[2], win[slot_][2]); } while (0)
#define CV_STEP(r_, top_, mid_, bot_) do { if ((r_) < 64) { float acc[8]; \
        _Pragma("unroll") for (int j = 0; j < 8; ++j) { float s_ = 0.f; \
            _Pragma("unroll") for (int dx = 0; dx < 3; ++dx) s_ += w[dx][j] * win[top_][dx][j] + w[3 + dx][j] * win[mid_][dx][j] + w[6 + dx][j] * win[bot_][dx][j]; \
            acc[j] = silu_f(s_) * qs; } \
        *(u32x4*)(op + (size_t)(r_) * 64 * D) = pack8(acc); \
        CV_UNPACK(top_); CV_LOAD((r_) + 3); } } while (0)
#pragma unroll
        for (int dx = 0; dx < 3; ++dx)
#pragma unroll
            for (int j = 0; j < 8; ++j) win[2][dx][j] = 0.f;
        CV_LOAD(0); CV_UNPACK(0); CV_LOAD(1); CV_UNPACK(1); CV_LOAD(2);
        for (int r = 0; r < 66; r += 3) { CV_STEP(r, 2, 0, 1); CV_STEP(r + 1, 0, 1, 2); CV_STEP(r + 2, 1, 2, 0); }
#undef CV_LOAD
#undef CV_UNPACK
#undef CV_STEP
    }
    for (int row = MLAT + (gt >> 7); row < MALL; row += (G * 512) >> 7) {
        float acc[8];
#pragma unroll
        for (int j = 0; j < 8; ++j) acc[j] = 0.f;
        const int t = (row - MLAT) & 255;
#pragma unroll
        for (int dx = -1; dx <= 1; ++dx) { const int t2 = t + dx;
            if (t2 >= 0 && t2 < 256) { float f[8]; unpack8(*(const u32x4*)(Z + (size_t)(row + dx) * ZW + ch0), f);
#pragma unroll
                for (int j = 0; j < 8; ++j) acc[j] += w[3 + dx + 1][j] * f[j]; } }
#pragma unroll
        for (int j = 0; j < 8; ++j) acc[j] = silu_f(acc[j]) * qs;
        *(u32x4*)(QKV + (size_t)row * D + ch0) = pack8(acc);
    }
}

constexpr int L_GLR = 0, L_B = 8192, BP = 68, L_TOT = L_B + 2 * 64 * BP * 4, L_Q = L_TOT + 2048, QP = 72, L_K = L_Q + 2 * 64 * QP * 2, L_KHT = L_K + 2 * 64 * QP * 2, L_VT = L_KHT + 2 * 64 * QP * 2,
              L_P = L_VT + 128 * QP * 2, PP = 136, L_G1END = L_P + 64 * PP * 2;
static_assert(L_G1END <= LDS_BYTES, "G1 LDS");
DEV void gla_unit_rows(int u, int& b, int& c, int& h, int& row0) {
    if (u < NU_LAT) { b = u >> 8; c = (u >> 2) & 63; h = u & 3; row0 = b * SEQ + c * 64; }
    else { const int v = u - NU_LAT; b = v >> 4; c = (v >> 2) & 3; h = v & 3; row0 = MLAT + b * CTXL + c * 64; }
}
DEV void g1_phase(const Args& a, unsigned char* lds, int G) {
    unsigned char* ws = a.ws;
    const bf16_t* Z = (const bf16_t*)(ws + WS_ZH); const bf16_t* QKV = (const bf16_t*)(ws + WS_XN);
    bf16_t* QT = (bf16_t*)(ws + WS_QT); bf16_t* OI = (bf16_t*)(ws + WS_OI); bf16_t* KV = (bf16_t*)(ws + WS_KV); float* DEC = (float*)(ws + WS_DEC);
    const int t = threadIdx.x, lane = t & 63, w = t >> 6, ln = lane & 15, kg = lane >> 4;
    float* sB = (float*)(lds + L_B);
    bf16_t* sQ = (bf16_t*)(lds + L_Q); bf16_t* sK = (bf16_t*)(lds + L_K); bf16_t* sKhT = (bf16_t*)(lds + L_KHT); bf16_t* sVT = (bf16_t*)(lds + L_VT); bf16_t* sP = (bf16_t*)(lds + L_P);
    const int gdir = w >> 2, dkt = w & 3;
#define G1_LOAD(u_) do { int b_, c_, h_, r_; gla_unit_rows((u_), b_, c_, h_, r_); \
        _Pragma("unroll") for (int pt = 0; pt < 4; ++pt) gfn[pt] = (kg < 2) ? *(const u32x4*)(Z + (size_t)(r_ + pt * 16 + ln) * ZW + ZC_GLR + gdir * 16 + kg * 8) : (u32x4){0u, 0u, 0u, 0u}; \
        const bf16_t* qp_ = QKV + (size_t)(r_ + (t & 63)) * D + (t >> 6) * 8; \
        qn = *(const u32x4*)(qp_ + h_ * 64); kn = *(const u32x4*)(qp_ + 256 + h_ * 64); vn0 = *(const u32x4*)(qp_ + 512 + h_ * 128); vn1 = *(const u32x4*)(qp_ + 512 + h_ * 128 + 64); } while (0)
#define G1_WLOAD(h_) do { const float* wg_ = a.in[gdir ? I_WGB : I_WGF] + (h_) * 64 + dkt * 16 + ln; float wv_[8]; \
        _Pragma("unroll") for (int j = 0; j < 8; ++j) wv_[j] = (kg < 2) ? wg_[(kg * 8 + j) * 256] : 0.f; \
        const u32x4 wp_ = pack8(wv_); wfrag = __builtin_bit_cast(bf16x8, wp_); bias4 = *(const f32x4*)(a.in[gdir ? I_BGB : I_BGF] + (h_) * 64 + dkt * 16 + kg * 4); } while (0)
#define DPP_SHR(x_, n_) __builtin_bit_cast(float, __builtin_amdgcn_update_dpp(0, __builtin_bit_cast(int, (x_)), 0x110 | (n_), 0xf, 0xf, true))
    u32x4 qn, kn, vn0, vn1, gfn[4];
    if ((int)blockIdx.x < NU_ALL) G1_LOAD((int)blockIdx.x);
    bf16x8 wfrag; f32x4 bias4; int hcur = blockIdx.x & 3;
    G1_WLOAD(hcur);
    for (int u = blockIdx.x; u < NU_ALL; u += G) {
        int b, c, h, row0; gla_unit_rows(u, b, c, h, row0); const bool lat = u < NU_LAT;
        if (h != hcur) { hcur = h; G1_WLOAD(h); }
        const int pos = t & 63, g8 = t >> 6;
        const u32x4 qraw = qn, kraw = kn, vraw0 = vn0, vraw1 = vn1;
        u32x4 gf[4];
#pragma unroll
        for (int pt = 0; pt < 4; ++pt) gf[pt] = gfn[pt];
        if (u + G < NU_ALL) G1_LOAD(u + G);
        {
            float gl[4][4], cs[4][4], tot[4];
#pragma unroll
            for (int pt = 0; pt < 4; ++pt) {
                f32x4 pre = mfma16(wfrag, __builtin_bit_cast(bf16x8, gf[pt]), bias4);
#pragma unroll
                for (int r = 0; r < 4; ++r) { const float x = pre[r]; const float ls = (fminf(x, 0.f) - __logf(1.f + __expf(-fabsf(x)))) * (1.f / 16.f); gl[pt][r] = ls;
                    float sc = ls; sc += DPP_SHR(sc, 1); sc += DPP_SHR(sc, 2); sc += DPP_SHR(sc, 4); sc += DPP_SHR(sc, 8); cs[pt][r] = sc; }
            }
#pragma unroll
            for (int r = 0; r < 4; ++r) { float off = 0.f;
#pragma unroll
                for (int pt = 0; pt < 4; ++pt) { const float tt = __shfl(cs[pt][r], (lane & 48) | 15); cs[pt][r] += off; off += tt; }
                tot[r] = off; }
            if (gdir) {
#pragma unroll
                for (int pt = 0; pt < 4; ++pt)
#pragma unroll
                    for (int r = 0; r < 4; ++r) cs[pt][r] = tot[r] - cs[pt][r] + gl[pt][r];
            }
#pragma unroll
            for (int pt = 0; pt < 4; ++pt) *(f32x4*)(sB + (gdir * 64 + pt * 16 + ln) * BP + dkt * 16 + kg * 4) = (f32x4){cs[pt][0], cs[pt][1], cs[pt][2], cs[pt][3]};
            if (ln == 15) *(f32x4*)(DEC + ((size_t)u * 2 + gdir) * 64 + dkt * 16 + kg * 4) = (f32x4){__expf(tot[0]), __expf(tot[1]), __expf(tot[2]), __expf(tot[3])};
        }
        LBAR();
        {
            float q[8], k[8]; unpack8(qraw, q); unpack8(kraw, k);
            const unsigned tsel = (lane & 1) ? 0x03020706u : 0x05040100u;
#pragma unroll
            for (int dir = 0; dir < 2; ++dir) {
                const float* bp = sB + (dir * 64 + pos) * BP + g8 * 8; const float* bl = sB + (dir * 64 + (dir ? 0 : 63)) * BP + g8 * 8;
                const f32x4 b0 = *(const f32x4*)bp, b1 = *(const f32x4*)(bp + 4), l0 = *(const f32x4*)bl, l1 = *(const f32x4*)(bl + 4);
                float qt[8], kt[8], kh[8];
#pragma unroll
                for (int j = 0; j < 8; ++j) { const float bb = j < 4 ? b0[j] : b1[j - 4], ll = j < 4 ? l0[j] : l1[j - 4]; qt[j] = q[j] * __expf(bb); kt[j] = k[j] * __expf(-bb); kh[j] = k[j] * __expf(ll - bb); }
                const u32x4 qw = pack8(qt), kw = pack8(kt), hw = pack8(kh);
                *(u32x4*)(sQ + (dir * 64 + pos) * QP + g8 * 8) = qw;
                *(u32x4*)(sK + (dir * 64 + pos) * QP + g8 * 8) = kw;
                { unsigned* kp = (unsigned*)(sKhT + (dir * 64 + g8 * 8 + (lane & 1)) * QP + (pos & ~1));
#pragma unroll
                  for (int d = 0; d < 4; ++d) { const unsigned own = hw[d], oth = (unsigned)__builtin_amdgcn_update_dpp(0, (int)own, 0xB1, 0xf, 0xf, true);
                      kp[d * QP] = __builtin_amdgcn_perm(oth, own, tsel); } }
            }
#pragma unroll
            for (int i = 0; i < 2; ++i) { const u32x4 vw = i ? vraw1 : vraw0; unsigned* vp = (unsigned*)(sVT + ((g8 + 8 * i) * 8 + (lane & 1)) * QP + (pos & ~1));
#pragma unroll
                for (int d = 0; d < 4; ++d) { const unsigned own = vw[d], oth = (unsigned)__builtin_amdgcn_update_dpp(0, (int)own, 0xB1, 0xf, 0xf, true);
                    vp[d * QP] = __builtin_amdgcn_perm(oth, own, tsel); } }
        }
        LBAR();
        if (lat) {
            const int p2 = t >> 3, g2 = (t & 7) * 8;
#pragma unroll
            for (int dir = 0; dir < 2; ++dir) *(u32x4*)(QT + (size_t)(row0 + p2) * 512 + dir * 256 + h * 64 + g2) = *(const u32x4*)(sQ + (dir * 64 + p2) * QP + g2);
        }
        {
            const int dir = w >> 2, it = w & 3;
            bf16x8 qf[2];
#pragma unroll
            for (int ks = 0; ks < 2; ++ks) qf[ks] = *(const bf16x8*)(sQ + (dir * 64 + it * 16 + ln) * QP + ks * 32 + kg * 8);
#pragma unroll
            for (int jt = 0; jt < 4; ++jt) {
                f32x4 acc = {0.f, 0.f, 0.f, 0.f};
                const bool live = dir ? (jt >= it) : (jt <= it);
                if (live) {
#pragma unroll
                    for (int ks = 0; ks < 2; ++ks) { const bf16x8 kf = *(const bf16x8*)(sK + (dir * 64 + jt * 16 + ln) * QP + ks * 32 + kg * 8); acc = mfma16(kf, qf[ks], acc); }
                }
                const int i = it * 16 + ln, j0 = jt * 16 + kg * 4;
                float pv[4];
#pragma unroll
                for (int r = 0; r < 4; ++r) { const int j = j0 + r; const bool keep = dir ? (j >= i) : (j <= i); pv[r] = keep ? acc[r] : 0.f; }
                u32x2 pw; pw.x = cvt_pk_bf16(pv[0], pv[1]); pw.y = cvt_pk_bf16(pv[2], pv[3]);
                *(u32x2*)(sP + i * PP + dir * 64 + j0) = pw;
            }
        }
        LBAR();
        if (lat) {
            const int it = w & 3, half = w >> 2;
            f32x4 acc[4];
#pragma unroll
            for (int d = 0; d < 4; ++d) acc[d] = (f32x4){0.f, 0.f, 0.f, 0.f};
#pragma unroll
            for (int ks = 0; ks < 4; ++ks) {
                const bf16x8 pf = *(const bf16x8*)(sP + (it * 16 + ln) * PP + ks * 32 + kg * 8);
#pragma unroll
                for (int d = 0; d < 4; ++d) { const bf16x8 vf = *(const bf16x8*)(sVT + (half * 64 + (d >> 1) * 32 + prow(d & 1, ln)) * QP + (ks & 1) * 32 + kg * 8); acc[d] = mfma16(vf, pf, acc[d]); }
            }
#pragma unroll
            for (int p = 0; p < 2; ++p) *(u32x4*)(OI + (size_t)(row0 + it * 16 + ln) * 512 + h * 128 + half * 64 + p * 32 + kg * 8) = pack8v(acc[2 * p], acc[2 * p + 1]);
        }
        {
            const int dir = w >> 2;
#pragma unroll
            for (int e = 0; e < 2; ++e) {
                const int dvt = (w & 3) * 2 + e;
                bf16x8 vf[2];
#pragma unroll
                for (int ks = 0; ks < 2; ++ks) vf[ks] = *(const bf16x8*)(sVT + (dvt * 16 + ln) * QP + ks * 32 + kg * 8);
#pragma unroll
                for (int p = 0; p < 2; ++p) {
                    f32x4 acc[2];
#pragma unroll
                    for (int n = 0; n < 2; ++n) { acc[n] = (f32x4){0.f, 0.f, 0.f, 0.f};
#pragma unroll
                        for (int ks = 0; ks < 2; ++ks) { const bf16x8 kf = *(const bf16x8*)(sKhT + (dir * 64 + p * 32 + prow(n, ln)) * QP + ks * 32 + kg * 8); acc[n] = mfma16(kf, vf[ks], acc[n]); } }
                    *(u32x4*)(KV + (((size_t)u * 2 + dir) * 128 + dvt * 16 + ln) * 64 + p * 32 + kg * 8) = pack8v(acc[0], acc[1]);
                }
            }
        }
        LBAR();
    }
}

DEV void g2_phase(const Args& a, int G) {
    unsigned char* ws = a.ws;
    const bf16_t* KV = (const bf16_t*)(ws + WS_KV); const float* DEC = (const float*)(ws + WS_DEC); bf16_t* SB = (bf16_t*)(ws + WS_SB);
    for (int gt = blockIdx.x * 512 + threadIdx.x; gt < 128 * 1024; gt += G * 512) {
        const int s = gt >> 10, rem = gt & 1023, dv = rem >> 3, k8 = (rem & 7) * 8;
        const int b = s >> 3, h = (s >> 1) & 3, dir = s & 1;
        float S[8];
#pragma unroll
        for (int j = 0; j < 8; ++j) S[j] = 0.f;
#pragma unroll 1
        for (int blk = 0; blk < 17; ++blk) {
            u32x4 kvr[4]; f32x4 d0[4], d1[4]; size_t offs[4];
#pragma unroll
            for (int i = 0; i < 4; ++i) {
                const int step = blk * 4 + i; int u;
                if (step < 4) { const int c = dir ? 3 - step : step; u = NU_LAT + b * 16 + c * 4 + h; }
                else { const int c = dir ? 67 - step : step - 4; u = b * 256 + c * 4 + h; }
                offs[i] = (((size_t)u * 2 + dir) * 128 + dv) * 64 + k8;
                kvr[i] = *(const u32x4*)(KV + offs[i]);
                const float* dp = DEC + ((size_t)u * 2 + dir) * 64 + k8; d0[i] = *(const f32x4*)dp; d1[i] = *(const f32x4*)(dp + 4);
            }
#pragma unroll
            for (int i = 0; i < 4; ++i) {
                if (blk > 0) *(u32x4*)(SB + offs[i]) = pack8(S);
                float kv[8]; unpack8(kvr[i], kv);
#pragma unroll
                for (int j = 0; j < 8; ++j) S[j] = (j < 4 ? d0[i][j] : d1[i][j - 4]) * S[j] + kv[j];
            }
        }
    }
}

DEV void g3c1_phase(const Args& a, unsigned char* lds, int G) {
    unsigned char* ws = a.ws;
    const bf16_t* Z = (const bf16_t*)(ws + WS_ZH); const bf16_t* QT = (const bf16_t*)(ws + WS_QT); const bf16_t* OI = (const bf16_t*)(ws + WS_OI); const bf16_t* SB = (const bf16_t*)(ws + WS_SB);
    const bf16_t* WSB = (const bf16_t*)(ws + WS_WS); const float* rowss = (const float*)(ws + WS_RSP); bf16_t* MIX = (bf16_t*)(ws + WS_KV);
    const int t = threadIdx.x, lane = t & 63, w = t >> 6, ln = lane & 15, kg = lane >> 4;
    unsigned* sV = (unsigned*)lds;
    {
        bf16x8 nqf[4]; u32x4 noi[4], nog[4];
#define G3_ROW(pu_) ({ const int u_ = 2 * (pu_) + (w >> 2); (u_ >> 8) * SEQ + ((u_ >> 2) & 63) * 64 + (w & 3) * 16 + ln; })
#define G3_LOAD(pu_) do { const int u_ = 2 * (pu_) + (w >> 2), h_ = u_ & 3; const size_t r_ = (size_t)G3_ROW(pu_); \
        _Pragma("unroll") for (int ks = 0; ks < 4; ++ks) { const int k = ks * 32 + kg * 8; nqf[ks] = *(const bf16x8*)(QT + r_ * 512 + (k >> 6) * 256 + h_ * 64 + (k & 63)); } \
        _Pragma("unroll") for (int p = 0; p < 4; ++p) { noi[p] = *(const u32x4*)(OI + r_ * 512 + h_ * 128 + p * 32 + kg * 8); nog[p] = *(const u32x4*)(Z + r_ * ZW + ZC_OG + h_ * 128 + p * 32 + kg * 8); } } while (0)
        if ((int)blockIdx.x < NU_LAT / 2) G3_LOAD((int)blockIdx.x);
        for (int pu = blockIdx.x; pu < NU_LAT / 2; pu += G) {
            const int u = 2 * pu + (w >> 2), h = u & 3, row = G3_ROW(pu);
            bf16x8 qf[4]; u32x4 oi[4], og[4];
#pragma unroll
            for (int i = 0; i < 4; ++i) { qf[i] = nqf[i]; oi[i] = noi[i]; og[i] = nog[i]; }
            if (pu + G < NU_LAT / 2) G3_LOAD(pu + G);
            f32x4 acc[8];
#pragma unroll
            for (int d = 0; d < 8; ++d) acc[d] = (f32x4){0.f, 0.f, 0.f, 0.f};
#pragma unroll
            for (int ks = 0; ks < 4; ++ks) {
                const int k = ks * 32 + kg * 8, dir = k >> 6, kk = k & 63;
                bf16x8 sf[8];
#pragma unroll
                for (int d = 0; d < 8; ++d) sf[d] = *(const bf16x8*)(SB + (((size_t)u * 2 + dir) * 128 + (d >> 1) * 32 + prow(d & 1, ln)) * 64 + kk);
#pragma unroll
                for (int d = 0; d < 8; ++d) acc[d] = mfma16(sf[d], qf[ks], acc[d]);
            }
            float ss = 0.f;
#pragma unroll
            for (int p = 0; p < 4; ++p) { float f[8]; unpack8(oi[p], f);
#pragma unroll
                for (int j = 0; j < 4; ++j) { acc[2 * p][j] += f[j]; acc[2 * p + 1][j] += f[4 + j]; ss += acc[2 * p][j] * acc[2 * p][j] + acc[2 * p + 1][j] * acc[2 * p + 1][j]; } }
            ss += __shfl_xor(ss, 16); ss += __shfl_xor(ss, 32);
            const float rstd = rsqrtf(ss * (1.f / 128.f) + EPS);
#pragma unroll
            for (int p = 0; p < 4; ++p) { const int dv = p * 32 + kg * 8; float f[8], o[8]; unpack8(og[p], f);
                const f32x4 g0 = *(const f32x4*)(a.in[I_GLAG] + dv), g1 = *(const f32x4*)(a.in[I_GLAG] + dv + 4);
#pragma unroll
                for (int j = 0; j < 4; ++j) { o[j] = acc[2 * p][j] * rstd * g0[j] * f[j]; o[4 + j] = acc[2 * p + 1][j] * rstd * g1[j] * f[4 + j]; }
                *(u32x4*)(MIX + (size_t)row * D + h * 128 + dv) = pack8(o); }
        }
#undef G3_ROW
#undef G3_LOAD
    }
    {
        const int cgi = t & 7, pp = t >> 3;
        int hcur = -1; bf16x8 wf[4]; float bs = 0.f; f32x4 g0 = {0.f, 0.f, 0.f, 0.f}, g1 = g0;
        u32x4 nva, nvb, ngu[2]; f32x4 npa, npb, npc, npd;
#define C1_LOAD(v_) do { const int b_ = (v_) >> 8, n_ = ((v_) >> 3) & 31, hd_ = (v_) & 7, r0_ = b_ * SEQ + n_ * 128; \
        nva = *(const u32x4*)(Z + (size_t)(r0_ + 2 * pp) * ZW + ZC_VS + hd_ * 64 + cgi * 8); nvb = *(const u32x4*)(Z + (size_t)(r0_ + 2 * pp + 1) * ZW + ZC_VS + hd_ * 64 + cgi * 8); \
        const float* rp_ = rowss + (size_t)(r0_ + 2 * pp) * 8; npa = *(const f32x4*)rp_; npb = *(const f32x4*)(rp_ + 4); npc = *(const f32x4*)(rp_ + 8); npd = *(const f32x4*)(rp_ + 12); \
        _Pragma("unroll") for (int p = 0; p < 2; ++p) ngu[p] = *(const u32x4*)(Z + (size_t)(r0_ + w * 16 + ln) * ZW + ZC_U + hd_ * 64 + p * 32 + kg * 8); } while (0)
        if ((int)blockIdx.x < NU_LAT) C1_LOAD((int)blockIdx.x);
        for (int v = blockIdx.x; v < NU_LAT; v += G) {
            const int b = v >> 8, n = (v >> 3) & 31, hd = v & 7, r0 = b * SEQ + n * 128;
            if (hd != hcur) { hcur = hd;
#pragma unroll
                for (int ks = 0; ks < 4; ++ks) wf[ks] = *(const bf16x8*)(WSB + ((size_t)hd * 128 + w * 16 + ln) * 128 + ks * 32 + kg * 8);
                bs = a.in[I_BS][hd * 128 + w * 16 + ln];
                g0 = *(const f32x4*)(a.in[I_CMG] + hd * 64 + cgi * 8); g1 = *(const f32x4*)(a.in[I_CMG] + hd * 64 + cgi * 8 + 4); }
            const u32x4 va = nva, vb = nvb; const f32x4 pa = npa, pb = npb, pc = npc, pd = npd; u32x4 gu[2]; gu[0] = ngu[0]; gu[1] = ngu[1];
            if (v + G < NU_LAT) C1_LOAD(v + G);
            {
                float f0[8], f1[8]; unpack8(va, f0); unpack8(vb, f1);
                const float rs0 = rsqrtf((((pa.x + pa.y) + (pa.z + pa.w)) + ((pb.x + pb.y) + (pb.z + pb.w))) * (1.f / 512.f) + EPS), rs1 = rsqrtf((((pc.x + pc.y) + (pc.z + pc.w)) + ((pd.x + pd.y) + (pd.z + pd.w))) * (1.f / 512.f) + EPS);
#pragma unroll
                for (int j = 0; j < 8; ++j) { const float gj = j < 4 ? g0[j] : g1[j - 4]; const int ch = cgi * 8 + j, fsw = (ch ^ (ch >> 3)) & 15;
                    sV[ch * 64 + (((pp >> 2) ^ fsw) << 2) + (pp & 3)] = cvt_pk_bf16(f0[j] * rs0 * gj, f1[j] * rs1 * gj); }
            }
            LBAR();
            {
                f32x4 acc[4];
#pragma unroll
                for (int d = 0; d < 4; ++d) acc[d] = (f32x4){0.f, 0.f, 0.f, 0.f};
#pragma unroll
                for (int ks = 0; ks < 4; ++ks) {
#pragma unroll
                    for (int d = 0; d < 4; ++d) { const int ch = (d >> 1) * 32 + prow(d & 1, ln), fsw = (ch ^ (ch >> 3)) & 15; const bf16x8 vf = *(const bf16x8*)(sV + ch * 64 + (((ks * 4 + kg) ^ fsw) << 2)); acc[d] = mfma16(vf, wf[ks], acc[d]); }
                }
#pragma unroll
                for (int p = 0; p < 2; ++p) { const int ch = hd * 64 + p * 32 + kg * 8; float f[8], o[8]; unpack8(gu[p], f);
#pragma unroll
                    for (int j = 0; j < 4; ++j) { o[j] = (acc[2 * p][j] + bs) * f[j]; o[4 + j] = (acc[2 * p + 1][j] + bs) * f[4 + j]; }
                    *(u32x4*)(MIX + (size_t)(r0 + w * 16 + ln) * D + 512 + ch) = pack8(o); }
            }
            LBAR();
        }
#undef C1_LOAD
    }
}

#define LAS __attribute__((address_space(3)))
#define XB_TMO      128
#define XB_XCNT(j)  (256  + 64 * (j))
#define XB_XSUB(j)  (1280 + 64 * (j))
#define XB_XGEN(j)  (2304 + 64 * (j))
#define XB_TOP      3328
#define XB_TOPGEN   3392
#define XCD_BAR_WORDS 3456
#define XB_SPIN_CAP (1u << 18)

__device__ __forceinline__ unsigned xb_ld(unsigned* p)              { return __hip_atomic_load(p, __ATOMIC_RELAXED, __HIP_MEMORY_SCOPE_AGENT); }
__device__ __forceinline__ unsigned xb_add(unsigned* p, unsigned v) { return __hip_atomic_fetch_add(p, v, __ATOMIC_RELAXED, __HIP_MEMORY_SCOPE_AGENT); }
__device__ __forceinline__ unsigned xb_xcc_id() { return (unsigned)__builtin_amdgcn_s_getreg((3 << 11) | 20) & 0xFu; }
#define XB_SPIN(cond, bar) do { unsigned _sp = 0; while (cond) { __builtin_amdgcn_s_sleep(1); \
    if ((++_sp & 255u) == 0u) { if (xb_ld(&(bar)[XB_TMO])) break; if (_sp > XB_SPIN_CAP) { atomicAdd(&(bar)[XB_TMO], 1u); break; } } } } while (0)

struct XcdBarrier {
    unsigned* bar; unsigned x;
    volatile LAS unsigned* st;
};

__device__ __forceinline__ XcdBarrier xcd_barrier_post(unsigned* bar, volatile LAS unsigned* st) {
    XcdBarrier b; b.bar = bar; b.x = xb_xcc_id(); b.st = st;
    if (threadIdx.x == 0) (void)xb_add(&bar[XB_XCNT(b.x)], 1u);
    return b;
}
__device__ __forceinline__ void xcd_barrier_complete(unsigned* bar, unsigned x, unsigned& nloc, unsigned& nx) {
    const unsigned G = gridDim.x * gridDim.y * gridDim.z;
    unsigned sum, cnt, mine, sp = 0u;
    for (;;) {
        sum = 0u; cnt = 0u; mine = 0u;
#pragma unroll
        for (unsigned j = 0; j < 16; ++j) { const unsigned c = xb_ld(&bar[XB_XCNT(j)]); sum += c; cnt += (c > 0u) ? 1u : 0u; mine = (j == x) ? c : mine; }
        if (sum == G) break;
        __builtin_amdgcn_s_sleep(1);
        if ((++sp & 255u) == 0u) { if (xb_ld(&bar[XB_TMO])) break; if (sp > XB_SPIN_CAP) { atomicAdd(&bar[XB_TMO], 1u); break; } }
    }
    nloc = mine > 0u ? mine : 1u; nx = cnt > 0u ? cnt : 1u;
}

__device__ __forceinline__ void xcd_barrier(const XcdBarrier& b) {
    asm volatile("s_waitcnt vmcnt(0)" ::: "memory");
    __syncthreads();
    if (threadIdx.x == 0) {
        unsigned* bar = b.bar;
        __builtin_amdgcn_s_waitcnt(0);
        unsigned nloc = b.st[0], nx = b.st[1];
        if (nloc == 0u) { xcd_barrier_complete(bar, b.x, nloc, nx); b.st[0] = nloc; b.st[1] = nx; }
        const unsigned old = xb_add(&bar[XB_XSUB(b.x)], 1u);
        const unsigned gen = old / nloc;
        if (old + 1u == (gen + 1u) * nloc) {
            __builtin_amdgcn_fence(__ATOMIC_RELEASE, "agent");
            asm volatile("s_waitcnt vmcnt(0)" ::: "memory");
            const unsigned og = xb_add(&bar[XB_TOP], 1u);
            const unsigned tg = og / nx;
            if (og + 1u == (tg + 1u) * nx) xb_add(&bar[XB_TOPGEN], 1u);
            else XB_SPIN(xb_ld(&bar[XB_TOPGEN]) == tg, bar);
            __builtin_amdgcn_fence(__ATOMIC_ACQUIRE, "agent");
            xb_add(&bar[XB_XGEN(b.x)], 1u);
            asm volatile("s_waitcnt vmcnt(0)" ::: "memory");
        } else {
            XB_SPIN(xb_ld(&bar[XB_XGEN(b.x)]) == gen, bar);
            __builtin_amdgcn_fence(__ATOMIC_ACQUIRE, "agent");
            asm volatile("s_waitcnt vmcnt(0)" ::: "memory");
        }
    }
    __syncthreads();
}


constexpr int NPHASE = 15;
__global__ void __launch_bounds__(512, 2) fwd_kernel(Args a) {
    extern __shared__ __attribute__((aligned(16))) unsigned char lds[];
    const int G = gridDim.x, tid = threadIdx.x, lane = tid & 63, wave = __builtin_amdgcn_readfirstlane(tid >> 6);
    const int gw = blockIdx.x * 8 + wave, NGW = G * 8;
    unsigned char* ws = a.ws;
    const float* mod = (const float*)(ws + WS_MOD);
    bf16_t* XN = (bf16_t*)(ws + WS_XN); bf16_t* ZH = (bf16_t*)(ws + WS_ZH); float* X1C = (float*)(ws + WS_X1C);
    PG8_LAS unsigned char* ldsg = (PG8_LAS unsigned char*)lds;
    const int lo = a.ph_lo, hi = a.ph_hi;
    volatile LAS unsigned* bst = (volatile LAS unsigned*)(ldsg + (LDS_BYTES - 64));
    if (tid == 0) { bst[0] = 0u; bst[1] = 0u; }
    __syncthreads();
    XcdBarrier xbar; xbar.bar = (unsigned*)(ws + WS_CTL); xbar.x = 0; xbar.st = bst;
    if (hi - lo > 1) xbar = xcd_barrier_post((unsigned*)(ws + WS_CTL), bst);
#define IN(k) (lo <= (k) && (k) < hi)
#define SEAM(k) do { if (IN(k) && IN((k) + 1)) { if (a.ph_hi > 4096) cg::this_grid().sync(); else xcd_barrier(xbar); } } while (0)
    if (IN(0)) { p0_prep(a, lds, gw, NGW, wave, lane); } SEAM(0);
    if (IN(1)) { norm_mod_phase(a.in[I_X], a.in[I_CTX], MALL, a.in[I_N1G], mod, 0, 1, XN, gw, NGW, lane);
        shiftw_phase((const bf16_t*)(ws + WS_WIN), ZW, mod, 3, (float*)(ws + WS_SHW1), gw, NGW, lane); shiftw_phase((const bf16_t*)(ws + WS_W2A), NFF2, mod, 6, (float*)(ws + WS_SHW2), gw, NGW, lane); } SEAM(1);
    if (IN(2)) { pg8::Gemm g{XN, (const bf16_t*)(ws + WS_W1A), MALL, NFF2, D}; pg8::StaticOrder S; S.init(MALL, NFF2, G, (int)blockIdx.x); EpiSwiGLU<false> E{ZH, nullptr, nullptr};
        pg8::gemm_phase<EpiSwiGLU<false>, pg8::StaticOrder, true, true>(ldsg, g, S, E); } SEAM(2);
    if (IN(3)) { pg8::Gemm g{ZH, (const bf16_t*)(ws + WS_W1B), MALL, D, DFF}; pg8::StaticOrder S; S.init(MALL, D, G, (int)blockIdx.x); typedef EpiResid<2, true, true, 4> EpiT; EpiT E{a.in[I_X], a.in[I_CTX], a.out, X1C, mod, XN, a.in[I_N2G], (float*)(ws + WS_RS2)};
        pg8::gemm_phase<EpiT, pg8::StaticOrder, true, true>(ldsg, g, S, E); } SEAM(3);
    if (IN(5)) { pg8::Gemm g{XN, (const bf16_t*)(ws + WS_WIN), MALL, ZW, D}; pg8::StaticOrder S; S.init(MALL, ZW, G, (int)blockIdx.x); EpiZ E{ZH, (float*)(ws + WS_RSP), (const float*)(ws + WS_RS2), (const float*)(ws + WS_SHW1)};
        pg8::gemm_phase<EpiZ, pg8::StaticOrder, true, true>(ldsg, g, S, E); } SEAM(5);
    if (IN(6)) { conv_phase(ZH, a.in[I_CONVW], XN, G); } SEAM(6);
    if (IN(7)) { g1_phase(a, lds, G); } SEAM(7);
    if (IN(8)) { g2_phase(a, G); } SEAM(8);
    if (IN(9)) { g3c1_phase(a, lds, G); } SEAM(9);
    if (IN(10)) { pg8::Gemm g{(const bf16_t*)(ws + WS_KV), (const bf16_t*)(ws + WS_WOUT), MLAT, D, D}; pg8::StaticOrder S; S.init(MLAT, D, G, (int)blockIdx.x); typedef EpiResid<5, false, true, 7> EpiT; EpiT E{a.out, a.out, a.out, a.out, mod, XN, a.in[I_N3G], (float*)(ws + WS_RS3)};
        pg8::gemm_phase<EpiT, pg8::StaticOrder, true, true>(ldsg, g, S, E); } SEAM(10);
    if (IN(12)) { pg8::Gemm g{XN, (const bf16_t*)(ws + WS_W2A), MLAT, NFF2, D}; pg8::StaticOrder S; S.init(MLAT, NFF2, G, (int)blockIdx.x); EpiSwiGLU<true> E{ZH, (const float*)(ws + WS_RS3), (const float*)(ws + WS_SHW2)};
        pg8::gemm_phase<EpiSwiGLU<true>, pg8::StaticOrder, true, true>(ldsg, g, S, E); } SEAM(12);
    if (IN(13)) { pg8::Gemm g{ZH, (const bf16_t*)(ws + WS_W2B), MLAT, D, DFF}; pg8::StaticOrder S; S.init(MLAT, D, G, (int)blockIdx.x); typedef EpiResid<8, true, false, 0> EpiT; EpiT E{a.out, a.out, a.out, a.out, mod, nullptr, nullptr, nullptr};
        pg8::gemm_phase<EpiT, pg8::StaticOrder, true, true>(ldsg, g, S, E); } SEAM(13);
    if (IN(14)) { final_norm_phase(a.out, a.in[I_FING], gw, NGW, lane); }
#if defined(MK_EXTRA_SYNC) && MK_EXTRA_SYNC
    if (hi - lo > 1) for (int i = 0; i < MK_EXTRA_SYNC; ++i) cg::this_grid().sync();
#endif
#undef IN
#undef SEAM
}


extern "C" void kernel_launch(void* const* d_in, const int* in_sizes, int n_in, void* d_out, int out_size, void* d_ws, size_t ws_size, hipStream_t stream) {
    static int grid = 0;
    if (grid == 0) {
        if (n_in != 25 || out_size != MLAT * D || ws_size < WS_END) { fprintf(stderr, "kernel_launch: unexpected shapes (n_in %d, out %d, ws %zu; need ws >= %zu)\n", n_in, out_size, ws_size, (size_t)WS_END); grid = -1; return; }
        int dev = 0, cus = 0, per_cu = 0;
        (void)hipGetDevice(&dev); (void)hipDeviceGetAttribute(&cus, hipDeviceAttributeMultiprocessorCount, dev);
        if (hipFuncSetAttribute((const void*)fwd_kernel, hipFuncAttributeMaxDynamicSharedMemorySize, LDS_BYTES) != hipSuccess) { fprintf(stderr, "kernel_launch: hipFuncSetAttribute failed\n"); grid = -1; return; }
        if (hipOccupancyMaxActiveBlocksPerMultiprocessor(&per_cu, (const void*)fwd_kernel, 512, LDS_BYTES) != hipSuccess || per_cu < 1) { fprintf(stderr, "kernel_launch: occupancy query says %d\n", per_cu); per_cu = 1; }
        (void)hipGetLastError();
        grid = cus * per_cu;
    }
    if (grid < 0) return;
    (void)hipMemsetAsync((char*)d_ws + WS_CTL, 0, 1 << 20, stream);
    Args a{};
    for (int i = 0; i < 25; ++i) a.in[i] = (const float*)d_in[i];
    a.out = (float*)d_out; a.ws = (unsigned char*)d_ws;
#if MK_ONE_LAUNCH
    a.ph_lo = 0; a.ph_hi = NPHASE;
    void* args[] = {&a};
    hipError_t e = hipLaunchCooperativeKernel((const void*)fwd_kernel, dim3(grid), dim3(512), args, LDS_BYTES, stream);
    if (e != hipSuccess) fprintf(stderr, "cooperative launch failed: %s (grid %d)\n", hipGetErrorString(e), grid);
#if defined(MK_DUP) && MK_DUP
    for (int p = 0; p < NPHASE; ++p) if ((MK_DUP >> p) & 1) { a.ph_lo = p; a.ph_hi = p + 1; hipLaunchKernelGGL(fwd_kernel, dim3(grid), dim3(512), LDS_BYTES, stream, a); }
#endif
#else
    for (int p = 0; p < NPHASE; ++p) { a.ph_lo = p; a.ph_hi = p + 1; hipLaunchKernelGGL(fwd_kernel, dim3(grid), dim3(512), LDS_BYTES, stream, a); }
#endif
}
```

```cpp
#include <hip/hip_runtime.h>
#include <hip/hip_cooperative_groups.h>
#include <cstdio>
#include <cstdint>
namespace cg = cooperative_groups;
#ifndef MK_ONE_LAUNCH
#define MK_ONE_LAUNCH 1
#endif
#ifndef MK_DUP
#define MK_DUP 0
#endif
#ifndef MK_EXTRA_SYNC
#define MK_EXTRA_SYNC 0
#endif
namespace pg8 {
#define PG8_LAS __attribute__((address_space(3)))
typedef unsigned short bf16_t;
typedef short bf16x8 __attribute__((ext_vector_type(8)));
typedef float f32x4 __attribute__((ext_vector_type(4)));
typedef unsigned u32x4 __attribute__((ext_vector_type(4)));
constexpr int BM = 256, BK = 64, HALF = 128, HTB = HALF * BK * 2  , STAGE_BYTES = 8 * HTB, NXCD = 8, WGM = 8;

__host__ __device__ __forceinline__ int lds_byte(int r, int c) { const int st = (r >> 4) * 2 + (c >> 5), rr = r & 15, cc = c & 31, ob = rr * 64 + cc * 2; return st * 1024 + (ob ^ (((ob >> 9) & 1) << 5)); }
__host__ __device__ __forceinline__ void stage_rc(int b, int& R, int& C) { const int st = b / 1024, sb = b % 1024, swz = sb ^ (((sb >> 9) & 1) << 5); R = (st >> 1) * 16 + swz / 64; C = (st & 1) * 32 + (swz % 64) / 2; }
__host__ __device__ __forceinline__ int perm32(int rho) { const int n = rho >> 4, i = rho & 15; return 8 * (i >> 2) + 4 * n + (i & 3); }

struct Unit { int pm, pn; };
struct Gemm { const bf16_t* A; const bf16_t* Bt; int M, N, K; };

struct StaticOrder {
    int nM, nN, nwg, G, c;
    __host__ __device__ void init(int M, int N, int G_, int c_) { nM = M / BM; nN = N / BM; nwg = nM * nN; G = G_; c = c_; }
    __host__ __device__ bool next(int i, Unit& u) const {
        const long L = (long)i * G + c; if (L >= nwg) return false;
        int wgid = (int)L; { const int q = nwg / NXCD, r = nwg % NXCD, xcd = wgid % NXCD, off = wgid / NXCD; wgid = (xcd < r ? xcd * (q + 1) : r * (q + 1) + (xcd - r) * q) + off; }
        const int nig = WGM * nN, gid = wgid / nig, fm = gid * WGM, gsz = (nM - fm) < WGM ? (nM - fm) : WGM;
        u.pm = fm + ((wgid % nig) % gsz); u.pn = (wgid % nig) / gsz; return true;
    }
    __device__ __forceinline__ void a_ready(const Unit&) const {}
    __device__ __forceinline__ void done(const Unit&) const {}
};

typedef float f32x2_t __attribute__((ext_vector_type(2))); typedef __bf16 bf16x2_t __attribute__((ext_vector_type(2)));
__device__ __forceinline__ unsigned cvt_pk_bf16(float lo, float hi) { f32x2_t v = {lo, hi}; bf16x2_t b = __builtin_convertvector(v, bf16x2_t); return __builtin_bit_cast(unsigned, b); }
template <class Epi, class Sched, bool ALIGN_EPI = false, bool SP2 = false>
__device__ __forceinline__ void gemm_phase(PG8_LAS unsigned char* lds, const Gemm g, const Sched& S, const Epi& E) {
    const int tid = threadIdx.x, wid = __builtin_amdgcn_readfirstlane(tid >> 6), lane = tid & 63, wr = wid >> 2, wc = wid & 3, fr = lane & 15, fq = lane >> 4;
    const int K = g.K, nt = K / BK;
    unsigned voffA[2], voffB[2];
#pragma unroll
    for (int i = 0; i < 2; ++i) { int R, C; stage_rc(tid * 16 + i * 8192, R, C); const int Rb = Epi::PERM ? ((R & ~31) + perm32(R & 31)) : R;
        voffA[i] = (unsigned)(R * K + C) * 2u; voffB[i] = (unsigned)(Rb * K + C) * 2u; }
    const size_t kstep = (size_t)(BK * 2);
    const size_t hstep = (size_t)HALF * K * 2;
    const size_t tstep = 2 * hstep;
    const unsigned ldsw = (unsigned)wid * 1024u;
    const int aoff = lds_byte(wr * 64 + fr, fq * 8), boff = lds_byte(wc * 32 + fr, fq * 8);
#define PG8_SA(b, h) (((b) * 2 + (h)) * HTB)
#define PG8_SB(b, h) ((4 + (b) * 2 + (h)) * HTB)
#define PG8_STAGE(bufoff, gbase, voff) do { _Pragma("unroll") for (int _i = 0; _i < 2; ++_i) \
        __builtin_amdgcn_global_load_lds((const unsigned*)((const char*)(gbase) + (voff)[_i]), (PG8_LAS unsigned*)(lds + (bufoff) + ldsw + _i * 8192), 16, 0, 0); } while (0)
#define PG8_LDA(dst, b, h) do { _Pragma("unroll") for (int m = 0; m < 4; ++m) _Pragma("unroll") for (int k = 0; k < 2; ++k) dst[m][k] = *(const PG8_LAS bf16x8*)(lds + PG8_SA(b, h) + aoff + m * 2048 + k * 1024); } while (0)
#define PG8_LDB(dst, b, h) do { _Pragma("unroll") for (int n = 0; n < 2; ++n) _Pragma("unroll") for (int k = 0; k < 2; ++k) dst[n][k] = *(const PG8_LAS bf16x8*)(lds + PG8_SB(b, h) + boff + n * 2048 + k * 1024); } while (0)
#define PG8_MMA(ai, bj, At, Bt) do { __builtin_amdgcn_s_setprio(1); _Pragma("unroll") for (int m = 0; m < 4; ++m) _Pragma("unroll") for (int n = 0; n < 2; ++n) _Pragma("unroll") for (int k = 0; k < 2; ++k) \
        acc[ai][bj][m][n] = __builtin_amdgcn_mfma_f32_16x16x32_bf16(Bt[n][k], At[m][k], acc[ai][bj][m][n], 0, 0, 0); __builtin_amdgcn_s_setprio(0); } while (0)
#define PG8_WAIT_V(n) asm volatile("s_waitcnt vmcnt(" #n ")" ::: "memory")
#define PG8_WAIT_L(n) asm volatile("s_waitcnt lgkmcnt(" #n ")" ::: "memory")
#define PG8_BAR __builtin_amdgcn_s_barrier()
#define PG8_SCHED __builtin_amdgcn_sched_barrier(0)
    Unit cur, nxt; int ui = 0;
    if (!S.next(0, cur)) return;
    f32x4 acc[2][2][4][2];
#pragma unroll
    for (int a = 0; a < 2; ++a)
#pragma unroll
        for (int b = 0; b < 2; ++b)
#pragma unroll
            for (int m = 0; m < 4; ++m)
#pragma unroll
                for (int n = 0; n < 2; ++n) acc[a][b][m][n] = (f32x4){0.f, 0.f, 0.f, 0.f};
    bf16x8 At[4][2], B0[2][2], B1[2][2];
    const char* cA = (const char*)g.A + (size_t)cur.pm * tstep; const char* cB = (const char*)g.Bt + (size_t)cur.pn * tstep;
    S.a_ready(cur);
    if constexpr (SP2) {
        PG8_STAGE(PG8_SB(0, 0), cB, voffB); PG8_STAGE(PG8_SB(0, 1), cB + hstep, voffB); PG8_STAGE(PG8_SA(0, 0), cA, voffA); PG8_STAGE(PG8_SA(0, 1), cA + hstep, voffA);
        if (wr == 1) PG8_BAR;
        PG8_WAIT_V(2); PG8_BAR;
        PG8_STAGE(PG8_SB(1, 0), cB + kstep, voffB); PG8_STAGE(PG8_SA(1, 0), cA + kstep, voffA); PG8_STAGE(PG8_SB(1, 1), cB + hstep + kstep, voffB);
        PG8_WAIT_V(6); PG8_BAR;
    } else {
        PG8_STAGE(PG8_SB(0, 0), cB, voffB); PG8_STAGE(PG8_SA(0, 0), cA, voffA); PG8_STAGE(PG8_SB(0, 1), cB + hstep, voffB); PG8_STAGE(PG8_SA(0, 1), cA + hstep, voffA);
        if (wr == 1) PG8_BAR;
        PG8_WAIT_V(4); PG8_BAR;
        PG8_STAGE(PG8_SB(1, 0), cB + kstep, voffB); PG8_STAGE(PG8_SA(1, 0), cA + kstep, voffA); PG8_STAGE(PG8_SB(1, 1), cB + hstep + kstep, voffB);
        PG8_WAIT_V(6); PG8_BAR;
    }
    for (;;) {
        const bool has_next = S.next(ui + 1, nxt);
        const char* nA = has_next ? (const char*)g.A + (size_t)nxt.pm * tstep : cA; const char* nB = has_next ? (const char*)g.Bt + (size_t)nxt.pn * tstep : cB;
        for (int t = 0; t < nt; t += 2) {
            const bool last = (t == nt - 2);
            const char* a1 = cA + (size_t)(t + 1) * kstep;
            const char* a2 = last ? nA : cA + (size_t)(t + 2) * kstep; const char* b2 = last ? nB : cB + (size_t)(t + 2) * kstep;
            const char* a3 = a2 + kstep; const char* b3 = b2 + kstep;
            if (last && has_next) S.a_ready(nxt);
            if constexpr (SP2) {
            PG8_LDB(B0, 0, 0); PG8_LDB(B1, 0, 1); PG8_SCHED; PG8_LDA(At, 0, 0); PG8_STAGE(PG8_SA(1, 1), a1 + hstep, voffA);
            PG8_WAIT_V(8); PG8_WAIT_L(0); PG8_BAR; PG8_MMA(0, 0, At, B0); PG8_MMA(0, 1, At, B1); PG8_BAR; PG8_SCHED;
            PG8_LDA(At, 0, 1); PG8_STAGE(PG8_SB(0, 0), b2, voffB); PG8_STAGE(PG8_SB(0, 1), b2 + hstep, voffB); PG8_STAGE(PG8_SA(0, 0), a2, voffA);
            PG8_WAIT_V(8); PG8_WAIT_L(0); PG8_BAR; PG8_MMA(1, 0, At, B0); PG8_MMA(1, 1, At, B1); PG8_BAR; PG8_SCHED;
            PG8_LDB(B0, 1, 0); PG8_LDB(B1, 1, 1); PG8_SCHED; PG8_LDA(At, 1, 0); PG8_STAGE(PG8_SA(0, 1), a2 + hstep, voffA);
            PG8_WAIT_V(8); PG8_WAIT_L(0); PG8_BAR; PG8_MMA(0, 0, At, B0); PG8_MMA(0, 1, At, B1); PG8_BAR; PG8_SCHED;
            PG8_LDA(At, 1, 1); PG8_STAGE(PG8_SB(1, 0), b3, voffB); PG8_STAGE(PG8_SB(1, 1), b3 + hstep, voffB); PG8_STAGE(PG8_SA(1, 0), a3, voffA);
            PG8_WAIT_V(8); PG8_WAIT_L(0); PG8_BAR; PG8_MMA(1, 0, At, B0); PG8_MMA(1, 1, At, B1); PG8_BAR; PG8_SCHED;
            } else {
            PG8_LDB(B0, 0, 0); PG8_SCHED; PG8_LDA(At, 0, 0); PG8_STAGE(PG8_SA(1, 1), a1 + hstep, voffA);
            PG8_WAIT_L(8); PG8_BAR; PG8_WAIT_L(0); PG8_MMA(0, 0, At, B0); PG8_BAR; PG8_SCHED;
            PG8_LDB(B1, 0, 1); PG8_STAGE(PG8_SB(0, 0), b2, voffB);
            PG8_BAR; PG8_WAIT_L(0); PG8_MMA(0, 1, At, B1); PG8_BAR;
            PG8_LDA(At, 0, 1); PG8_STAGE(PG8_SA(0, 0), a2, voffA);
            PG8_BAR; PG8_WAIT_L(0); PG8_MMA(1, 0, At, B0); PG8_BAR; PG8_SCHED;
            PG8_STAGE(PG8_SB(0, 1), b2 + hstep, voffB);
            PG8_WAIT_V(6); PG8_BAR; PG8_MMA(1, 1, At, B1); PG8_BAR;
            PG8_LDB(B0, 1, 0); PG8_SCHED; PG8_LDA(At, 1, 0); PG8_STAGE(PG8_SA(0, 1), a2 + hstep, voffA);
            PG8_WAIT_L(8); PG8_BAR; PG8_WAIT_L(0); PG8_MMA(0, 0, At, B0); PG8_BAR; PG8_SCHED;
            PG8_LDB(B1, 1, 1); PG8_STAGE(PG8_SB(1, 0), b3, voffB);
            PG8_BAR; PG8_WAIT_L(0); PG8_MMA(0, 1, At, B1); PG8_BAR;
            PG8_LDA(At, 1, 1); PG8_STAGE(PG8_SA(1, 0), a3, voffA);
            PG8_BAR; PG8_WAIT_L(0); PG8_MMA(1, 0, At, B0); PG8_BAR; PG8_SCHED;
            PG8_STAGE(PG8_SB(1, 1), b3 + hstep, voffB);
            PG8_WAIT_V(6); PG8_BAR; PG8_MMA(1, 1, At, B1); PG8_BAR;
            }
        }
        if constexpr (ALIGN_EPI) { if (wr == 0) PG8_BAR; }
        if constexpr (!Epi::AFTER_DRAIN) { E(acc, cur, wr, wc, fr, fq); S.done(cur); }
        if (!has_next) break;
#pragma unroll
        for (int a = 0; a < 2; ++a)
#pragma unroll
            for (int b = 0; b < 2; ++b)
#pragma unroll
                for (int m = 0; m < 4; ++m)
#pragma unroll
                    for (int n = 0; n < 2; ++n) acc[a][b][m][n] = (f32x4){0.f, 0.f, 0.f, 0.f};
        cur = nxt; cA = nA; cB = nB; ++ui;
        if constexpr (ALIGN_EPI) { if (wr == 1) PG8_BAR; }
    }
    PG8_WAIT_V(0);
    if constexpr (!ALIGN_EPI) { if (wr == 0) PG8_BAR; }
    PG8_BAR;
    if constexpr (Epi::AFTER_DRAIN) { E.fused(acc, cur, wr, wc, fr, fq, lds, wid, lane); S.done(cur); }
#undef PG8_SA
#undef PG8_SB
#undef PG8_STAGE
#undef PG8_LDA
#undef PG8_LDB
#undef PG8_MMA
#undef PG8_WAIT_V
#undef PG8_WAIT_L
#undef PG8_BAR
#undef PG8_SCHED
}
}
using pg8::bf16_t; using pg8::bf16x8; using pg8::f32x4; using pg8::u32x4; using pg8::Unit; using pg8::cvt_pk_bf16;
typedef unsigned u32x2 __attribute__((ext_vector_type(2)));
#define DEV __device__ __forceinline__
constexpr int D = 1024, NB = 16, SEQ = 4096, MLAT = NB * SEQ, CTXL = 256, MCTX = NB * CTXL, MALL = MLAT + MCTX;
constexpr int DFF = 2816, NFF2 = 2 * DFF, ZW = 2816, NMOD = 9 * D;
constexpr int NU_LAT = NB * 64 * 4, NU_CTX = NB * 4 * 4, NU_ALL = NU_LAT + NU_CTX;
constexpr float EPS = 1e-6f;
constexpr int ZC_OG = 1024, ZC_U = 1536, ZC_VS = 2048, ZC_GLR = 2560;
constexpr size_t MiB = 1u << 20;
constexpr size_t WS_CTL = 0, WS_MOD = 64 * 1024;
static_assert(WS_MOD + 17 * 9216 * 4 <= (1u << 20), "MOD inside the zeroed region");
constexpr size_t WS_W1A = 2 * MiB, WS_W1B = 13 * MiB, WS_WIN = 19 * MiB, WS_WOUT = 25 * MiB, WS_W2A = 27 * MiB, WS_W2B = 38 * MiB, WS_WS = 44 * MiB;
constexpr size_t WS_DEC = 45 * MiB, WS_X1C = 48 * MiB, WS_XN = 64 * MiB, WS_ZH = 200 * MiB, WS_QT = 574 * MiB, WS_OI = 638 * MiB, WS_KV = 702 * MiB, WS_SB = 838 * MiB, WS_RSP = 966 * MiB, WS_RS2 = 969 * MiB, WS_RS3 = 974 * MiB, WS_SHW1 = 978 * MiB, WS_SHW2 = 979 * MiB, WS_END = 980 * MiB;
static_assert(WS_MOD + 17 * NMOD * 4 <= 2 * MiB && WS_RSP + (size_t)MALL * 8 * 4 <= WS_RS2 && WS_RS2 + (size_t)MALL * 16 * 4 <= WS_RS3 && WS_RS3 + (size_t)MLAT * 16 * 4 <= WS_SHW1 && WS_SHW1 + 17 * ZW * 4 <= WS_SHW2 && WS_SHW2 + 17 * NFF2 * 4 <= WS_END, "mod / row-stat / shift regions");
static_assert(WS_W1A + (size_t)NFF2 * D * 2 <= WS_W1B && WS_W1B + (size_t)D * DFF * 2 <= WS_WIN && WS_WIN + (size_t)ZW * D * 2 <= WS_WOUT && WS_WOUT + (size_t)D * D * 2 <= WS_W2A, "w map");
static_assert(WS_W2A + (size_t)NFF2 * D * 2 <= WS_W2B && WS_W2B + (size_t)D * DFF * 2 <= WS_WS && WS_WS + 8 * 128 * 128 * 2 <= WS_DEC && WS_DEC + (size_t)NU_ALL * 128 * 4 <= WS_X1C, "w map 2");
static_assert(WS_X1C + (size_t)MCTX * D * 4 <= WS_XN && WS_XN + (size_t)MALL * D * 2 <= WS_ZH && WS_ZH + (size_t)MALL * ZW * 2 <= WS_QT && WS_QT + (size_t)MLAT * 512 * 2 <= WS_OI, "act map");
static_assert(WS_OI + (size_t)MLAT * 512 * 2 <= WS_KV && WS_KV + (size_t)NU_ALL * 2 * 128 * 64 * 2 <= WS_SB && WS_SB + (size_t)NU_LAT * 2 * 128 * 64 * 2 <= WS_RSP, "act map 2");
static_assert(WS_KV + (size_t)MLAT * D * 2 <= WS_SB, "MIX overlays KV");
constexpr int LDS_BYTES = 147456;

DEV float bf_lo(unsigned w) { return __uint_as_float(w << 16); }
DEV float bf_hi(unsigned w) { return __uint_as_float(w & 0xffff0000u); }
DEV float silu_f(float x) { return x * __builtin_amdgcn_rcpf(1.f + __expf(-x)); }
DEV float gelu_f(float x) { const float t = 1.5957691216f * (x + 0.044715f * x * x * x); return x * __builtin_amdgcn_rcpf(1.f + __expf(-t)); }
DEV float wave_sum(float v) {
#pragma unroll
    for (int o = 1; o < 64; o <<= 1) v += __shfl_xor(v, o);
    return v;
}
#define LDS_WAIT() asm volatile("s_waitcnt lgkmcnt(0)" ::: "memory")
#define LBAR() do { asm volatile("s_waitcnt lgkmcnt(0)" ::: "memory"); __builtin_amdgcn_s_barrier(); asm volatile("" ::: "memory"); } while (0)
DEV void unpack8(const u32x4 w, float (&f)[8]) { f[0] = bf_lo(w.x); f[1] = bf_hi(w.x); f[2] = bf_lo(w.y); f[3] = bf_hi(w.y); f[4] = bf_lo(w.z); f[5] = bf_hi(w.z); f[6] = bf_lo(w.w); f[7] = bf_hi(w.w); }
DEV u32x4 pack8(const float (&f)[8]) { u32x4 w; w.x = cvt_pk_bf16(f[0], f[1]); w.y = cvt_pk_bf16(f[2], f[3]); w.z = cvt_pk_bf16(f[4], f[5]); w.w = cvt_pk_bf16(f[6], f[7]); return w; }
DEV f32x4 mfma16(bf16x8 a, bf16x8 b, f32x4 c) { return __builtin_amdgcn_mfma_f32_16x16x32_bf16(a, b, c, 0, 0, 0); }

DEV int prow(int n, int ln) { return 8 * (ln >> 2) + 4 * n + (ln & 3); }
DEV u32x4 pack8v(const f32x4 a, const f32x4 b) { u32x4 w; w.x = cvt_pk_bf16(a[0], a[1]); w.y = cvt_pk_bf16(a[2], a[3]); w.z = cvt_pk_bf16(b[0], b[1]); w.w = cvt_pk_bf16(b[2], b[3]); return w; }
DEV float row_rstd(const float* rs, int row, int fq) {
    const f32x4 p = *(const f32x4*)(rs + (size_t)row * 16 + fq * 4); float s = (p.x + p.y) + (p.z + p.w);
    s += __shfl_xor(s, 16); s += __shfl_xor(s, 32); return rsqrtf(s * (1.f / D) + EPS);
}
template <bool FUSED> struct EpiSwiGLU {
    static constexpr bool PERM = true, AFTER_DRAIN = false;
    bf16_t* H; const float* rs; const float* shw;
    DEV void operator()(const f32x4 (&acc)[2][2][4][2], const Unit& u, int wr, int wc, int fr, int fq) const {
        asm volatile("" : "+v"(fr), "+v"(fq));
        const int row0 = u.pm * 256 + wr * 64 + fr, col0 = u.pn * 128 + wc * 32 + 8 * fq;
        f32x4 sg[2], su[2];
        if (FUSED) { const int b = u.pm >> 4; const float* sp = shw + (size_t)b * NFF2 + u.pn * 256 + wc * 32 + 8 * fq;
            sg[0] = *(const f32x4*)sp; sg[1] = *(const f32x4*)(sp + 4); su[0] = *(const f32x4*)(sp + 128); su[1] = *(const f32x4*)(sp + 132); }
#pragma unroll
        for (int ai = 0; ai < 2; ++ai)
#pragma unroll
            for (int m = 0; m < 4; ++m) {
                const int row = row0 + ai * 128 + m * 16;
                float rstd = 1.f; if (FUSED) rstd = row_rstd(rs, row, fq);
                float h[8];
#pragma unroll
                for (int n = 0; n < 2; ++n)
#pragma unroll
                    for (int j = 0; j < 4; ++j) { float g = acc[ai][0][m][n][j], up = acc[ai][1][m][n][j]; if (FUSED) { g = g * rstd + sg[n][j]; up = up * rstd + su[n][j]; } h[4 * n + j] = silu_f(g) * up; }
                *(u32x4*)(H + (size_t)row * DFF + col0) = pack8(h);
            }
    }
};
template <int GATE_I, bool HALF, bool WITH_XN, int SCALE_I> struct EpiResid {
    static constexpr bool PERM = WITH_XN, AFTER_DRAIN = false; static constexpr int NS = PERM ? 4 : 16;
    const float* res_lat; const float* res_ctx; float* out_lat; float* out_ctx; const float* mod;
    bf16_t* xn; const float* g; float* rs;
    static constexpr int gate_i = GATE_I, scale_i = SCALE_I; static constexpr float coef = HALF ? 0.5f : 1.0f; static constexpr bool has_xn = WITH_XN;
    DEV void operator()(const f32x4 (&acc)[2][2][4][2], const Unit& u, int wr, int wc, int fr, int fq) const {
        asm volatile("" : "+v"(fr), "+v"(fq));
        const bool lat = u.pm < MLAT / 256; const int b = lat ? (u.pm >> 4) : 16;
        const float* res = lat ? res_lat : res_ctx; float* out = lat ? out_lat : out_ctx;
        const int grow0 = u.pm * 256 + wr * 64 + fr, row0 = (lat ? grow0 : grow0 - MLAT), col0 = u.pn * 256 + wc * 32 + (PERM ? 8 : 4) * fq;
        float ss[8];
#pragma unroll
        for (int i = 0; i < 8; ++i) ss[i] = 0.f;
#pragma unroll
        for (int bj = 0; bj < 2; ++bj) {
            f32x4 gv[2], gs[2];
#pragma unroll
            for (int n = 0; n < 2; ++n) { gv[n] = *(const f32x4*)(mod + (size_t)b * NMOD + gate_i * D + col0 + bj * 128 + NS * n) * coef;
                if (has_xn) gs[n] = *(const f32x4*)(g + col0 + bj * 128 + 4 * n) * (*(const f32x4*)(mod + (size_t)b * NMOD + scale_i * D + col0 + bj * 128 + 4 * n) + 1.f); }
#pragma unroll
            for (int ai = 0; ai < 2; ++ai)
#pragma unroll
                for (int m = 0; m < 4; ++m) {
                    const size_t p = (size_t)(row0 + ai * 128 + m * 16) * D + col0 + bj * 128;
                    const f32x4 r0 = *(const f32x4*)(res + p), r1 = *(const f32x4*)(res + p + NS);
                    const f32x4 o0 = r0 + gv[0] * acc[ai][bj][m][0], o1 = r1 + gv[1] * acc[ai][bj][m][1];
                    *(f32x4*)(out + p) = o0; *(f32x4*)(out + p + NS) = o1;
                    if (has_xn) { ss[ai * 4 + m] += (o0[0] * o0[0] + o0[1] * o0[1]) + (o0[2] * o0[2] + o0[3] * o0[3]) + (o1[0] * o1[0] + o1[1] * o1[1]) + (o1[2] * o1[2] + o1[3] * o1[3]);
                        *(u32x4*)(xn + (size_t)(grow0 + ai * 128 + m * 16) * D + col0 + bj * 128) = pack8v(o0 * gs[0], o1 * gs[1]); }
                }
        }
        if (has_xn) {
#pragma unroll
            for (int i = 0; i < 8; ++i) { float v = ss[i]; v += __shfl_xor(v, 16); v += __shfl_xor(v, 32); if (fq == 0) rs[(size_t)(grow0 + (i >> 2) * 128 + (i & 3) * 16) * 16 + u.pn * 4 + wc] = v; }
        }
    }
};
struct EpiZ {
    static constexpr bool PERM = true, AFTER_DRAIN = false;
    bf16_t* Z; float* rowss; const float* rs; const float* shw;
    DEV void operator()(const f32x4 (&acc)[2][2][4][2], const Unit& u, int wr, int wc, int fr, int fq) const {
        asm volatile("" : "+v"(fr), "+v"(fq));
        const int pn = u.pn; const int act = (pn < 4 || pn >= 10) ? 0 : (pn < 6 ? 1 : 2); const bool stat = (pn == 8 || pn == 9);
        const int row0 = u.pm * 256 + wr * 64 + fr, col0 = pn * 256 + wc * 32 + 8 * fq; const int b = u.pm < MLAT / 256 ? (u.pm >> 4) : 16;
        f32x4 sw[2][2];
#pragma unroll
        for (int bj = 0; bj < 2; ++bj)
#pragma unroll
            for (int n = 0; n < 2; ++n) sw[bj][n] = *(const f32x4*)(shw + (size_t)b * ZW + col0 + bj * 128 + 4 * n);
#pragma unroll
        for (int ai = 0; ai < 2; ++ai)
#pragma unroll
            for (int m = 0; m < 4; ++m) {
                const int row = row0 + ai * 128 + m * 16; float ss = 0.f; const float rstd = row_rstd(rs, row, fq);
#pragma unroll
                for (int bj = 0; bj < 2; ++bj) {
                    float v[8];
#pragma unroll
                    for (int n = 0; n < 2; ++n)
#pragma unroll
                        for (int j = 0; j < 4; ++j) { float x = acc[ai][bj][m][n][j] * rstd + sw[bj][n][j]; if (act == 1) x = silu_f(x); else if (act == 2) x = gelu_f(x); v[4 * n + j] = x; ss += x * x; }
                    *(u32x4*)(Z + (size_t)row * ZW + col0 + bj * 128) = pack8(v);
                }
                if (stat) { ss += __shfl_xor(ss, 16); ss += __shfl_xor(ss, 32); if (fq == 0) rowss[(size_t)row * 8 + (pn - 8) * 4 + wc] = ss; }
            }
    }
};

struct Args { const float* in[25]; float* out; unsigned char* ws; int ph_lo, ph_hi; };
enum { I_X = 0, I_C, I_CTX, I_CCTX, I_WADA, I_BADA, I_N1G, I_FF1IN, I_FF1OUT, I_N2G, I_WIN, I_CONVW, I_WGF, I_BGF, I_WGB, I_BGB, I_GLAG, I_CMG, I_WS, I_BS, I_WOUT, I_N3G, I_FF2IN, I_FF2OUT, I_FING };

DEV void transpose_item(const float* W, int K, int N, bf16_t* WT, int n0, int drow0, int k0, float* scr, int lane) {
    float tv[32];
#pragma unroll
    for (int i = 0; i < 32; ++i) tv[i] = W[(size_t)(k0 + 2 * i + (lane >> 5)) * N + n0 + (lane & 31)];
#pragma unroll
    for (int i = 0; i < 32; ++i) scr[(2 * i + (lane >> 5)) * 33 + (lane & 31)] = tv[i];
    LDS_WAIT();
    const int c = lane & 7;
#pragma unroll
    for (int j = 0; j < 4; ++j) { const int n = (lane >> 3) + 8 * j; const float* s = scr + (8 * c) * 33 + n;
        u32x4 o; o.x = cvt_pk_bf16(s[0 * 33], s[1 * 33]); o.y = cvt_pk_bf16(s[2 * 33], s[3 * 33]); o.z = cvt_pk_bf16(s[4 * 33], s[5 * 33]); o.w = cvt_pk_bf16(s[6 * 33], s[7 * 33]);
        *(u32x4*)(WT + (size_t)(drow0 + n) * K + k0 + 8 * c) = o; }
    LDS_WAIT();
}
DEV int ffin_rowmap(int n0) { const int up = n0 >= DFF, j = up ? n0 - DFF : n0; return (j >> 7) * 256 + up * 128 + (j & 127); }
DEV int win_rowmap(int n0) { return n0 < 1024 ? n0 : (n0 < 1056 ? n0 - 1024 + ZC_GLR : n0 - 1056 + ZC_OG); }
DEV void p0_prep(const Args& a, unsigned char* lds, int gw, int NGW, int wave, int lane) {
    unsigned char* ws = a.ws;
    float* scr = (float*)(lds + wave * 16384);
    constexpr int I_A = (D / 64) * (NFF2 / 32), I_B = (DFF / 64) * (D / 32), I_IN = (D / 64) * (2592 / 32), I_O = (D / 64) * (D / 32), I_ADA = (NMOD / 16) * 8;
    constexpr int NIT = 2 * I_A + 2 * I_B + I_IN + I_O + I_ADA;
    for (int it = gw; it < NIT; it += NGW) {
        int r = it;
        if (r < I_ADA) {
            const int cgi = r % (NMOD / 16), kc = r / (NMOD / 16), n0 = cgi * 16, k0 = kc * 128, col = lane & 15, kq = lane >> 4;
            for (int idx = lane; idx < 17 * 128; idx += 64) { const int b = idx >> 7, k = idx & 127; const float cv = (b < 16) ? a.in[I_C][b * D + k0 + k] : a.in[I_CCTX][k0 + k]; scr[idx] = silu_f(cv); }
            const float* wp = a.in[I_WADA] + (size_t)(k0 + kq * 32) * NMOD + n0 + col;
            float acc[17];
#pragma unroll
            for (int b = 0; b < 17; ++b) acc[b] = 0.f;
            LDS_WAIT();
#pragma unroll 1
            for (int kb = 0; kb < 2; ++kb) {
                float wv[16];
#pragma unroll
                for (int kk = 0; kk < 16; ++kk) wv[kk] = wp[(size_t)(kb * 16 + kk) * NMOD];
#pragma unroll
                for (int kk = 0; kk < 16; ++kk) {
#pragma unroll
                    for (int b = 0; b < 17; ++b) acc[b] += scr[b * 128 + kq * 32 + kb * 16 + kk] * wv[kk]; }
            }
            LDS_WAIT();
            float* mod = (float*)(ws + WS_MOD);
            const float bias = (kc == 0) ? a.in[I_BADA][n0 + col] : 0.f;
#pragma unroll
            for (int b = 0; b < 17; ++b) { float v = acc[b]; v += __shfl_xor(v, 16); v += __shfl_xor(v, 32); if (kq == 0) atomicAdd(mod + b * NMOD + n0 + col, v + bias); }
            continue;
        }
        r -= I_ADA;
        if (r < I_A) { const int nb = r % (NFF2 / 32), kb = r / (NFF2 / 32); transpose_item(a.in[I_FF1IN], D, NFF2, (bf16_t*)(ws + WS_W1A), nb * 32, ffin_rowmap(nb * 32), kb * 64, scr, lane); continue; } r -= I_A;
        if (r < I_A) { const int nb = r % (NFF2 / 32), kb = r / (NFF2 / 32); transpose_item(a.in[I_FF2IN], D, NFF2, (bf16_t*)(ws + WS_W2A), nb * 32, ffin_rowmap(nb * 32), kb * 64, scr, lane); continue; } r -= I_A;
        if (r < I_B) { const int nb = r % (D / 32), kb = r / (D / 32); transpose_item(a.in[I_FF1OUT], DFF, D, (bf16_t*)(ws + WS_W1B), nb * 32, nb * 32, kb * 64, scr, lane); continue; } r -= I_B;
        if (r < I_B) { const int nb = r % (D / 32), kb = r / (D / 32); transpose_item(a.in[I_FF2OUT], DFF, D, (bf16_t*)(ws + WS_W2B), nb * 32, nb * 32, kb * 64, scr, lane); continue; } r -= I_B;
        if (r < I_IN) { const int nb = r % (2592 / 32), kb = r / (2592 / 32); transpose_item(a.in[I_WIN], D, 2592, (bf16_t*)(ws + WS_WIN), nb * 32, win_rowmap(nb * 32), kb * 64, scr, lane); continue; } r -= I_IN;
        { const int nb = r % (D / 32), kb = r / (D / 32); transpose_item(a.in[I_WOUT], D, D, (bf16_t*)(ws + WS_WOUT), nb * 32, nb * 32, kb * 64, scr, lane); }
    }
    const int gt = gw * 64 + lane, NGT = NGW * 64;
    for (int i = gt; i < 8 * 128 * 128 / 2; i += NGT) { const float2 v = ((const float2*)a.in[I_WS])[i]; ((unsigned*)(ws + WS_WS))[i] = cvt_pk_bf16(v.x, v.y); }
    for (int i = gt; i < (ZW - 2592) * D / 2; i += NGT) ((unsigned*)(ws + WS_WIN + (size_t)2592 * D * 2))[i] = 0u;
}

DEV void norm_mod_phase(const float* src_lat, const float* src_ctx, int nrows, const float* g, const float* mod, int shift_i, int scale_i, bf16_t* XN, int gw, int NGW, int lane) {
    for (int row = 2 * gw; row < nrows; row += 2 * NGW) {
        const bool lat = row < MLAT; const int b = lat ? (row >> 12) : 16;
        const f32x4* xr = (const f32x4*)(lat ? src_lat + (size_t)row * D : src_ctx + (size_t)(row - MLAT) * D) + lane;
        f32x4 v[2][4], gm[4], sh[4];
#pragma unroll
        for (int r = 0; r < 2; ++r)
#pragma unroll
            for (int j = 0; j < 4; ++j) v[r][j] = __builtin_nontemporal_load(&xr[r * 256 + 64 * j]);
        const f32x4* gp = (const f32x4*)g + lane; const f32x4* scp = (const f32x4*)(mod + (size_t)b * NMOD + scale_i * D) + lane; const f32x4* shp = (const f32x4*)(mod + (size_t)b * NMOD + shift_i * D) + lane;
#pragma unroll
        for (int j = 0; j < 4; ++j) { gm[j] = gp[64 * j] * (scp[64 * j] + 1.f); sh[j] = shp[64 * j]; }
#pragma unroll
        for (int r = 0; r < 2; ++r) {
            float s = 0.f;
#pragma unroll
            for (int j = 0; j < 4; ++j) s += (v[r][j].x * v[r][j].x + v[r][j].y * v[r][j].y) + (v[r][j].z * v[r][j].z + v[r][j].w * v[r][j].w);
            const float rstd = rsqrtf(wave_sum(s) * (1.f / D) + EPS);
            u32x2* o8 = (u32x2*)(XN + (size_t)(row + r) * D) + lane;
#pragma unroll
            for (int j = 0; j < 4; ++j) { const f32x4 y = (v[r][j] * rstd) * gm[j] + sh[j]; u32x2 w; w.x = cvt_pk_bf16(y.x, y.y); w.y = cvt_pk_bf16(y.z, y.w); o8[64 * j] = w; }
        }
    }
}
DEV void final_norm_phase(float* xo, const float* g, int gw, int NGW, int lane) {
    const f32x4* gp = (const f32x4*)g + lane;
    f32x4 gm[4];
#pragma unroll
    for (int j = 0; j < 4; ++j) gm[j] = gp[64 * j];
    for (int vr = 2 * gw; vr < MLAT; vr += 2 * NGW) {
        const int rnd = 3 - (vr >> 14), wv = vr & 16383, row = (((wv >> 11) * 32 + rnd * 8 + ((wv >> 8) & 7)) << 8) + (wv & 255);
        f32x4* xr = (f32x4*)(xo + (size_t)row * D) + lane;
        f32x4 v[2][4];
#pragma unroll
        for (int r = 0; r < 2; ++r)
#pragma unroll
            for (int j = 0; j < 4; ++j) v[r][j] = xr[r * 256 + 64 * j];
#pragma unroll
        for (int r = 0; r < 2; ++r) {
            float s = 0.f;
#pragma unroll
            for (int j = 0; j < 4; ++j) s += (v[r][j].x * v[r][j].x + v[r][j].y * v[r][j].y) + (v[r][j].z * v[r][j].z + v[r][j].w * v[r][j].w);
            const float rstd = rsqrtf(wave_sum(s) * (1.f / D) + EPS);
#pragma unroll
            for (int j = 0; j < 4; ++j) __builtin_nontemporal_store((v[r][j] * rstd) * gm[j], &xr[r * 256 + 64 * j]);
        }
    }
}

DEV void shiftw_phase(const bf16_t* Wt, int N, const float* mod, int shift_i, float* shw, int gw, int NGW, int lane) {
    for (int n = gw; n < N; n += NGW) {
        float wv[16]; { float f[8]; unpack8(*(const u32x4*)(Wt + (size_t)n * D + lane * 16), f);
#pragma unroll
            for (int j = 0; j < 8; ++j) wv[j] = f[j];
            unpack8(*(const u32x4*)(Wt + (size_t)n * D + lane * 16 + 8), f);
#pragma unroll
            for (int j = 0; j < 8; ++j) wv[8 + j] = f[j]; }
        float mine = 0.f;
#pragma unroll 6
        for (int b = 0; b < 17; ++b) {
            const f32x4* sp = (const f32x4*)(mod + (size_t)b * NMOD + shift_i * D + lane * 16); float s = 0.f;
#pragma unroll
            for (int q = 0; q < 4; ++q) { const f32x4 v = sp[q]; s += (v.x * wv[4 * q] + v.y * wv[4 * q + 1]) + (v.z * wv[4 * q + 2] + v.w * wv[4 * q + 3]); }
            s = wave_sum(s); if (lane == b) mine = s;
        }
        if (lane < 17) shw[(size_t)lane * N + n] = mine;
    }
}

DEV void conv_phase(const bf16_t* Z, const float* cw, bf16_t* QKV, int G) {
    const int gt = blockIdx.x * 512 + threadIdx.x, cgi = gt & 127, ch0 = cgi * 8;
    float w[9][8];
#pragma unroll
    for (int t = 0; t < 9; ++t) { const f32x4 a = *(const f32x4*)(cw + t * 1024 + ch0), b = *(const f32x4*)(cw + t * 1024 + ch0 + 4); w[t][0] = a.x; w[t][1] = a.y; w[t][2] = a.z; w[t][3] = a.w; w[t][4] = b.x; w[t][5] = b.y; w[t][6] = b.z; w[t][7] = b.w; }
    const float qs = (ch0 < 256) ? 0.125f : 1.f;
    const u32x4 zero4 = {0u, 0u, 0u, 0u};
    for (int sid = gt >> 7; sid < NB * 64; sid += (G * 512) >> 7) {
        const int cc = sid & 63, b = sid >> 6; const bool hasL = cc > 0, hasR = cc < 63;
        const bf16_t* zp = Z + (size_t)(b * SEQ + cc) * ZW + ch0;
        bf16_t* op = QKV + (size_t)(b * SEQ + cc) * D + ch0;
        float win[3][3][8];
        u32x4 raw[3];
#define CV_LOAD(r_) do { const bf16_t* q_ = zp + (size_t)(r_) * 64 * ZW; const bool v_ = (r_) < 64; \
        raw[0] = (v_ && hasL) ? *(const u32x4*)(q_ - ZW) : zero4; raw[1] = v_ ? *(const u32x4*)q_ : zero4; raw[2] = (v_ && hasR) ? *(const u32x4*)(q_ + ZW) : zero4; } while (0)
#define CV_UNPACK(slot_) do { unpack8(raw[0], win[slot_][0]); unpack8(raw[1], win[slot_][1]); unpack8(raw[2], win[slot_][2]); } while (0)
#define CV_STEP(r_, top_, mid_, bot_) do { if ((r_) < 64) { float acc[8]; \
        _Pragma("unroll") for (int j = 0; j < 8; ++j) { float s_ = 0.f; \
            _Pragma("unroll") for (int dx = 0; dx < 3; ++dx) s_ += w[dx][j] * win[top_][dx][j] + w[3 + dx][j] * win[mid_][dx][j] + w[6 + dx][j] * win[bot_][dx][j]; \
            acc[j] = silu_f(s_) * qs; } \
        *(u32x4*)(op + (size_t)(r_) * 64 * D) = pack8(acc); \
        CV_UNPACK(top_); CV_LOAD((r_) + 3); } } while (0)
#pragma unroll
        for (int dx = 0; dx < 3; ++dx)
#pragma unroll
            for (int j = 0; j < 8; ++j) win[2][dx][j] = 0.f;
        CV_LOAD(0); CV_UNPACK(0); CV_LOAD(1); CV_UNPACK(1); CV_LOAD(2);
        for (int r = 0; r < 66; r += 3) { CV_STEP(r, 2, 0, 1); CV_STEP(r + 1, 0, 1, 2); CV_STEP(r + 2, 1, 2, 0); }
#undef CV_LOAD
#undef CV_UNPACK
#undef CV_STEP
    }
    for (int row = MLAT + (gt >> 7); row < MALL; row += (G * 512) >> 7) {
        float acc[8];
#pragma unroll
        for (int j = 0; j < 8; ++j) acc[j] = 0.f;
        const int t = (row - MLAT) & 255;
#pragma unroll
        for (int dx = -1; dx <= 1; ++dx) { const int t2 = t + dx;
            if (t2 >= 0 && t2 < 256) { float f[8]; unpack8(*(const u32x4*)(Z + (size_t)(row + dx) * ZW + ch0), f);
#pragma unroll
                for (int j = 0; j < 8; ++j) acc[j] += w[3 + dx + 1][j] * f[j]; } }
#pragma unroll
        for (int j = 0; j < 8; ++j) acc[j] = silu_f(acc[j]) * qs;
        *(u32x4*)(QKV + (size_t)row * D + ch0) = pack8(acc);
    }
}

constexpr int L_GLR = 0, L_B = 8192, BP = 68, L_TOT = L_B + 2 * 64 * BP * 4, L_Q = L_TOT + 2048, QP = 72, L_K = L_Q + 2 * 64 * QP * 2, L_KHT = L_K + 2 * 64 * QP * 2, L_VT = L_KHT + 2 * 64 * QP * 2,
              L_P = L_VT + 128 * QP * 2, PP = 136, L_G1END = L_P + 64 * PP * 2;
static_assert(L_G1END <= LDS_BYTES, "G1 LDS");
DEV void gla_unit_rows(int u, int& b, int& c, int& h, int& row0) {
    if (u < NU_LAT) { b = u >> 8; c = (u >> 2) & 63; h = u & 3; row0 = b * SEQ + c * 64; }
    else { const int v = u - NU_LAT; b = v >> 4; c = (v >> 2) & 3; h = v & 3; row0 = MLAT + b * CTXL + c * 64; }
}
DEV void g1_phase(const Args& a, unsigned char* lds, int G) {
    unsigned char* ws = a.ws;
    const bf16_t* Z = (const bf16_t*)(ws + WS_ZH); const bf16_t* QKV = (const bf16_t*)(ws + WS_XN);
    bf16_t* QT = (bf16_t*)(ws + WS_QT); bf16_t* OI = (bf16_t*)(ws + WS_OI); bf16_t* KV = (bf16_t*)(ws + WS_KV); float* DEC = (float*)(ws + WS_DEC);
    const int t = threadIdx.x, lane = t & 63, w = t >> 6, ln = lane & 15, kg = lane >> 4;
    float* sB = (float*)(lds + L_B);
    bf16_t* sQ = (bf16_t*)(lds + L_Q); bf16_t* sK = (bf16_t*)(lds + L_K); bf16_t* sKhT = (bf16_t*)(lds + L_KHT); bf16_t* sVT = (bf16_t*)(lds + L_VT); bf16_t* sP = (bf16_t*)(lds + L_P);
    const int gdir = w >> 2, dkt = w & 3;
#define G1_LOAD(u_) do { int b_, c_, h_, r_; gla_unit_rows((u_), b_, c_, h_, r_); \
        _Pragma("unroll") for (int pt = 0; pt < 4; ++pt) gfn[pt] = (kg < 2) ? *(const u32x4*)(Z + (size_t)(r_ + pt * 16 + ln) * ZW + ZC_GLR + gdir * 16 + kg * 8) : (u32x4){0u, 0u, 0u, 0u}; \
        const bf16_t* qp_ = QKV + (size_t)(r_ + (t & 63)) * D + (t >> 6) * 8; \
        qn = *(const u32x4*)(qp_ + h_ * 64); kn = *(const u32x4*)(qp_ + 256 + h_ * 64); vn0 = *(const u32x4*)(qp_ + 512 + h_ * 128); vn1 = *(const u32x4*)(qp_ + 512 + h_ * 128 + 64); } while (0)
#define G1_WLOAD(h_) do { const float* wg_ = a.in[gdir ? I_WGB : I_WGF] + (h_) * 64 + dkt * 16 + ln; float wv_[8]; \
        _Pragma("unroll") for (int j = 0; j < 8; ++j) wv_[j] = (kg < 2) ? wg_[(kg * 8 + j) * 256] : 0.f; \
        const u32x4 wp_ = pack8(wv_); wfrag = __builtin_bit_cast(bf16x8, wp_); bias4 = *(const f32x4*)(a.in[gdir ? I_BGB : I_BGF] + (h_) * 64 + dkt * 16 + kg * 4); } while (0)
#define DPP_SHR(x_, n_) __builtin_bit_cast(float, __builtin_amdgcn_update_dpp(0, __builtin_bit_cast(int, (x_)), 0x110 | (n_), 0xf, 0xf, true))
    u32x4 qn, kn, vn0, vn1, gfn[4];
    if ((int)blockIdx.x < NU_ALL) G1_LOAD((int)blockIdx.x);
    bf16x8 wfrag; f32x4 bias4; int hcur = blockIdx.x & 3;
    G1_WLOAD(hcur);
    for (int u = blockIdx.x; u < NU_ALL; u += G) {
        int b, c, h, row0; gla_unit_rows(u, b, c, h, row0); const bool lat = u < NU_LAT;
        if (h != hcur) { hcur = h; G1_WLOAD(h); }
        const int pos = t & 63, g8 = t >> 6;
        const u32x4 qraw = qn, kraw = kn, vraw0 = vn0, vraw1 = vn1;
        u32x4 gf[4];
#pragma unroll
        for (int pt = 0; pt < 4; ++pt) gf[pt] = gfn[pt];
        if (u + G < NU_ALL) G1_LOAD(u + G);
        {
            float gl[4][4], cs[4][4], tot[4];
#pragma unroll
            for (int pt = 0; pt < 4; ++pt) {
                f32x4 pre = mfma16(wfrag, __builtin_bit_cast(bf16x8, gf[pt]), bias4);
#pragma unroll
                for (int r = 0; r < 4; ++r) { const float x = pre[r]; const float ls = (fminf(x, 0.f) - __logf(1.f + __expf(-fabsf(x)))) * (1.f / 16.f); gl[pt][r] = ls;
                    float sc = ls; sc += DPP_SHR(sc, 1); sc += DPP_SHR(sc, 2); sc += DPP_SHR(sc, 4); sc += DPP_SHR(sc, 8); cs[pt][r] = sc; }
            }
#pragma unroll
            for (int r = 0; r < 4; ++r) { float off = 0.f;
#pragma unroll
                for (int pt = 0; pt < 4; ++pt) { const float tt = __shfl(cs[pt][r], (lane & 48) | 15); cs[pt][r] += off; off += tt; }
                tot[r] = off; }
            if (gdir) {
#pragma unroll
                for (int pt = 0; pt < 4; ++pt)
#pragma unroll
                    for (int r = 0; r < 4; ++r) cs[pt][r] = tot[r] - cs[pt][r] + gl[pt][r];
            }
#pragma unroll
            for (int pt = 0; pt < 4; ++pt) *(f32x4*)(sB + (gdir * 64 + pt * 16 + ln) * BP + dkt * 16 + kg * 4) = (f32x4){cs[pt][0], cs[pt][1], cs[pt][2], cs[pt][3]};
            if (ln == 15) *(f32x4*)(DEC + ((size_t)u * 2 + gdir) * 64 + dkt * 16 + kg * 4) = (f32x4){__expf(tot[0]), __expf(tot[1]), __expf(tot[2]), __expf(tot[3])};
        }
        LBAR();
        {
            float q[8], k[8]; unpack8(qraw, q); unpack8(kraw, k);
            const unsigned tsel = (lane & 1) ? 0x03020706u : 0x05040100u;
#pragma unroll
            for (int dir = 0; dir < 2; ++dir) {
                const float* bp = sB + (dir * 64 + pos) * BP + g8 * 8; const float* bl = sB + (dir * 64 + (dir ? 0 : 63)) * BP + g8 * 8;
                const f32x4 b0 = *(const f32x4*)bp, b1 = *(const f32x4*)(bp + 4), l0 = *(const f32x4*)bl, l1 = *(const f32x4*)(bl + 4);
                float qt[8], kt[8], kh[8];
#pragma unroll
                for (int j = 0; j < 8; ++j) { const float bb = j < 4 ? b0[j] : b1[j - 4], ll = j < 4 ? l0[j] : l1[j - 4]; qt[j] = q[j] * __expf(bb); kt[j] = k[j] * __expf(-bb); kh[j] = k[j] * __expf(ll - bb); }
                const u32x4 qw = pack8(qt), kw = pack8(kt), hw = pack8(kh);
                *(u32x4*)(sQ + (dir * 64 + pos) * QP + g8 * 8) = qw;
                *(u32x4*)(sK + (dir * 64 + pos) * QP + g8 * 8) = kw;
                { unsigned* kp = (unsigned*)(sKhT + (dir * 64 + g8 * 8 + (lane & 1)) * QP + (pos & ~1));
#pragma unroll
                  for (int d = 0; d < 4; ++d) { const unsigned own = hw[d], oth = (unsigned)__builtin_amdgcn_update_dpp(0, (int)own, 0xB1, 0xf, 0xf, true);
                      kp[d * QP] = __builtin_amdgcn_perm(oth, own, tsel); } }
            }
#pragma unroll
            for (int i = 0; i < 2; ++i) { const u32x4 vw = i ? vraw1 : vraw0; unsigned* vp = (unsigned*)(sVT + ((g8 + 8 * i) * 8 + (lane & 1)) * QP + (pos & ~1));
#pragma unroll
                for (int d = 0; d < 4; ++d) { const unsigned own = vw[d], oth = (unsigned)__builtin_amdgcn_update_dpp(0, (int)own, 0xB1, 0xf, 0xf, true);
                    vp[d * QP] = __builtin_amdgcn_perm(oth, own, tsel); } }
        }
        LBAR();
        if (lat) {
            const int p2 = t >> 3, g2 = (t & 7) * 8;
#pragma unroll
            for (int dir = 0; dir < 2; ++dir) *(u32x4*)(QT + (size_t)(row0 + p2) * 512 + dir * 256 + h * 64 + g2) = *(const u32x4*)(sQ + (dir * 64 + p2) * QP + g2);
        }
        {
            const int dir = w >> 2, it = w & 3;
            bf16x8 qf[2];
#pragma unroll
            for (int ks = 0; ks < 2; ++ks) qf[ks] = *(const bf16x8*)(sQ + (dir * 64 + it * 16 + ln) * QP + ks * 32 + kg * 8);
#pragma unroll
            for (int jt = 0; jt < 4; ++jt) {
                f32x4 acc = {0.f, 0.f, 0.f, 0.f};
                const bool live = dir ? (jt >= it) : (jt <= it);
                if (live) {
#pragma unroll
                    for (int ks = 0; ks < 2; ++ks) { const bf16x8 kf = *(const bf16x8*)(sK + (dir * 64 + jt * 16 + ln) * QP + ks * 32 + kg * 8); acc = mfma16(kf, qf[ks], acc); }
                }
                const int i = it * 16 + ln, j0 = jt * 16 + kg * 4;
                float pv[4];
#pragma unroll
                for (int r = 0; r < 4; ++r) { const int j = j0 + r; const bool keep = dir ? (j >= i) : (j <= i); pv[r] = keep ? acc[r] : 0.f; }
                u32x2 pw; pw.x = cvt_pk_bf16(pv[0], pv[1]); pw.y = cvt_pk_bf16(pv[2], pv[3]);
                *(u32x2*)(sP + i * PP + dir * 64 + j0) = pw;
            }
        }
        LBAR();
        if (lat) {
            const int it = w & 3, half = w >> 2;
            f32x4 acc[4];
#pragma unroll
            for (int d = 0; d < 4; ++d) acc[d] = (f32x4){0.f, 0.f, 0.f, 0.f};
#pragma unroll
            for (int ks = 0; ks < 4; ++ks) {
                const bf16x8 pf = *(const bf16x8*)(sP + (it * 16 + ln) * PP + ks * 32 + kg * 8);
#pragma unroll
                for (int d = 0; d < 4; ++d) { const bf16x8 vf = *(const bf16x8*)(sVT + (half * 64 + (d >> 1) * 32 + prow(d & 1, ln)) * QP + (ks & 1) * 32 + kg * 8); acc[d] = mfma16(vf, pf, acc[d]); }
            }
#pragma unroll
            for (int p = 0; p < 2; ++p) *(u32x4*)(OI + (size_t)(row0 + it * 16 + ln) * 512 + h * 128 + half * 64 + p * 32 + kg * 8) = pack8v(acc[2 * p], acc[2 * p + 1]);
        }
        {
            const int dir = w >> 2;
#pragma unroll
            for (int e = 0; e < 2; ++e) {
                const int dvt = (w & 3) * 2 + e;
                bf16x8 vf[2];
#pragma unroll
                for (int ks = 0; ks < 2; ++ks) vf[ks] = *(const bf16x8*)(sVT + (dvt * 16 + ln) * QP + ks * 32 + kg * 8);
#pragma unroll
                for (int p = 0; p < 2; ++p) {
                    f32x4 acc[2];
#pragma unroll
                    for (int n = 0; n < 2; ++n) { acc[n] = (f32x4){0.f, 0.f, 0.f, 0.f};
#pragma unroll
                        for (int ks = 0; ks < 2; ++ks) { const bf16x8 kf = *(const bf16x8*)(sKhT + (dir * 64 + p * 32 + prow(n, ln)) * QP + ks * 32 + kg * 8); acc[n] = mfma16(kf, vf[ks], acc[n]); } }
                    *(u32x4*)(KV + (((size_t)u * 2 + dir) * 128 + dvt * 16 + ln) * 64 + p * 32 + kg * 8) = pack8v(acc[0], acc[1]);
                }
            }
        }
        LBAR();
    }
}

DEV void g2_phase(const Args& a, int G) {
    unsigned char* ws = a.ws;
    const bf16_t* KV = (const bf16_t*)(ws + WS_KV); const float* DEC = (const float*)(ws + WS_DEC); bf16_t* SB = (bf16_t*)(ws + WS_SB);
    for (int gt = blockIdx.x * 512 + threadIdx.x; gt < 128 * 1024; gt += G * 512) {
        const int s = gt >> 10, rem = gt & 1023, dv = rem >> 3, k8 = (rem & 7) * 8;
        const int b = s >> 3, h = (s >> 1) & 3, dir = s & 1;
        float S[8];
#pragma unroll
        for (int j = 0; j < 8; ++j) S[j] = 0.f;
#pragma unroll 1
        for (int blk = 0; blk < 17; ++blk) {
            u32x4 kvr[4]; f32x4 d0[4], d1[4]; size_t offs[4];
#pragma unroll
            for (int i = 0; i < 4; ++i) {
                const int step = blk * 4 + i; int u;
                if (step < 4) { const int c = dir ? 3 - step : step; u = NU_LAT + b * 16 + c * 4 + h; }
                else { const int c = dir ? 67 - step : step - 4; u = b * 256 + c * 4 + h; }
                offs[i] = (((size_t)u * 2 + dir) * 128 + dv) * 64 + k8;
                kvr[i] = *(const u32x4*)(KV + offs[i]);
                const float* dp = DEC + ((size_t)u * 2 + dir) * 64 + k8; d0[i] = *(const f32x4*)dp; d1[i] = *(const f32x4*)(dp + 4);
            }
#pragma unroll
            for (int i = 0; i < 4; ++i) {
                if (blk > 0) *(u32x4*)(SB + offs[i]) = pack8(S);
                float kv[8]; unpack8(kvr[i], kv);
#pragma unroll
                for (int j = 0; j < 8; ++j) S[j] = (j < 4 ? d0[i][j] : d1[i][j - 4]) * S[j] + kv[j];
            }
        }
    }
}

DEV void g3c1_phase(const Args& a, unsigned char* lds, int G) {
    unsigned char* ws = a.ws;
    const bf16_t* Z = (const bf16_t*)(ws + WS_ZH); const bf16_t* QT = (const bf16_t*)(ws + WS_QT); const bf16_t* OI = (const bf16_t*)(ws + WS_OI); const bf16_t* SB = (const bf16_t*)(ws + WS_SB);
    const bf16_t* WSB = (const bf16_t*)(ws + WS_WS); const float* rowss = (const float*)(ws + WS_RSP); bf16_t* MIX = (bf16_t*)(ws + WS_KV);
    const int t = threadIdx.x, lane = t & 63, w = t >> 6, ln = lane & 15, kg = lane >> 4;
    unsigned* sV = (unsigned*)lds;
    {
        bf16x8 nqf[4]; u32x4 noi[4], nog[4];
#define G3_ROW(pu_) ({ const int u_ = 2 * (pu_) + (w >> 2); (u_ >> 8) * SEQ + ((u_ >> 2) & 63) * 64 + (w & 3) * 16 + ln; })
#define G3_LOAD(pu_) do { const int u_ = 2 * (pu_) + (w >> 2), h_ = u_ & 3; const size_t r_ = (size_t)G3_ROW(pu_); \
        _Pragma("unroll") for (int ks = 0; ks < 4; ++ks) { const int k = ks * 32 + kg * 8; nqf[ks] = *(const bf16x8*)(QT + r_ * 512 + (k >> 6) * 256 + h_ * 64 + (k & 63)); } \
        _Pragma("unroll") for (int p = 0; p < 4; ++p) { noi[p] = *(const u32x4*)(OI + r_ * 512 + h_ * 128 + p * 32 + kg * 8); nog[p] = *(const u32x4*)(Z + r_ * ZW + ZC_OG + h_ * 128 + p * 32 + kg * 8); } } while (0)
        if ((int)blockIdx.x < NU_LAT / 2) G3_LOAD((int)blockIdx.x);
        for (int pu = blockIdx.x; pu < NU_LAT / 2; pu += G) {
            const int u = 2 * pu + (w >> 2), h = u & 3, row = G3_ROW(pu);
            bf16x8 qf[4]; u32x4 oi[4], og[4];
#pragma unroll
            for (int i = 0; i < 4; ++i) { qf[i] = nqf[i]; oi[i] = noi[i]; og[i] = nog[i]; }
            if (pu + G < NU_LAT / 2) G3_LOAD(pu + G);
            f32x4 acc[8];
#pragma unroll
            for (int d = 0; d < 8; ++d) acc[d] = (f32x4){0.f, 0.f, 0.f, 0.f};
#pragma unroll
            for (int ks = 0; ks < 4; ++ks) {
                const int k = ks * 32 + kg * 8, dir = k >> 6, kk = k & 63;
                bf16x8 sf[8];
#pragma unroll
                for (int d = 0; d < 8; ++d) sf[d] = *(const bf16x8*)(SB + (((size_t)u * 2 + dir) * 128 + (d >> 1) * 32 + prow(d & 1, ln)) * 64 + kk);
#pragma unroll
                for (int d = 0; d < 8; ++d) acc[d] = mfma16(sf[d], qf[ks], acc[d]);
            }
            float ss = 0.f;
#pragma unroll
            for (int p = 0; p < 4; ++p) { float f[8]; unpack8(oi[p], f);
#pragma unroll
                for (int j = 0; j < 4; ++j) { acc[2 * p][j] += f[j]; acc[2 * p + 1][j] += f[4 + j]; ss += acc[2 * p][j] * acc[2 * p][j] + acc[2 * p + 1][j] * acc[2 * p + 1][j]; } }
            ss += __shfl_xor(ss, 16); ss += __shfl_xor(ss, 32);
            const float rstd = rsqrtf(ss * (1.f / 128.f) + EPS);
#pragma unroll
            for (int p = 0; p < 4; ++p) { const int dv = p * 32 + kg * 8; float f[8], o[8]; unpack8(og[p], f);
                const f32x4 g0 = *(const f32x4*)(a.in[I_GLAG] + dv), g1 = *(const f32x4*)(a.in[I_GLAG] + dv + 4);
#pragma unroll
                for (int j = 0; j < 4; ++j) { o[j] = acc[2 * p][j] * rstd * g0[j] * f[j]; o[4 + j] = acc[2 * p + 1][j] * rstd * g1[j] * f[4 + j]; }
                *(u32x4*)(MIX + (size_t)row * D + h * 128 + dv) = pack8(o); }
        }
#undef G3_ROW
#undef G3_LOAD
    }
    {
        const int cgi = t & 7, pp = t >> 3;
        int hcur = -1; bf16x8 wf[4]; float bs = 0.f; f32x4 g0 = {0.f, 0.f, 0.f, 0.f}, g1 = g0;
        u32x4 nva, nvb, ngu[2]; f32x4 npa, npb, npc, npd;
#define C1_LOAD(v_) do { const int b_ = (v_) >> 8, n_ = ((v_) >> 3) & 31, hd_ = (v_) & 7, r0_ = b_ * SEQ + n_ * 128; \
        nva = *(const u32x4*)(Z + (size_t)(r0_ + 2 * pp) * ZW + ZC_VS + hd_ * 64 + cgi * 8); nvb = *(const u32x4*)(Z + (size_t)(r0_ + 2 * pp + 1) * ZW + ZC_VS + hd_ * 64 + cgi * 8); \
        const float* rp_ = rowss + (size_t)(r0_ + 2 * pp) * 8; npa = *(const f32x4*)rp_; npb = *(const f32x4*)(rp_ + 4); npc = *(const f32x4*)(rp_ + 8); npd = *(const f32x4*)(rp_ + 12); \
        _Pragma("unroll") for (int p = 0; p < 2; ++p) ngu[p] = *(const u32x4*)(Z + (size_t)(r0_ + w * 16 + ln) * ZW + ZC_U + hd_ * 64 + p * 32 + kg * 8); } while (0)
        if ((int)blockIdx.x < NU_LAT) C1_LOAD((int)blockIdx.x);
        for (int v = blockIdx.x; v < NU_LAT; v += G) {
            const int b = v >> 8, n = (v >> 3) & 31, hd = v & 7, r0 = b * SEQ + n * 128;
            if (hd != hcur) { hcur = hd;
#pragma unroll
                for (int ks = 0; ks < 4; ++ks) wf[ks] = *(const bf16x8*)(WSB + ((size_t)hd * 128 + w * 16 + ln) * 128 + ks * 32 + kg * 8);
                bs = a.in[I_BS][hd * 128 + w * 16 + ln];
                g0 = *(const f32x4*)(a.in[I_CMG] + hd * 64 + cgi * 8); g1 = *(const f32x4*)(a.in[I_CMG] + hd * 64 + cgi * 8 + 4); }
            const u32x4 va = nva, vb = nvb; const f32x4 pa = npa, pb = npb, pc = npc, pd = npd; u32x4 gu[2]; gu[0] = ngu[0]; gu[1] = ngu[1];
            if (v + G < NU_LAT) C1_LOAD(v + G);
            {
                float f0[8], f1[8]; unpack8(va, f0); unpack8(vb, f1);
                const float rs0 = rsqrtf((((pa.x + pa.y) + (pa.z + pa.w)) + ((pb.x + pb.y) + (pb.z + pb.w))) * (1.f / 512.f) + EPS), rs1 = rsqrtf((((pc.x + pc.y) + (pc.z + pc.w)) + ((pd.x + pd.y) + (pd.z + pd.w))) * (1.f / 512.f) + EPS);
#pragma unroll
                for (int j = 0; j < 8; ++j) { const float gj = j < 4 ? g0[j] : g1[j - 4]; const int ch = cgi * 8 + j, fsw = (ch ^ (ch >> 3)) & 15;
                    sV[ch * 64 + (((pp >> 2) ^ fsw) << 2) + (pp & 3)] = cvt_pk_bf16(f0[j] * rs0 * gj, f1[j] * rs1 * gj); }
            }
            LBAR();
            {
                f32x4 acc[4];
#pragma unroll
                for (int d = 0; d < 4; ++d) acc[d] = (f32x4){0.f, 0.f, 0.f, 0.f};
#pragma unroll
                for (int ks = 0; ks < 4; ++ks) {
#pragma unroll
                    for (int d = 0; d < 4; ++d) { const int ch = (d >> 1) * 32 + prow(d & 1, ln), fsw = (ch ^ (ch >> 3)) & 15; const bf16x8 vf = *(const bf16x8*)(sV + ch * 64 + (((ks * 4 + kg) ^ fsw) << 2)); acc[d] = mfma16(vf, wf[ks], acc[d]); }
                }
#pragma unroll
                for (int p = 0; p < 2; ++p) { const int ch = hd * 64 + p * 32 + kg * 8; float f[8], o[8]; unpack8(gu[p], f);
#pragma unroll
                    for (int j = 0; j < 4; ++j) { o[j] = (acc[2 * p][j] + bs) * f[j]; o[4 + j] = (acc[2 * p + 1][j] + bs) * f[4 + j]; }
                    *(u32x4*)(MIX + (size_t)(r0 + w * 16 + ln) * D + 512 + ch) = pack8(o); }
            }
            LBAR();
        }
#undef C1_LOAD
    }
}

#define LAS __attribute__((address_space(3)))
#define XB_TMO      128
#define XB_XCNT(j)  (256  + 64 * (j))
#define XB_XSUB(j)  (1280 + 64 * (j))
#define XB_XGEN(j)  (2304 + 64 * (j))
#define XB_TOP      3328
#define XB_TOPGEN   3392
#define XCD_BAR_WORDS 3456
#define XB_SPIN_CAP (1u << 18)

__device__ __forceinline__ unsigned xb_ld(unsigned* p)              { return __hip_atomic_load(p, __ATOMIC_RELAXED, __HIP_MEMORY_SCOPE_AGENT); }
__device__ __forceinline__ unsigned xb_add(unsigned* p, unsigned v) { return __hip_atomic_fetch_add(p, v, __ATOMIC_RELAXED, __HIP_MEMORY_SCOPE_AGENT); }
__device__ __forceinline__ unsigned xb_xcc_id() { return (unsigned)__builtin_amdgcn_s_getreg((3 << 11) | 20) & 0xFu; }
#define XB_SPIN(cond, bar) do { unsigned _sp = 0; while (cond) { __builtin_amdgcn_s_sleep(1); \
    if ((++_sp & 255u) == 0u) { if (xb_ld(&(bar)[XB_TMO])) break; if (_sp > XB_SPIN_CAP) { atomicAdd(&(bar)[XB_TMO], 1u); break; } } } } while (0)

struct XcdBarrier {
    unsigned* bar; unsigned x;
    volatile LAS unsigned* st;
};

__device__ __forceinline__ XcdBarrier xcd_barrier_post(unsigned* bar, volatile LAS unsigned* st) {
    XcdBarrier b; b.bar = bar; b.x = xb_xcc_id(); b.st = st;
    if (threadIdx.x == 0) (void)xb_add(&bar[XB_XCNT(b.x)], 1u);
    return b;
}
__device__ __forceinline__ void xcd_barrier_complete(unsigned* bar, unsigned x, unsigned& nloc, unsigned& nx) {
    const unsigned G = gridDim.x * gridDim.y * gridDim.z;
    unsigned sum, cnt, mine, sp = 0u;
    for (;;) {
        sum = 0u; cnt = 0u; mine = 0u;
#pragma unroll
        for (unsigned j = 0; j < 16; ++j) { const unsigned c = xb_ld(&bar[XB_XCNT(j)]); sum += c; cnt += (c > 0u) ? 1u : 0u; mine = (j == x) ? c : mine; }
        if (sum == G) break;
        __builtin_amdgcn_s_sleep(1);
        if ((++sp & 255u) == 0u) { if (xb_ld(&bar[XB_TMO])) break; if (sp > XB_SPIN_CAP) { atomicAdd(&bar[XB_TMO], 1u); break; } }
    }
    nloc = mine > 0u ? mine : 1u; nx = cnt > 0u ? cnt : 1u;
}

__device__ __forceinline__ void xcd_barrier(const XcdBarrier& b) {
    asm volatile("s_waitcnt vmcnt(0)" ::: "memory");
    __syncthreads();
    if (threadIdx.x == 0) {
        unsigned* bar = b.bar;
        __builtin_amdgcn_s_waitcnt(0);
        unsigned nloc = b.st[0], nx = b.st[1];
        if (nloc == 0u) { xcd_barrier_complete(bar, b.x, nloc, nx); b.st[0] = nloc; b.st[1] = nx; }
        const unsigned old = xb_add(&bar[XB_XSUB(b.x)], 1u);
        const unsigned gen = old / nloc;
        if (old + 1u == (gen + 1u) * nloc) {
            __builtin_amdgcn_fence(__ATOMIC_RELEASE, "agent");
            asm volatile("s_waitcnt vmcnt(0)" ::: "memory");
            const unsigned og = xb_add(&bar[XB_TOP], 1u);
            const unsigned tg = og / nx;
            if (og + 1u == (tg + 1u) * nx) xb_add(&bar[XB_TOPGEN], 1u);
            else XB_SPIN(xb_ld(&bar[XB_TOPGEN]) == tg, bar);
            __builtin_amdgcn_fence(__ATOMIC_ACQUIRE, "agent");
            xb_add(&bar[XB_XGEN(b.x)], 1u);
            asm volatile("s_waitcnt vmcnt(0)" ::: "memory");
        } else {
            XB_SPIN(xb_ld(&bar[XB_XGEN(b.x)]) == gen, bar);
            __builtin_amdgcn_fence(__ATOMIC_ACQUIRE, "agent");
            asm volatile("s_waitcnt vmcnt(0)" ::: "memory");
        }
    }
    __syncthreads();
}


constexpr int NPHASE = 15;
__global__ void __launch_bounds__(512, 2) fwd_kernel(Args a) {
    extern __shared__ __attribute__((aligned(16))) unsigned char lds[];
    const int G = gridDim.x, tid = threadIdx.x, lane = tid & 63, wave = __builtin_amdgcn_readfirstlane(tid >> 6);
    const int gw = blockIdx.x * 8 + wave, NGW = G * 8;
    unsigned char* ws = a.ws;
    const float* mod = (const float*)(ws + WS_MOD);
    bf16_t* XN = (bf16_t*)(ws + WS_XN); bf16_t* ZH = (bf16_t*)(ws + WS_ZH); float* X1C = (float*)(ws + WS_X1C);
    PG8_LAS unsigned char* ldsg = (PG8_LAS unsigned char*)lds;
    const int lo = a.ph_lo, hi = a.ph_hi;
    volatile LAS unsigned* bst = (volatile LAS unsigned*)(ldsg + (LDS_BYTES - 64));
    if (tid == 0) { bst[0] = 0u; bst[1] = 0u; }
    __syncthreads();
    XcdBarrier xbar; xbar.bar = (unsigned*)(ws + WS_CTL); xbar.x = 0; xbar.st = bst;
    if (hi - lo > 1) xbar = xcd_barrier_post((unsigned*)(ws + WS_CTL), bst);
#define IN(k) (lo <= (k) && (k) < hi)
#define SEAM(k) do { if (IN(k) && IN((k) + 1)) { if (a.ph_hi > 4096) cg::this_grid().sync(); else xcd_barrier(xbar); } } while (0)
    if (IN(0)) { p0_prep(a, lds, gw, NGW, wave, lane); } SEAM(0);
    if (IN(1)) { norm_mod_phase(a.in[I_X], a.in[I_CTX], MALL, a.in[I_N1G], mod, 0, 1, XN, gw, NGW, lane);
        shiftw_phase((const bf16_t*)(ws + WS_WIN), ZW, mod, 3, (float*)(ws + WS_SHW1), gw, NGW, lane); shiftw_phase((const bf16_t*)(ws + WS_W2A), NFF2, mod, 6, (float*)(ws + WS_SHW2), gw, NGW, lane); } SEAM(1);
    if (IN(2)) { pg8::Gemm g{XN, (const bf16_t*)(ws + WS_W1A), MALL, NFF2, D}; pg8::StaticOrder S; S.init(MALL, NFF2, G, (int)blockIdx.x); EpiSwiGLU<false> E{ZH, nullptr, nullptr};
        pg8::gemm_phase<EpiSwiGLU<false>, pg8::StaticOrder, true, true>(ldsg, g, S, E); } SEAM(2);
    if (IN(3)) { pg8::Gemm g{ZH, (const bf16_t*)(ws + WS_W1B), MALL, D, DFF}; pg8::StaticOrder S; S.init(MALL, D, G, (int)blockIdx.x); typedef EpiResid<2, true, true, 4> EpiT; EpiT E{a.in[I_X], a.in[I_CTX], a.out, X1C, mod, XN, a.in[I_N2G], (float*)(ws + WS_RS2)};
        pg8::gemm_phase<EpiT, pg8::StaticOrder, true, true>(ldsg, g, S, E); } SEAM(3);
    if (IN(5)) { pg8::Gemm g{XN, (const bf16_t*)(ws + WS_WIN), MALL, ZW, D}; pg8::StaticOrder S; S.init(MALL, ZW, G, (int)blockIdx.x); EpiZ E{ZH, (float*)(ws + WS_RSP), (const float*)(ws + WS_RS2), (const float*)(ws + WS_SHW1)};
        pg8::gemm_phase<EpiZ, pg8::StaticOrder, true, true>(ldsg, g, S, E); } SEAM(5);
    if (IN(6)) { conv_phase(ZH, a.in[I_CONVW], XN, G); } SEAM(6);
    if (IN(7)) { g1_phase(a, lds, G); } SEAM(7);
    if (IN(8)) { g2_phase(a, G); } SEAM(8);
    if (IN(9)) { g3c1_phase(a, lds, G); } SEAM(9);
    if (IN(10)) { pg8::Gemm g{(const bf16_t*)(ws + WS_KV), (const bf16_t*)(ws + WS_WOUT), MLAT, D, D}; pg8::StaticOrder S; S.init(MLAT, D, G, (int)blockIdx.x); typedef EpiResid<5, false, true, 7> EpiT; EpiT E{a.out, a.out, a.out, a.out, mod, XN, a.in[I_N3G], (float*)(ws + WS_RS3)};
        pg8::gemm_phase<EpiT, pg8::StaticOrder, true, true>(ldsg, g, S, E); } SEAM(10);
    if (IN(12)) { pg8::Gemm g{XN, (const bf16_t*)(ws + WS_W2A), MLAT, NFF2, D}; pg8::StaticOrder S; S.init(MLAT, NFF2, G, (int)blockIdx.x); EpiSwiGLU<true> E{ZH, (const float*)(ws + WS_RS3), (const float*)(ws + WS_SHW2)};
        pg8::gemm_phase<EpiSwiGLU<true>, pg8::StaticOrder, true, true>(ldsg, g, S, E); } SEAM(12);
    if (IN(13)) { pg8::Gemm g{ZH, (const bf16_t*)(ws + WS_W2B), MLAT, D, DFF}; pg8::StaticOrder S; S.init(MLAT, D, G, (int)blockIdx.x); typedef EpiResid<8, true, false, 0> EpiT; EpiT E{a.out, a.out, a.out, a.out, mod, nullptr, nullptr, nullptr};
        pg8::gemm_phase<EpiT, pg8::StaticOrder, true, true>(ldsg, g, S, E); } SEAM(13);
    if (IN(14)) { final_norm_phase(a.out, a.in[I_FING], gw, NGW, lane); }
#if defined(MK_EXTRA_SYNC) && MK_EXTRA_SYNC
    if (hi - lo > 1) for (int i = 0; i < MK_EXTRA_SYNC; ++i) cg::this_grid().sync();
#endif
#undef IN
#undef SEAM
}


extern "C" void kernel_launch(void* const* d_in, const int* in_sizes, int n_in, void* d_out, int out_size, void* d_ws, size_t ws_size, hipStream_t stream) {
    static int grid = 0;
    if (grid == 0) {
        if (n_in != 25 || out_size != MLAT * D || ws_size < WS_END) { fprintf(stderr, "kernel_launch: unexpected shapes (n_in %d, out %d, ws %zu; need ws >= %zu)\n", n_in, out_size, ws_size, (size_t)WS_END); grid = -1; return; }
        int dev = 0, cus = 0, per_cu = 0;
        (void)hipGetDevice(&dev); (void)hipDeviceGetAttribute(&cus, hipDeviceAttributeMultiprocessorCount, dev);
        if (hipFuncSetAttribute((const void*)fwd_kernel, hipFuncAttributeMaxDynamicSharedMemorySize, LDS_BYTES) != hipSuccess) { fprintf(stderr, "kernel_launch: hipFuncSetAttribute failed\n"); grid = -1; return; }
        if (hipOccupancyMaxActiveBlocksPerMultiprocessor(&per_cu, (const void*)fwd_kernel, 512, LDS_BYTES) != hipSuccess || per_cu < 1) { fprintf(stderr, "kernel_launch: occupancy query says %d\n", per_cu); per_cu = 1; }
        (void)hipGetLastError();
        grid = cus * per_cu;
    }
    if (grid < 0) return;
    (void)hipMemsetAsync((char*)d_ws + WS_CTL, 0, 1 << 20, stream);
    Args a{};
    for (int i = 0; i < 25; ++i) a.in[i] = (const float*)d_in[i];
    a.out = (float*)d_out; a.ws = (unsigned char*)d_ws;
#if MK_ONE_LAUNCH
    a.ph_lo = 0; a.ph_hi = NPHASE;
    void* args[] = {&a};
    hipError_t e = hipLaunchCooperativeKernel((const void*)fwd_kernel, dim3(grid), dim3(512), args, LDS_BYTES, stream);
    if (e != hipSuccess) fprintf(stderr, "cooperative launch failed: %s (grid %d)\n", hipGetErrorString(e), grid);
#if defined(MK_DUP) && MK_DUP
    for (int p = 0; p < NPHASE; ++p) if ((MK_DUP >> p) & 1) { a.ph_lo = p; a.ph_hi = p + 1; hipLaunchKernelGGL(fwd_kernel, dim3(grid), dim3(512), LDS_BYTES, stream, a); }
#endif
#else
    for (int p = 0; p < NPHASE; ++p) { a.ph_lo = p; a.ph_hi = p + 1; hipLaunchKernelGGL(fwd_kernel, dim3(grid), dim3(512), LDS_BYTES, stream, a); }
#endif
}
```

```cpp
#include <hip/hip_runtime.h>
#include <hip/hip_cooperative_groups.h>
#include <cstdio>
#include <cstdint>
namespace cg = cooperative_groups;
#ifndef MK_ONE_LAUNCH
#define MK_ONE_LAUNCH 1
#endif
#ifndef MK_DUP
#define MK_DUP 0
#endif
#ifndef MK_EXTRA_SYNC
#define MK_EXTRA_SYNC 0
#endif
namespace pg8 {
#define PG8_LAS __attribute__((address_space(3)))
typedef unsigned short bf16_t;
typedef short bf16x8 __attribute__((ext_vector_type(8)));
typedef float f32x4 __attribute__((ext_vector_type(4)));
typedef unsigned u32x4 __attribute__((ext_vector_type(4)));
constexpr int BM = 256, BK = 64, HALF = 128, HTB = HALF * BK * 2  , STAGE_BYTES = 8 * HTB, NXCD = 8, WGM = 8;

__host__ __device__ __forceinline__ int lds_byte(int r, int c) { const int st = (r >> 4) * 2 + (c >> 5), rr = r & 15, cc = c & 31, ob = rr * 64 + cc * 2; return st * 1024 + (ob ^ (((ob >> 9) & 1) << 5)); }
__host__ __device__ __forceinline__ void stage_rc(int b, int& R, int& C) { const int st = b / 1024, sb = b % 1024, swz = sb ^ (((sb >> 9) & 1) << 5); R = (st >> 1) * 16 + swz / 64; C = (st & 1) * 32 + (swz % 64) / 2; }
__host__ __device__ __forceinline__ int perm32(int rho) { const int n = rho >> 4, i = rho & 15; return 8 * (i >> 2) + 4 * n + (i & 3); }

struct Unit { int pm, pn; };
struct Gemm { const bf16_t* A; const bf16_t* Bt; int M, N, K; };

struct StaticOrder {
    int nM, nN, nwg, G, c;
    __host__ __device__ void init(int M, int N, int G_, int c_) { nM = M / BM; nN = N / BM; nwg = nM * nN; G = G_; c = c_; }
    __host__ __device__ bool next(int i, Unit& u) const {
        const long L = (long)i * G + c; if (L >= nwg) return false;
        int wgid = (int)L; { const int q = nwg / NXCD, r = nwg % NXCD, xcd = wgid % NXCD, off = wgid / NXCD; wgid = (xcd < r ? xcd * (q + 1) : r * (q + 1) + (xcd - r) * q) + off; }
        const int nig = WGM * nN, gid = wgid / nig, fm = gid * WGM, gsz = (nM - fm) < WGM ? (nM - fm) : WGM;
        u.pm = fm + ((wgid % nig) % gsz); u.pn = (wgid % nig) / gsz; return true;
    }
    __device__ __forceinline__ void a_ready(const Unit&) const {}
    __device__ __forceinline__ void done(const Unit&) const {}
};

typedef float f32x2_t __attribute__((ext_vector_type(2))); typedef __bf16 bf16x2_t __attribute__((ext_vector_type(2)));
__device__ __forceinline__ unsigned cvt_pk_bf16(float lo, float hi) { f32x2_t v = {lo, hi}; bf16x2_t b = __builtin_convertvector(v, bf16x2_t); return __builtin_bit_cast(unsigned, b); }
template <class Epi, class Sched, bool ALIGN_EPI = false, bool SP2 = false>
__device__ __forceinline__ void gemm_phase(PG8_LAS unsigned char* lds, const Gemm g, const Sched& S, const Epi& E) {
    const int tid = threadIdx.x, wid = __builtin_amdgcn_readfirstlane(tid >> 6), lane = tid & 63, wr = wid >> 2, wc = wid & 3, fr = lane & 15, fq = lane >> 4;
    const int K = g.K, nt = K / BK;
    unsigned voffA[2], voffB[2];
#pragma unroll
    for (int i = 0; i < 2; ++i) { int R, C; stage_rc(tid * 16 + i * 8192, R, C); const int Rb = Epi::PERM ? ((R & ~31) + perm32(R & 31)) : R;
        voffA[i] = (unsigned)(R * K + C) * 2u; voffB[i] = (unsigned)(Rb * K + C) * 2u; }
    const size_t kstep = (size_t)(BK * 2);
    const size_t hstep = (size_t)HALF * K * 2;
    const size_t tstep = 2 * hstep;
    const unsigned ldsw = (unsigned)wid * 1024u;
    const int aoff = lds_byte(wr * 64 + fr, fq * 8), boff = lds_byte(wc * 32 + fr, fq * 8);
#define PG8_SA(b, h) (((b) * 2 + (h)) * HTB)
#define PG8_SB(b, h) ((4 + (b) * 2 + (h)) * HTB)
#define PG8_STAGE(bufoff, gbase, voff) do { _Pragma("unroll") for (int _i = 0; _i < 2; ++_i) \
        __builtin_amdgcn_global_load_lds((const unsigned*)((const char*)(gbase) + (voff)[_i]), (PG8_LAS unsigned*)(lds + (bufoff) + ldsw + _i * 8192), 16, 0, 0); } while (0)
#define PG8_LDA(dst, b, h) do { _Pragma("unroll") for (int m = 0; m < 4; ++m) _Pragma("unroll") for (int k = 0; k < 2; ++k) dst[m][k] = *(const PG8_LAS bf16x8*)(lds + PG8_SA(b, h) + aoff + m * 2048 + k * 1024); } while (0)
#define PG8_LDB(dst, b, h) do { _Pragma("unroll") for (int n = 0; n < 2; ++n) _Pragma("unroll") for (int k = 0; k < 2; ++k) dst[n][k] = *(const PG8_LAS bf16x8*)(lds + PG8_SB(b, h) + boff + n * 2048 + k * 1024); } while (0)
#define PG8_MMA(ai, bj, At, Bt) do { __builtin_amdgcn_s_setprio(1); _Pragma("unroll") for (int m = 0; m < 4; ++m) _Pragma("unroll") for (int n = 0; n < 2; ++n) _Pragma("unroll") for (int k = 0; k < 2; ++k) \
        acc[ai][bj][m][n] = __builtin_amdgcn_mfma_f32_16x16x32_bf16(Bt[n][k], At[m][k], acc[ai][bj][m][n], 0, 0, 0); __builtin_amdgcn_s_setprio(0); } while (0)
#define PG8_WAIT_V(n) asm volatile("s_waitcnt vmcnt(" #n ")" ::: "memory")
#define PG8_WAIT_L(n) asm volatile("s_waitcnt lgkmcnt(" #n ")" ::: "memory")
#define PG8_BAR __builtin_amdgcn_s_barrier()
#define PG8_SCHED __builtin_amdgcn_sched_barrier(0)
    Unit cur, nxt; int ui = 0;
    if (!S.next(0, cur)) return;
    f32x4 acc[2][2][4][2];
#pragma unroll
    for (int a = 0; a < 2; ++a)
#pragma unroll
        for (int b = 0; b < 2; ++b)
#pragma unroll
            for (int m = 0; m < 4; ++m)
#pragma unroll
                for (int n = 0; n < 2; ++n) acc[a][b][m][n] = (f32x4){0.f, 0.f, 0.f, 0.f};
    bf16x8 At[4][2], B0[2][2], B1[2][2];
    const char* cA = (const char*)g.A + (size_t)cur.pm * tstep; const char* cB = (const char*)g.Bt + (size_t)cur.pn * tstep;
    S.a_ready(cur);
    if constexpr (SP2) {
        PG8_STAGE(PG8_SB(0, 0), cB, voffB); PG8_STAGE(PG8_SB(0, 1), cB + hstep, voffB); PG8_STAGE(PG8_SA(0, 0), cA, voffA); PG8_STAGE(PG8_SA(0, 1), cA + hstep, voffA);
        if (wr == 1) PG8_BAR;
        PG8_WAIT_V(2); PG8_BAR;
        PG8_STAGE(PG8_SB(1, 0), cB + kstep, voffB); PG8_STAGE(PG8_SA(1, 0), cA + kstep, voffA); PG8_STAGE(PG8_SB(1, 1), cB + hstep + kstep, voffB);
        PG8_WAIT_V(6); PG8_BAR;
    } else {
        PG8_STAGE(PG8_SB(0, 0), cB, voffB); PG8_STAGE(PG8_SA(0, 0), cA, voffA); PG8_STAGE(PG8_SB(0, 1), cB + hstep, voffB); PG8_STAGE(PG8_SA(0, 1), cA + hstep, voffA);
        if (wr == 1) PG8_BAR;
        PG8_WAIT_V(4); PG8_BAR;
        PG8_STAGE(PG8_SB(1, 0), cB + kstep, voffB); PG8_STAGE(PG8_SA(1, 0), cA + kstep, voffA); PG8_STAGE(PG8_SB(1, 1), cB + hstep + kstep, voffB);
        PG8_WAIT_V(6); PG8_BAR;
    }
    for (;;) {
        const bool has_next = S.next(ui + 1, nxt);
        const char* nA = has_next ? (const char*)g.A + (size_t)nxt.pm * tstep : cA; const char* nB = has_next ? (const char*)g.Bt + (size_t)nxt.pn * tstep : cB;
        for (int t = 0; t < nt; t += 2) {
            const bool last = (t == nt - 2);
            const char* a1 = cA + (size_t)(t + 1) * kstep;
            const char* a2 = last ? nA : cA + (size_t)(t + 2) * kstep; const char* b2 = last ? nB : cB + (size_t)(t + 2) * kstep;
            const char* a3 = a2 + kstep; const char* b3 = b2 + kstep;
            if (last && has_next) S.a_ready(nxt);
            if constexpr (SP2) {
            PG8_LDB(B0, 0, 0); PG8_LDB(B1, 0, 1); PG8_SCHED; PG8_LDA(At, 0, 0); PG8_STAGE(PG8_SA(1, 1), a1 + hstep, voffA);
            PG8_WAIT_V(8); PG8_WAIT_L(0); PG8_BAR; PG8_MMA(0, 0, At, B0); PG8_MMA(0, 1, At, B1); PG8_BAR; PG8_SCHED;
            PG8_LDA(At, 0, 1); PG8_STAGE(PG8_SB(0, 0), b2, voffB); PG8_STAGE(PG8_SB(0, 1), b2 + hstep, voffB); PG8_STAGE(PG8_SA(0, 0), a2, voffA);
            PG8_WAIT_V(8); PG8_WAIT_L(0); PG8_BAR; PG8_MMA(1, 0, At, B0); PG8_MMA(1, 1, At, B1); PG8_BAR; PG8_SCHED;
            PG8_LDB(B0, 1, 0); PG8_LDB(B1, 1, 1); PG8_SCHED; PG8_LDA(At, 1, 0); PG8_STAGE(PG8_SA(0, 1), a2 + hstep, voffA);
            PG8_WAIT_V(8); PG8_WAIT_L(0); PG8_BAR; PG8_MMA(0, 0, At, B0); PG8_MMA(0, 1, At, B1); PG8_BAR; PG8_SCHED;
            PG8_LDA(At, 1, 1); PG8_STAGE(PG8_SB(1, 0), b3, voffB); PG8_STAGE(PG8_SB(1, 1), b3 + hstep, voffB); PG8_STAGE(PG8_SA(1, 0), a3, voffA);
            PG8_WAIT_V(8); PG8_WAIT_L(0); PG8_BAR; PG8_MMA(1, 0, At, B0); PG8_MMA(1, 1, At, B1); PG8_BAR; PG8_SCHED;
            } else {
            PG8_LDB(B0, 0, 0); PG8_SCHED; PG8_LDA(At, 0, 0); PG8_STAGE(PG8_SA(1, 1), a1 + hstep, voffA);
            PG8_WAIT_L(8); PG8_BAR; PG8_WAIT_L(0); PG8_MMA(0, 0, At, B0); PG8_BAR; PG8_SCHED;
            PG8_LDB(B1, 0, 1); PG8_STAGE(PG8_SB(0, 0), b2, voffB);
            PG8_BAR; PG8_WAIT_L(0); PG8_MMA(0, 1, At, B1); PG8_BAR;
            PG8_LDA(At, 0, 1); PG8_STAGE(PG8_SA(0, 0), a2, voffA);
            PG8_BAR; PG8_WAIT_L(0); PG8_MMA(1, 0, At, B0); PG8_BAR; PG8_SCHED;
            PG8_STAGE(PG8_SB(0, 1), b2 + hstep, voffB);
            PG8_WAIT_V(6); PG8_BAR; PG8_MMA(1, 1, At, B1); PG8_BAR;
            PG8_LDB(B0, 1, 0); PG8_SCHED; PG8_LDA(At, 1, 0); PG8_STAGE(PG8_SA(0, 1), a2 + hstep, voffA);
            PG8_WAIT_L(8); PG8_BAR; PG8_WAIT_L(0); PG8_MMA(0, 0, At, B0); PG8_BAR; PG8_SCHED;
            PG8_LDB(B1, 1, 1); PG8_STAGE(PG8_SB(1, 0), b3, voffB);
            PG8_BAR; PG8_WAIT_L(0); PG8_MMA(0, 1, At, B1); PG8_BAR;
            PG8_LDA(At, 1, 1); PG8_STAGE(PG8_SA(1, 0), a3, voffA);
            PG8_BAR; PG8_WAIT_L(0); PG8_MMA(1, 0, At, B0); PG8_BAR; PG8_SCHED;
            PG8_STAGE(PG8_SB(1, 1), b3 + hstep, voffB);
            PG8_WAIT_V(6); PG8_BAR; PG8_MMA(1, 1, At, B1); PG8_BAR;
            }
        }
        if constexpr (ALIGN_EPI) { if (wr == 0) PG8_BAR; }
        if constexpr (!Epi::AFTER_DRAIN) { E(acc, cur, wr, wc, fr, fq); S.done(cur); }
        if (!has_next) break;
#pragma unroll
        for (int a = 0; a < 2; ++a)
#pragma unroll
            for (int b = 0; b < 2; ++b)
#pragma unroll
                for (int m = 0; m < 4; ++m)
#pragma unroll
                    for (int n = 0; n < 2; ++n) acc[a][b][m][n] = (f32x4){0.f, 0.f, 0.f, 0.f};
        cur = nxt; cA = nA; cB = nB; ++ui;
        if constexpr (ALIGN_EPI) { if (wr == 1) PG8_BAR; }
    }
    PG8_WAIT_V(0);
    if constexpr (!ALIGN_EPI) { if (wr == 0) PG8_BAR; }
    PG8_BAR;
    if constexpr (Epi::AFTER_DRAIN) { E.fused(acc, cur, wr, wc, fr, fq, lds, wid, lane); S.done(cur); }
#undef PG8_SA
#undef PG8_SB
#undef PG8_STAGE
#undef PG8_LDA
#undef PG8_LDB
#undef PG8_MMA
#undef PG8_WAIT_V
#undef PG8_WAIT_L
#undef PG8_BAR
#undef PG8_SCHED
}
}
using pg8::bf16_t; using pg8::bf16x8; using pg8::f32x4; using pg8::u32x4; using pg8::Unit; using pg8::cvt_pk_bf16;
typedef unsigned u32x2 __attribute__((ext_vector_type(2)));
#define DEV __device__ __forceinline__
constexpr int D = 1024, NB = 16, SEQ = 4096, MLAT = NB * SEQ, CTXL = 256, MCTX = NB * CTXL, MALL = MLAT + MCTX;
constexpr int DFF = 2816, NFF2 = 2 * DFF, ZW = 2816, NMOD = 9 * D;
constexpr int NU_LAT = NB * 64 * 4, NU_CTX = NB * 4 * 4, NU_ALL = NU_LAT + NU_CTX;
constexpr float EPS = 1e-6f;
constexpr int ZC_OG = 1024, ZC_U = 1536, ZC_VS = 2048, ZC_GLR = 2560;
constexpr size_t MiB = 1u << 20;
constexpr size_t WS_CTL = 0, WS_MOD = 64 * 1024;
static_assert(WS_MOD + 17 * 9216 * 4 <= (1u << 20), "MOD inside the zeroed region");
constexpr size_t WS_W1A = 2 * MiB, WS_W1B = 13 * MiB, WS_WIN = 19 * MiB, WS_WOUT = 25 * MiB, WS_W2A = 27 * MiB, WS_W2B = 38 * MiB, WS_WS = 44 * MiB;
constexpr size_t WS_DEC = 45 * MiB, WS_X1C = 48 * MiB, WS_XN = 64 * MiB, WS_ZH = 200 * MiB, WS_QT = 574 * MiB, WS_OI = 638 * MiB, WS_KV = 702 * MiB, WS_SB = 838 * MiB, WS_RSP = 966 * MiB, WS_RS2 = 969 * MiB, WS_RS3 = 974 * MiB, WS_SHW1 = 978 * MiB, WS_SHW2 = 979 * MiB, WS_END = 980 * MiB;
static_assert(WS_MOD + 17 * NMOD * 4 <= 2 * MiB && WS_RSP + (size_t)MALL * 8 * 4 <= WS_RS2 && WS_RS2 + (size_t)MALL * 16 * 4 <= WS_RS3 && WS_RS3 + (size_t)MLAT * 16 * 4 <= WS_SHW1 && WS_SHW1 + 17 * ZW * 4 <= WS_SHW2 && WS_SHW2 + 17 * NFF2 * 4 <= WS_END, "mod / row-stat / shift regions");
static_assert(WS_W1A + (size_t)NFF2 * D * 2 <= WS_W1B && WS_W1B + (size_t)D * DFF * 2 <= WS_WIN && WS_WIN + (size_t)ZW * D * 2 <= WS_WOUT && WS_WOUT + (size_t)D * D * 2 <= WS_W2A, "w map");
static_assert(WS_W2A + (size_t)NFF2 * D * 2 <= WS_W2B && WS_W2B + (size_t)D * DFF * 2 <= WS_WS && WS_WS + 8 * 128 * 128 * 2 <= WS_DEC && WS_DEC + (size_t)NU_ALL * 128 * 4 <= WS_X1C, "w map 2");
static_assert(WS_X1C + (size_t)MCTX * D * 4 <= WS_XN && WS_XN + (size_t)MALL * D * 2 <= WS_ZH && WS_ZH + (size_t)MALL * ZW * 2 <= WS_QT && WS_QT + (size_t)MLAT * 512 * 2 <= WS_OI, "act map");
static_assert(WS_OI + (size_t)MLAT * 512 * 2 <= WS_KV && WS_KV + (size_t)NU_ALL * 2 * 128 * 64 * 2 <= WS_SB && WS_SB + (size_t)NU_LAT * 2 * 128 * 64 * 2 <= WS_RSP, "act map 2");
static_assert(WS_KV + (size_t)MLAT * D * 2 <= WS_SB, "MIX overlays KV");
constexpr int LDS_BYTES = 147456;

DEV float bf_lo(unsigned w) { return __uint_as_float(w << 16); }
DEV float bf_hi(unsigned w) { return __uint_as_float(w & 0xffff0000u); }
DEV float silu_f(float x) { return x * __builtin_amdgcn_rcpf(1.f + __expf(-x)); }
DEV float gelu_f(float x) { const float t = 1.5957691216f * (x + 0.044715f * x * x * x); return x * __builtin_amdgcn_rcpf(1.f + __expf(-t)); }
DEV float wave_sum(float v) {
#pragma unroll
    for (int o = 1; o < 64; o <<= 1) v += __shfl_xor(v, o);
    return v;
}
#define LDS_WAIT() asm volatile("s_waitcnt lgkmcnt(0)" ::: "memory")
#define LBAR() do { asm volatile("s_waitcnt lgkmcnt(0)" ::: "memory"); __builtin_amdgcn_s_barrier(); asm volatile("" ::: "memory"); } while (0)
DEV void unpack8(const u32x4 w, float (&f)[8]) { f[0] = bf_lo(w.x); f[1] = bf_hi(w.x); f[2] = bf_lo(w.y); f[3] = bf_hi(w.y); f[4] = bf_lo(w.z); f[5] = bf_hi(w.z); f[6] = bf_lo(w.w); f[7] = bf_hi(w.w); }
DEV u32x4 pack8(const float (&f)[8]) { u32x4 w; w.x = cvt_pk_bf16(f[0], f[1]); w.y = cvt_pk_bf16(f[2], f[3]); w.z = cvt_pk_bf16(f[4], f[5]); w.w = cvt_pk_bf16(f[6], f[7]); return w; }
DEV f32x4 mfma16(bf16x8 a, bf16x8 b, f32x4 c) { return __builtin_amdgcn_mfma_f32_16x16x32_bf16(a, b, c, 0, 0, 0); }

DEV int prow(int n, int ln) { return 8 * (ln >> 2) + 4 * n + (ln & 3); }
DEV u32x4 pack8v(const f32x4 a, const f32x4 b) { u32x4 w; w.x = cvt_pk_bf16(a[0], a[1]); w.y = cvt_pk_bf16(a[2], a[3]); w.z = cvt_pk_bf16(b[0], b[1]); w.w = cvt_pk_bf16(b[2], b[3]); return w; }
DEV float row_rstd(const float* rs, int row, int fq) {
    const f32x4 p = *(const f32x4*)(rs + (size_t)row * 16 + fq * 4); float s = (p.x + p.y) + (p.z + p.w);
    s += __shfl_xor(s, 16); s += __shfl_xor(s, 32); return rsqrtf(s * (1.f / D) + EPS);
}
template <bool FUSED> struct EpiSwiGLU {
    static constexpr bool PERM = true, AFTER_DRAIN = false;
    bf16_t* H; const float* rs; const float* shw;
    DEV void operator()(const f32x4 (&acc)[2][2][4][2], const Unit& u, int wr, int wc, int fr, int fq) const {
        asm volatile("" : "+v"(fr), "+v"(fq));
        const int row0 = u.pm * 256 + wr * 64 + fr, col0 = u.pn * 128 + wc * 32 + 8 * fq;
        f32x4 sg[2], su[2];
        if (FUSED) { const int b = u.pm >> 4; const float* sp = shw + (size_t)b * NFF2 + u.pn * 256 + wc * 32 + 8 * fq;
            sg[0] = *(const f32x4*)sp; sg[1] = *(const f32x4*)(sp + 4); su[0] = *(const f32x4*)(sp + 128); su[1] = *(const f32x4*)(sp + 132); }
#pragma unroll
        for (int ai = 0; ai < 2; ++ai)
#pragma unroll
            for (int m = 0; m < 4; ++m) {
                const int row = row0 + ai * 128 + m * 16;
                float rstd = 1.f; if (FUSED) rstd = row_rstd(rs, row, fq);
                float h[8];
#pragma unroll
                for (int n = 0; n < 2; ++n)
#pragma unroll
                    for (int j = 0; j < 4; ++j) { float g = acc[ai][0][m][n][j], up = acc[ai][1][m][n][j]; if (FUSED) { g = g * rstd + sg[n][j]; up = up * rstd + su[n][j]; } h[4 * n + j] = silu_f(g) * up; }
                *(u32x4*)(H + (size_t)row * DFF + col0) = pack8(h);
            }
    }
};
template <int GATE_I, bool HALF, bool WITH_XN, int SCALE_I> struct EpiResid {
    static constexpr bool PERM = WITH_XN, AFTER_DRAIN = false; static constexpr int NS = PERM ? 4 : 16;
    const float* res_lat; const float* res_ctx; float* out_lat; float* out_ctx; const float* mod;
    bf16_t* xn; const float* g; float* rs;
    static constexpr int gate_i = GATE_I, scale_i = SCALE_I; static constexpr float coef = HALF ? 0.5f : 1.0f; static constexpr bool has_xn = WITH_XN;
    DEV void operator()(const f32x4 (&acc)[2][2][4][2], const Unit& u, int wr, int wc, int fr, int fq) const {
        asm volatile("" : "+v"(fr), "+v"(fq));
        const bool lat = u.pm < MLAT / 256; const int b = lat ? (u.pm >> 4) : 16;
        const float* res = lat ? res_lat : res_ctx; float* out = lat ? out_lat : out_ctx;
        const int grow0 = u.pm * 256 + wr * 64 + fr, row0 = (lat ? grow0 : grow0 - MLAT), col0 = u.pn * 256 + wc * 32 + (PERM ? 8 : 4) * fq;
        float ss[8];
#pragma unroll
        for (int i = 0; i < 8; ++i) ss[i] = 0.f;
#pragma unroll
        for (int bj = 0; bj < 2; ++bj) {
            f32x4 gv[2], gs[2];
#pragma unroll
            for (int n = 0; n < 2; ++n) { gv[n] = *(const f32x4*)(mod + (size_t)b * NMOD + gate_i * D + col0 + bj * 128 + NS * n) * coef;
                if (has_xn) gs[n] = *(const f32x4*)(g + col0 + bj * 128 + 4 * n) * (*(const f32x4*)(mod + (size_t)b * NMOD + scale_i * D + col0 + bj * 128 + 4 * n) + 1.f); }
#pragma unroll
            for (int ai = 0; ai < 2; ++ai)
#pragma unroll
                for (int m = 0; m < 4; ++m) {
                    const size_t p = (size_t)(row0 + ai * 128 + m * 16) * D + col0 + bj * 128;
                    const f32x4 r0 = *(const f32x4*)(res + p), r1 = *(const f32x4*)(res + p + NS);
                    const f32x4 o0 = r0 + gv[0] * acc[ai][bj][m][0], o1 = r1 + gv[1] * acc[ai][bj][m][1];
                    *(f32x4*)(out + p) = o0; *(f32x4*)(out + p + NS) = o1;
                    if (has_xn) { ss[ai * 4 + m] += (o0[0] * o0[0] + o0[1] * o0[1]) + (o0[2] * o0[2] + o0[3] * o0[3]) + (o1[0] * o1[0] + o1[1] * o1[1]) + (o1[2] * o1[2] + o1[3] * o1[3]);
                        *(u32x4*)(xn + (size_t)(grow0 + ai * 128 + m * 16) * D + col0 + bj * 128) = pack8v(o0 * gs[0], o1 * gs[1]); }
                }
        }
        if (has_xn) {
#pragma unroll
            for (int i = 0; i < 8; ++i) { float v = ss[i]; v += __shfl_xor(v, 16); v += __shfl_xor(v, 32); if (fq == 0) rs[(size_t)(grow0 + (i >> 2) * 128 + (i & 3) * 16) * 16 + u.pn * 4 + wc] = v; }
        }
    }
};
struct EpiZ {
    static constexpr bool PERM = true, AFTER_DRAIN = false;
    bf16_t* Z; float* rowss; const float* rs; const float* shw;
    DEV void operator()(const f32x4 (&acc)[2][2][4][2], const Unit& u, int wr, int wc, int fr, int fq) const {
        asm volatile("" : "+v"(fr), "+v"(fq));
        const int pn = u.pn; const int act = (pn < 4 || pn >= 10) ? 0 : (pn < 6 ? 1 : 2); const bool stat = (pn == 8 || pn == 9);
        const int row0 = u.pm * 256 + wr * 64 + fr, col0 = pn * 256 + wc * 32 + 8 * fq; const int b = u.pm < MLAT / 256 ? (u.pm >> 4) : 16;
        f32x4 sw[2][2];
#pragma unroll
        for (int bj = 0; bj < 2; ++bj)
#pragma unroll
            for (int n = 0; n < 2; ++n) sw[bj][n] = *(const f32x4*)(shw + (size_t)b * ZW + col0 + bj * 128 + 4 * n);
#pragma unroll
        for (int ai = 0; ai < 2; ++ai)
#pragma unroll
            for (int m = 0; m < 4; ++m) {
                const int row = row0 + ai * 128 + m * 16; float ss = 0.f; const float rstd = row_rstd(rs, row, fq);
#pragma unroll
                for (int bj = 0; bj < 2; ++bj) {
                    float v[8];
#pragma unroll
                    for (int n = 0; n < 2; ++n)
#pragma unroll
                        for (int j = 0; j < 4; ++j) { float x = acc[ai][bj][m][n][j] * rstd + sw[bj][n][j]; if (act == 1) x = silu_f(x); else if (act == 2) x = gelu_f(x); v[4 * n + j] = x; ss += x * x; }
                    *(u32x4*)(Z + (size_t)row * ZW + col0 + bj * 128) = pack8(v);
                }
                if (stat) { ss += __shfl_xor(ss, 16); ss += __shfl_xor(ss, 32); if (fq == 0) rowss[(size_t)row * 8 + (pn - 8) * 4 + wc] = ss; }
            }
    }
};

struct Args { const float* in[25]; float* out; unsigned char* ws; int ph_lo, ph_hi; };
enum { I_X = 0, I_C, I_CTX, I_CCTX, I_WADA, I_BADA, I_N1G, I_FF1IN, I_FF1OUT, I_N2G, I_WIN, I_CONVW, I_WGF, I_BGF, I_WGB, I_BGB, I_GLAG, I_CMG, I_WS, I_BS, I_WOUT, I_N3G, I_FF2IN, I_FF2OUT, I_FING };

DEV void transpose_item(const float* W, int K, int N, bf16_t* WT, int n0, int drow0, int k0, float* scr, int lane) {
    float tv[32];
#pragma unroll
    for (int i = 0; i < 32; ++i) tv[i] = W[(size_t)(k0 + 2 * i + (lane >> 5)) * N + n0 + (lane & 31)];
#pragma unroll
    for (int i = 0; i < 32; ++i) scr[(2 * i + (lane >> 5)) * 33 + (lane & 31)] = tv[i];
    LDS_WAIT();
    const int c = lane & 7;
#pragma unroll
    for (int j = 0; j < 4; ++j) { const int n = (lane >> 3) + 8 * j; const float* s = scr + (8 * c) * 33 + n;
        u32x4 o; o.x = cvt_pk_bf16(s[0 * 33], s[1 * 33]); o.y = cvt_pk_bf16(s[2 * 33], s[3 * 33]); o.z = cvt_pk_bf16(s[4 * 33], s[5 * 33]); o.w = cvt_pk_bf16(s[6 * 33], s[7 * 33]);
        *(u32x4*)(WT + (size_t)(drow0 + n) * K + k0 + 8 * c) = o; }
    LDS_WAIT();
}
DEV int ffin_rowmap(int n0) { const int up = n0 >= DFF, j = up ? n0 - DFF : n0; return (j >> 7) * 256 + up * 128 + (j & 127); }
DEV int win_rowmap(int n0) { return n0 < 1024 ? n0 : (n0 < 1056 ? n0 - 1024 + ZC_GLR : n0 - 1056 + ZC_OG); }
DEV void p0_prep(const Args& a, unsigned char* lds, int gw, int NGW, int wave, int lane) {
    unsigned char* ws = a.ws;
    float* scr = (float*)(lds + wave * 16384);
    constexpr int I_A = (D / 64) * (NFF2 / 32), I_B = (DFF / 64) * (D / 32), I_IN = (D / 64) * (2592 / 32), I_O = (D / 64) * (D / 32), I_ADA = (NMOD / 16) * 8;
    constexpr int NIT = 2 * I_A + 2 * I_B + I_IN + I_O + I_ADA;
    for (int r = gw; r < I_ADA; r += NGW) {
        {
            const int cgi = r % (NMOD / 16), kc = r / (NMOD / 16), n0 = cgi * 16, k0 = kc * 128, col = lane & 15, kq = lane >> 4;
            {
                float cv[34];
#pragma unroll
                for (int i = 0; i < 34; ++i) cv[i] = ((i >> 1) < 16) ? a.in[I_C][(i >> 1) * D + k0 + lane + 64 * (i & 1)] : a.in[I_CCTX][k0 + lane + 64 * (i & 1)];
#pragma unroll
                for (int i = 0; i < 34; ++i) scr[lane + 64 * i] = silu_f(cv[i]);
            }
            const float* wp = a.in[I_WADA] + (size_t)(k0 + kq * 32) * NMOD + n0 + col;
            float acc[17];
#pragma unroll
            for (int b = 0; b < 17; ++b) acc[b] = 0.f;
            LDS_WAIT();
#pragma unroll 1
            for (int kb = 0; kb < 2; ++kb) {
                float wv[16];
#pragma unroll
                for (int kk = 0; kk < 16; ++kk) wv[kk] = wp[(size_t)(kb * 16 + kk) * NMOD];
#pragma unroll
                for (int kk = 0; kk < 16; ++kk) {
#pragma unroll
                    for (int b = 0; b < 17; ++b) acc[b] += scr[b * 128 + kq * 32 + kb * 16 + kk] * wv[kk]; }
            }
            LDS_WAIT();
            float* mod = (float*)(ws + WS_MOD);
            const float bias = (kc == 0) ? a.in[I_BADA][n0 + col] : 0.f;
#pragma unroll
            for (int b = 0; b < 17; ++b) { float v = acc[b]; v += __shfl_xor(v, 16); v += __shfl_xor(v, 32); if (kq == 0) atomicAdd(mod + b * NMOD + n0 + col, v + bias); }
        }
    }
    {
        constexpr int NT = NIT - I_ADA;
        const float* nW = nullptr; bf16_t* nWT = nullptr; int nK = 0, nN = 0, nn0 = 0, nd0 = 0, nk0 = 0; float tvn[32];
#define T_DEC(r_) do { int q_ = (r_); \
        if (q_ < I_A) { nW = a.in[I_FF1IN]; nWT = (bf16_t*)(ws + WS_W1A); nK = D; nN = NFF2; nn0 = (q_ % (NFF2 / 32)) * 32; nd0 = ffin_rowmap(nn0); nk0 = (q_ / (NFF2 / 32)) * 64; } \
        else if ((q_ -= I_A) < I_A) { nW = a.in[I_FF2IN]; nWT = (bf16_t*)(ws + WS_W2A); nK = D; nN = NFF2; nn0 = (q_ % (NFF2 / 32)) * 32; nd0 = ffin_rowmap(nn0); nk0 = (q_ / (NFF2 / 32)) * 64; } \
        else if ((q_ -= I_A) < I_B) { nW = a.in[I_FF1OUT]; nWT = (bf16_t*)(ws + WS_W1B); nK = DFF; nN = D; nn0 = (q_ % (D / 32)) * 32; nd0 = nn0; nk0 = (q_ / (D / 32)) * 64; } \
        else if ((q_ -= I_B) < I_B) { nW = a.in[I_FF2OUT]; nWT = (bf16_t*)(ws + WS_W2B); nK = DFF; nN = D; nn0 = (q_ % (D / 32)) * 32; nd0 = nn0; nk0 = (q_ / (D / 32)) * 64; } \
        else if ((q_ -= I_B) < I_IN) { nW = a.in[I_WIN]; nWT = (bf16_t*)(ws + WS_WIN); nK = D; nN = 2592; nn0 = (q_ % (2592 / 32)) * 32; nd0 = win_rowmap(nn0); nk0 = (q_ / (2592 / 32)) * 64; } \
        else { q_ -= I_IN; nW = a.in[I_WOUT]; nWT = (bf16_t*)(ws + WS_WOUT); nK = D; nN = D; nn0 = (q_ % (D / 32)) * 32; nd0 = nn0; nk0 = (q_ / (D / 32)) * 64; } \
        _Pragma("unroll") for (int i = 0; i < 32; ++i) tvn[i] = nW[(size_t)(nk0 + 2 * i + (lane >> 5)) * nN + nn0 + (lane & 31)]; } while (0)
        if (gw < NT) T_DEC(gw);
        for (int r = gw; r < NT; r += NGW) {
            bf16_t* const cWT = nWT; const int cK = nK, cd0 = nd0, ck0 = nk0;
#pragma unroll
            for (int i = 0; i < 32; ++i) scr[(2 * i + (lane >> 5)) * 33 + (lane & 31)] = tvn[i];
            if (r + NGW < NT) T_DEC(r + NGW);
            LDS_WAIT();
            const int c = lane & 7;
#pragma unroll
            for (int j = 0; j < 4; ++j) { const int n = (lane >> 3) + 8 * j; const float* sp = scr + (8 * c) * 33 + n;
                u32x4 o; o.x = cvt_pk_bf16(sp[0 * 33], sp[1 * 33]); o.y = cvt_pk_bf16(sp[2 * 33], sp[3 * 33]); o.z = cvt_pk_bf16(sp[4 * 33], sp[5 * 33]); o.w = cvt_pk_bf16(sp[6 * 33], sp[7 * 33]);
                *(u32x4*)(cWT + (size_t)(cd0 + n) * cK + ck0 + 8 * c) = o; }
            LDS_WAIT();
        }
#undef T_DEC
    }
    const int gt = gw * 64 + lane, NGT = NGW * 64;
    for (int i = gt; i < 8 * 128 * 128 / 2; i += NGT) { const float2 v = ((const float2*)a.in[I_WS])[i]; ((unsigned*)(ws + WS_WS))[i] = cvt_pk_bf16(v.x, v.y); }
    for (int i = gt; i < (ZW - 2592) * D / 2; i += NGT) ((unsigned*)(ws + WS_WIN + (size_t)2592 * D * 2))[i] = 0u;
}

DEV void norm_mod_phase(const float* src_lat, const float* src_ctx, int nrows, const float* g, const float* mod, int shift_i, int scale_i, bf16_t* XN, int gw, int NGW, int lane) {
    for (int row = 2 * gw; row < nrows; row += 2 * NGW) {
        const bool lat = row < MLAT; const int b = lat ? (row >> 12) : 16;
        const f32x4* xr = (const f32x4*)(lat ? src_lat + (size_t)row * D : src_ctx + (size_t)(row - MLAT) * D) + lane;
        f32x4 v[2][4], gm[4], sh[4];
#pragma unroll
        for (int r = 0; r < 2; ++r)
#pragma unroll
            for (int j = 0; j < 4; ++j) v[r][j] = __builtin_nontemporal_load(&xr[r * 256 + 64 * j]);
        const f32x4* gp = (const f32x4*)g + lane; const f32x4* scp = (const f32x4*)(mod + (size_t)b * NMOD + scale_i * D) + lane; const f32x4* shp = (const f32x4*)(mod + (size_t)b * NMOD + shift_i * D) + lane;
#pragma unroll
        for (int j = 0; j < 4; ++j) { gm[j] = gp[64 * j] * (scp[64 * j] + 1.f); sh[j] = shp[64 * j]; }
#pragma unroll
        for (int r = 0; r < 2; ++r) {
            float s = 0.f;
#pragma unroll
            for (int j = 0; j < 4; ++j) s += (v[r][j].x * v[r][j].x + v[r][j].y * v[r][j].y) + (v[r][j].z * v[r][j].z + v[r][j].w * v[r][j].w);
            const float rstd = rsqrtf(wave_sum(s) * (1.f / D) + EPS);
            u32x2* o8 = (u32x2*)(XN + (size_t)(row + r) * D) + lane;
#pragma unroll
            for (int j = 0; j < 4; ++j) { const f32x4 y = (v[r][j] * rstd) * gm[j] + sh[j]; u32x2 w; w.x = cvt_pk_bf16(y.x, y.y); w.y = cvt_pk_bf16(y.z, y.w); o8[64 * j] = w; }
        }
    }
}
DEV void final_norm_phase(float* xo, const float* g, int gw, int NGW, int lane) {
    const f32x4* gp = (const f32x4*)g + lane;
    f32x4 gm[4];
#pragma unroll
    for (int j = 0; j < 4; ++j) gm[j] = gp[64 * j];
    for (int vr = 2 * gw; vr < MLAT; vr += 2 * NGW) {
        const int rnd = 3 - (vr >> 14), wv = vr & 16383, row = (((wv >> 11) * 32 + rnd * 8 + ((wv >> 8) & 7)) << 8) + (wv & 255);
        f32x4* xr = (f32x4*)(xo + (size_t)row * D) + lane;
        f32x4 v[2][4];
#pragma unroll
        for (int r = 0; r < 2; ++r)
#pragma unroll
            for (int j = 0; j < 4; ++j) v[r][j] = xr[r * 256 + 64 * j];
#pragma unroll
        for (int r = 0; r < 2; ++r) {
            float s = 0.f;
#pragma unroll
            for (int j = 0; j < 4; ++j) s += (v[r][j].x * v[r][j].x + v[r][j].y * v[r][j].y) + (v[r][j].z * v[r][j].z + v[r][j].w * v[r][j].w);
            const float rstd = rsqrtf(wave_sum(s) * (1.f / D) + EPS);
#pragma unroll
            for (int j = 0; j < 4; ++j) __builtin_nontemporal_store((v[r][j] * rstd) * gm[j], &xr[r * 256 + 64 * j]);
        }
    }
}

DEV void shiftw_phase(const bf16_t* Wt, int N, const float* mod, int shift_i, float* shw, int gw, int NGW, int lane) {
    for (int n = gw; n < N; n += NGW) {
        float wv[16]; { float f[8]; unpack8(*(const u32x4*)(Wt + (size_t)n * D + lane * 16), f);
#pragma unroll
            for (int j = 0; j < 8; ++j) wv[j] = f[j];
            unpack8(*(const u32x4*)(Wt + (size_t)n * D + lane * 16 + 8), f);
#pragma unroll
            for (int j = 0; j < 8; ++j) wv[8 + j] = f[j]; }
        float mine = 0.f;
#pragma unroll 6
        for (int b = 0; b < 17; ++b) {
            const f32x4* sp = (const f32x4*)(mod + (size_t)b * NMOD + shift_i * D + lane * 16); float s = 0.f;
#pragma unroll
            for (int q = 0; q < 4; ++q) { const f32x4 v = sp[q]; s += (v.x * wv[4 * q] + v.y * wv[4 * q + 1]) + (v.z * wv[4 * q + 2] + v.w * wv[4 * q + 3]); }
            s = wave_sum(s); if (lane == b) mine = s;
        }
        if (lane < 17) shw[(size_t)lane * N + n] = mine;
    }
}

DEV void conv_phase(const bf16_t* Z, const float* cw, bf16_t* QKV, int G) {
    const int gt = blockIdx.x * 512 + threadIdx.x, cgi = gt & 127, ch0 = cgi * 8;
    float w[9][8];
#pragma unroll
    for (int t = 0; t < 9; ++t) { const f32x4 a = *(const f32x4*)(cw + t * 1024 + ch0), b = *(const f32x4*)(cw + t * 1024 + ch0 + 4); w[t][0] = a.x; w[t][1] = a.y; w[t][2] = a.z; w[t][3] = a.w; w[t][4] = b.x; w[t][5] = b.y; w[t][6] = b.z; w[t][7] = b.w; }
    const float qs = (ch0 < 256) ? 0.125f : 1.f;
    const u32x4 zero4 = {0u, 0u, 0u, 0u};
    for (int sid = gt >> 7; sid < NB * 64; sid += (G * 512) >> 7) {
        const int cc = sid & 63, b = sid >> 6; const bool hasL = cc > 0, hasR = cc < 63;
        const bf16_t* zp = Z + (size_t)(b * SEQ + cc) * ZW + ch0;
        bf16_t* op = QKV + (size_t)(b * SEQ + cc) * D + ch0;
        float win[3][3][8];
        u32x4 raw[3];
#define CV_LOAD(r_) do { const bf16_t* q_ = zp + (size_t)(r_) * 64 * ZW; const bool v_ = (r_) < 64; \
        raw[0] = (v_ && hasL) ? *(const u32x4*)(q_ - ZW) : zero4; raw[1] = v_ ? *(const u32x4*)q_ : zero4; raw[2] = (v_ && hasR) ? *(const u32x4*)(q_ + ZW) : zero4; } while (0)
#define CV_UNPACK(slot_) do { unpack8(raw[0], win[slot_][0]); unpack8(raw[1], win[slot_][1]); unpack8(raw[2], win[slot_][2]); } while (0)
#define CV_STEP(r_, top_, mid_, bot_) do { if ((r_) < 64) { float acc[8]; \
        _Pragma("unroll") for (int j = 0; j < 8; ++j) { float s_ = 0.f; \
            _Pragma("unroll") for (int dx = 0; dx < 3; ++dx) s_ += w[dx][j] * win[top_][dx][j] + w[3 + dx][j] * win[mid_][dx][j] + w[6 + dx][j] * win[bot_][dx][j]; \
            acc[j] = silu_f(s_) * qs; } \
        *(u32x4*)(op + (size_t)(r_) * 64 * D) = pack8(acc); \
        CV_UNPACK(top_); CV_LOAD((r_) + 3); } } while (0)
#pragma unroll
        for (int dx = 0; dx < 3; ++dx)
#pragma unroll
            for (int j = 0; j < 8; ++j) win[2][dx][j] = 0.f;
        CV_LOAD(0); CV_UNPACK(0); CV_LOAD(1); CV_UNPACK(1); CV_LOAD(2);
        for (int r = 0; r < 66; r += 3) { CV_STEP(r, 2, 0, 1); CV_STEP(r + 1, 0, 1, 2); CV_STEP(r + 2, 1, 2, 0); }
#undef CV_LOAD
#undef CV_UNPACK
#undef CV_STEP
    }
    for (int row = MLAT + (gt >> 7); row < MALL; row += (G * 512) >> 7) {
        float acc[8];
#pragma unroll
        for (int j = 0; j < 8; ++j) acc[j] = 0.f;
        const int t = (row - MLAT) & 255;
#pragma unroll
        for (int dx = -1; dx <= 1; ++dx) { const int t2 = t + dx;
            if (t2 >= 0 && t2 < 256) { float f[8]; unpack8(*(const u32x4*)(Z + (size_t)(row + dx) * ZW + ch0), f);
#pragma unroll
                for (int j = 0; j < 8; ++j) acc[j] += w[3 + dx + 1][j] * f[j]; } }
#pragma unroll
        for (int j = 0; j < 8; ++j) acc[j] = silu_f(acc[j]) * qs;
        *(u32x4*)(QKV + (size_t)row * D + ch0) = pack8(acc);
    }
}

constexpr int L_GLR = 0, L_B = 8192, BP = 68, L_TOT = L_B + 2 * 64 * BP * 4, L_Q = L_TOT + 2048, QP = 72, L_K = L_Q + 2 * 64 * QP * 2, L_KHT = L_K + 2 * 64 * QP * 2, L_VT = L_KHT + 2 * 64 * QP * 2,
              L_P = L_VT + 128 * QP * 2, PP = 136, L_G1END = L_P + 64 * PP * 2;
static_assert(L_G1END <= LDS_BYTES, "G1 LDS");
DEV void gla_unit_rows(int u, int& b, int& c, int& h, int& row0) {
    if (u < NU_LAT) { b = u >> 8; c = (u >> 2) & 63; h = u & 3; row0 = b * SEQ + c * 64; }
    else { const int v = u - NU_LAT; b = v >> 4; c = (v >> 2) & 3; h = v & 3; row0 = MLAT + b * CTXL + c * 64; }
}
DEV void g1_phase(const Args& a, unsigned char* lds, int G) {
    unsigned char* ws = a.ws;
    const bf16_t* Z = (const bf16_t*)(ws + WS_ZH); const bf16_t* QKV = (const bf16_t*)(ws + WS_XN);
    bf16_t* QT = (bf16_t*)(ws + WS_QT); bf16_t* OI = (bf16_t*)(ws + WS_OI); bf16_t* KV = (bf16_t*)(ws + WS_KV); float* DEC = (float*)(ws + WS_DEC);
    const int t = threadIdx.x, lane = t & 63, w = t >> 6, ln = lane & 15, kg = lane >> 4;
    float* sB = (float*)(lds + L_B);
    bf16_t* sQ = (bf16_t*)(lds + L_Q); bf16_t* sK = (bf16_t*)(lds + L_K); bf16_t* sKhT = (bf16_t*)(lds + L_KHT); bf16_t* sVT = (bf16_t*)(lds + L_VT); bf16_t* sP = (bf16_t*)(lds + L_P);
    const int gdir = w >> 2, dkt = w & 3;
#define G1_LOAD(u_) do { int b_, c_, h_, r_; gla_unit_rows((u_), b_, c_, h_, r_); \
        _Pragma("unroll") for (int pt = 0; pt < 4; ++pt) gfn[pt] = (kg < 2) ? *(const u32x4*)(Z + (size_t)(r_ + pt * 16 + ln) * ZW + ZC_GLR + gdir * 16 + kg * 8) : (u32x4){0u, 0u, 0u, 0u}; \
        const bf16_t* qp_ = QKV + (size_t)(r_ + (t & 63)) * D + (t >> 6) * 8; \
        qn = *(const u32x4*)(qp_ + h_ * 64); kn = *(const u32x4*)(qp_ + 256 + h_ * 64); vn0 = *(const u32x4*)(qp_ + 512 + h_ * 128); vn1 = *(const u32x4*)(qp_ + 512 + h_ * 128 + 64); } while (0)
#define G1_WLOAD(h_) do { const float* wg_ = a.in[gdir ? I_WGB : I_WGF] + (h_) * 64 + dkt * 16 + ln; float wv_[8]; \
        _Pragma("unroll") for (int j = 0; j < 8; ++j) wv_[j] = (kg < 2) ? wg_[(kg * 8 + j) * 256] : 0.f; \
        const u32x4 wp_ = pack8(wv_); wfrag = __builtin_bit_cast(bf16x8, wp_); bias4 = *(const f32x4*)(a.in[gdir ? I_BGB : I_BGF] + (h_) * 64 + dkt * 16 + kg * 4); } while (0)
#define DPP_SHR(x_, n_) __builtin_bit_cast(float, __builtin_amdgcn_update_dpp(0, __builtin_bit_cast(int, (x_)), 0x110 | (n_), 0xf, 0xf, true))
    u32x4 qn, kn, vn0, vn1, gfn[4];
    if ((int)blockIdx.x < NU_ALL) G1_LOAD((int)blockIdx.x);
    bf16x8 wfrag; f32x4 bias4; int hcur = blockIdx.x & 3;
    G1_WLOAD(hcur);
    for (int u = blockIdx.x; u < NU_ALL; u += G) {
        int b, c, h, row0; gla_unit_rows(u, b, c, h, row0); const bool lat = u < NU_LAT;
        if (h != hcur) { hcur = h; G1_WLOAD(h); }
        const int pos = t & 63, g8 = t >> 6;
        const u32x4 qraw = qn, kraw = kn, vraw0 = vn0, vraw1 = vn1;
        u32x4 gf[4];
#pragma unroll
        for (int pt = 0; pt < 4; ++pt) gf[pt] = gfn[pt];
        if (u + G < NU_ALL) G1_LOAD(u + G);
        {
            float gl[4][4], cs[4][4], tot[4];
#pragma unroll
            for (int pt = 0; pt < 4; ++pt) {
                f32x4 pre = mfma16(wfrag, __builtin_bit_cast(bf16x8, gf[pt]), bias4);
#pragma unroll
                for (int r = 0; r < 4; ++r) { const float x = pre[r]; const float ls = (fminf(x, 0.f) - __logf(1.f + __expf(-fabsf(x)))) * (1.f / 16.f); gl[pt][r] = ls;
                    float sc = ls; sc += DPP_SHR(sc, 1); sc += DPP_SHR(sc, 2); sc += DPP_SHR(sc, 4); sc += DPP_SHR(sc, 8); cs[pt][r] = sc; }
            }
#pragma unroll
            for (int r = 0; r < 4; ++r) { float off = 0.f;
#pragma unroll
                for (int pt = 0; pt < 4; ++pt) { const float tt = __shfl(cs[pt][r], (lane & 48) | 15); cs[pt][r] += off; off += tt; }
                tot[r] = off; }
            if (gdir) {
#pragma unroll
                for (int pt = 0; pt < 4; ++pt)
#pragma unroll
                    for (int r = 0; r < 4; ++r) cs[pt][r] = tot[r] - cs[pt][r] + gl[pt][r];
            }
#pragma unroll
            for (int pt = 0; pt < 4; ++pt) *(f32x4*)(sB + (gdir * 64 + pt * 16 + ln) * BP + dkt * 16 + kg * 4) = (f32x4){cs[pt][0], cs[pt][1], cs[pt][2], cs[pt][3]};
            if (ln == 15) *(f32x4*)(DEC + ((size_t)u * 2 + gdir) * 64 + dkt * 16 + kg * 4) = (f32x4){__expf(tot[0]), __expf(tot[1]), __expf(tot[2]), __expf(tot[3])};
        }
        LBAR();
        {
            float q[8], k[8]; unpack8(qraw, q); unpack8(kraw, k);
            const unsigned tsel = (lane & 1) ? 0x03020706u : 0x05040100u;
#pragma unroll
            for (int dir = 0; dir < 2; ++dir) {
                const float* bp = sB + (dir * 64 + pos) * BP + g8 * 8; const float* bl = sB + (dir * 64 + (dir ? 0 : 63)) * BP + g8 * 8;
                const f32x4 b0 = *(const f32x4*)bp, b1 = *(const f32x4*)(bp + 4), l0 = *(const f32x4*)bl, l1 = *(const f32x4*)(bl + 4);
                float qt[8], kt[8], kh[8];
#pragma unroll
                for (int j = 0; j < 8; ++j) { const float bb = j < 4 ? b0[j] : b1[j - 4], ll = j < 4 ? l0[j] : l1[j - 4]; qt[j] = q[j] * __expf(bb); kt[j] = k[j] * __expf(-bb); kh[j] = k[j] * __expf(ll - bb); }
                const u32x4 qw = pack8(qt), kw = pack8(kt), hw = pack8(kh);
                *(u32x4*)(sQ + (dir * 64 + pos) * QP + g8 * 8) = qw;
                *(u32x4*)(sK + (dir * 64 + pos) * QP + g8 * 8) = kw;
                { unsigned* kp = (unsigned*)(sKhT + (dir * 64 + g8 * 8 + (lane & 1)) * QP + (pos & ~1));
#pragma unroll
                  for (int d = 0; d < 4; ++d) { const unsigned own = hw[d], oth = (unsigned)__builtin_amdgcn_update_dpp(0, (int)own, 0xB1, 0xf, 0xf, true);
                      kp[d * QP] = __builtin_amdgcn_perm(oth, own, tsel); } }
            }
#pragma unroll
            for (int i = 0; i < 2; ++i) { const u32x4 vw = i ? vraw1 : vraw0; unsigned* vp = (unsigned*)(sVT + ((g8 + 8 * i) * 8 + (lane & 1)) * QP + (pos & ~1));
#pragma unroll
                for (int d = 0; d < 4; ++d) { const unsigned own = vw[d], oth = (unsigned)__builtin_amdgcn_update_dpp(0, (int)own, 0xB1, 0xf, 0xf, true);
                    vp[d * QP] = __builtin_amdgcn_perm(oth, own, tsel); } }
        }
        LBAR();
        if (lat) {
            const int p2 = t >> 3, g2 = (t & 7) * 8;
#pragma unroll
            for (int dir = 0; dir < 2; ++dir) *(u32x4*)(QT + (size_t)(row0 + p2) * 512 + dir * 256 + h * 64 + g2) = *(const u32x4*)(sQ + (dir * 64 + p2) * QP + g2);
        }
        {
            const int dir = w >> 2, it = w & 3;
            bf16x8 qf[2];
#pragma unroll
            for (int ks = 0; ks < 2; ++ks) qf[ks] = *(const bf16x8*)(sQ + (dir * 64 + it * 16 + ln) * QP + ks * 32 + kg * 8);
#pragma unroll
            for (int jt = 0; jt < 4; ++jt) {
                f32x4 acc = {0.f, 0.f, 0.f, 0.f};
                const bool live = dir ? (jt >= it) : (jt <= it);
                if (live) {
#pragma unroll
                    for (int ks = 0; ks < 2; ++ks) { const bf16x8 kf = *(const bf16x8*)(sK + (dir * 64 + jt * 16 + ln) * QP + ks * 32 + kg * 8); acc = mfma16(kf, qf[ks], acc); }
                }
                const int i = it * 16 + ln, j0 = jt * 16 + kg * 4;
                float pv[4];
#pragma unroll
                for (int r = 0; r < 4; ++r) { const int j = j0 + r; const bool keep = dir ? (j >= i) : (j <= i); pv[r] = keep ? acc[r] : 0.f; }
                u32x2 pw; pw.x = cvt_pk_bf16(pv[0], pv[1]); pw.y = cvt_pk_bf16(pv[2], pv[3]);
                *(u32x2*)(sP + i * PP + dir * 64 + j0) = pw;
            }
        }
        LBAR();
        if (lat) {
            const int it = w & 3, half = w >> 2;
            f32x4 acc[4];
#pragma unroll
            for (int d = 0; d < 4; ++d) acc[d] = (f32x4){0.f, 0.f, 0.f, 0.f};
#pragma unroll
            for (int ks = 0; ks < 4; ++ks) {
                const bf16x8 pf = *(const bf16x8*)(sP + (it * 16 + ln) * PP + ks * 32 + kg * 8);
#pragma unroll
                for (int d = 0; d < 4; ++d) { const bf16x8 vf = *(const bf16x8*)(sVT + (half * 64 + (d >> 1) * 32 + prow(d & 1, ln)) * QP + (ks & 1) * 32 + kg * 8); acc[d] = mfma16(vf, pf, acc[d]); }
            }
#pragma unroll
            for (int p = 0; p < 2; ++p) *(u32x4*)(OI + (size_t)(row0 + it * 16 + ln) * 512 + h * 128 + half * 64 + p * 32 + kg * 8) = pack8v(acc[2 * p], acc[2 * p + 1]);
        }
        {
            const int dir = w >> 2;
#pragma unroll
            for (int e = 0; e < 2; ++e) {
                const int dvt = (w & 3) * 2 + e;
                bf16x8 vf[2];
#pragma unroll
                for (int ks = 0; ks < 2; ++ks) vf[ks] = *(const bf16x8*)(sVT + (dvt * 16 + ln) * QP + ks * 32 + kg * 8);
#pragma unroll
                for (int p = 0; p < 2; ++p) {
                    f32x4 acc[2];
#pragma unroll
                    for (int n = 0; n < 2; ++n) { acc[n] = (f32x4){0.f, 0.f, 0.f, 0.f};
#pragma unroll
                        for (int ks = 0; ks < 2; ++ks) { const bf16x8 kf = *(const bf16x8*)(sKhT + (dir * 64 + p * 32 + prow(n, ln)) * QP + ks * 32 + kg * 8); acc[n] = mfma16(kf, vf[ks], acc[n]); } }
                    *(u32x4*)(KV + (((size_t)u * 2 + dir) * 128 + dvt * 16 + ln) * 64 + p * 32 + kg * 8) = pack8v(acc[0], acc[1]);
                }
            }
        }
        LBAR();
    }
}

DEV void g2_phase(const Args& a, int G) {
    unsigned char* ws = a.ws;
    const bf16_t* KV = (const bf16_t*)(ws + WS_KV); const float* DEC = (const float*)(ws + WS_DEC); bf16_t* SB = (bf16_t*)(ws + WS_SB);
    for (int gt = blockIdx.x * 512 + threadIdx.x; gt < 128 * 1024; gt += G * 512) {
        const int s = gt >> 10, rem = gt & 1023, dv = rem >> 3, k8 = (rem & 7) * 8;
        const int b = s >> 3, h = (s >> 1) & 3, dir = s & 1;
        float S[8];
#pragma unroll
        for (int j = 0; j < 8; ++j) S[j] = 0.f;
#pragma unroll 1
        for (int blk = 0; blk < 17; ++blk) {
            u32x4 kvr[4]; f32x4 d0[4], d1[4]; size_t offs[4];
#pragma unroll
            for (int i = 0; i < 4; ++i) {
                const int step = blk * 4 + i; int u;
                if (step < 4) { const int c = dir ? 3 - step : step; u = NU_LAT + b * 16 + c * 4 + h; }
                else { const int c = dir ? 67 - step : step - 4; u = b * 256 + c * 4 + h; }
                offs[i] = (((size_t)u * 2 + dir) * 128 + dv) * 64 + k8;
                kvr[i] = *(const u32x4*)(KV + offs[i]);
                const float* dp = DEC + ((size_t)u * 2 + dir) * 64 + k8; d0[i] = *(const f32x4*)dp; d1[i] = *(const f32x4*)(dp + 4);
            }
#pragma unroll
            for (int i = 0; i < 4; ++i) {
                if (blk > 0) *(u32x4*)(SB + offs[i]) = pack8(S);
                float kv[8]; unpack8(kvr[i], kv);
#pragma unroll
                for (int j = 0; j < 8; ++j) S[j] = (j < 4 ? d0[i][j] : d1[i][j - 4]) * S[j] + kv[j];
            }
        }
    }
}

DEV void g3c1_phase(const Args& a, unsigned char* lds, int G) {
    unsigned char* ws = a.ws;
    const bf16_t* Z = (const bf16_t*)(ws + WS_ZH); const bf16_t* QT = (const bf16_t*)(ws + WS_QT); const bf16_t* OI = (const bf16_t*)(ws + WS_OI); const bf16_t* SB = (const bf16_t*)(ws + WS_SB);
    const bf16_t* WSB = (const bf16_t*)(ws + WS_WS); const float* rowss = (const float*)(ws + WS_RSP); bf16_t* MIX = (bf16_t*)(ws + WS_KV);
    const int t = threadIdx.x, lane = t & 63, w = t >> 6, ln = lane & 15, kg = lane >> 4;
    unsigned* sV = (unsigned*)lds;
    {
        bf16x8 nqf[4]; u32x4 noi[4], nog[4];
#define G3_ROW(pu_) ({ const int u_ = 2 * (pu_) + (w >> 2); (u_ >> 8) * SEQ + ((u_ >> 2) & 63) * 64 + (w & 3) * 16 + ln; })
#define G3_LOAD(pu_) do { const int u_ = 2 * (pu_) + (w >> 2), h_ = u_ & 3; const size_t r_ = (size_t)G3_ROW(pu_); \
        _Pragma("unroll") for (int ks = 0; ks < 4; ++ks) { const int k = ks * 32 + kg * 8; nqf[ks] = *(const bf16x8*)(QT + r_ * 512 + (k >> 6) * 256 + h_ * 64 + (k & 63)); } \
        _Pragma("unroll") for (int p = 0; p < 4; ++p) { noi[p] = *(const u32x4*)(OI + r_ * 512 + h_ * 128 + p * 32 + kg * 8); nog[p] = *(const u32x4*)(Z + r_ * ZW + ZC_OG + h_ * 128 + p * 32 + kg * 8); } } while (0)
        if ((int)blockIdx.x < NU_LAT / 2) G3_LOAD((int)blockIdx.x);
        for (int pu = blockIdx.x; pu < NU_LAT / 2; pu += G) {
            const int u = 2 * pu + (w >> 2), h = u & 3, row = G3_ROW(pu);
            bf16x8 qf[4]; u32x4 oi[4], og[4];
#pragma unroll
            for (int i = 0; i < 4; ++i) { qf[i] = nqf[i]; oi[i] = noi[i]; og[i] = nog[i]; }
            if (pu + G < NU_LAT / 2) G3_LOAD(pu + G);
            f32x4 acc[8];
#pragma unroll
            for (int d = 0; d < 8; ++d) acc[d] = (f32x4){0.f, 0.f, 0.f, 0.f};
#pragma unroll
            for (int ks = 0; ks < 4; ++ks) {
                const int k = ks * 32 + kg * 8, dir = k >> 6, kk = k & 63;
                bf16x8 sf[8];
#pragma unroll
                for (int d = 0; d < 8; ++d) sf[d] = *(const bf16x8*)(SB + (((size_t)u * 2 + dir) * 128 + (d >> 1) * 32 + prow(d & 1, ln)) * 64 + kk);
#pragma unroll
                for (int d = 0; d < 8; ++d) acc[d] = mfma16(sf[d], qf[ks], acc[d]);
            }
            float ss = 0.f;
#pragma unroll
            for (int p = 0; p < 4; ++p) { float f[8]; unpack8(oi[p], f);
#pragma unroll
                for (int j = 0; j < 4; ++j) { acc[2 * p][j] += f[j]; acc[2 * p + 1][j] += f[4 + j]; ss += acc[2 * p][j] * acc[2 * p][j] + acc[2 * p + 1][j] * acc[2 * p + 1][j]; } }
            ss += __shfl_xor(ss, 16); ss += __shfl_xor(ss, 32);
            const float rstd = rsqrtf(ss * (1.f / 128.f) + EPS);
#pragma unroll
            for (int p = 0; p < 4; ++p) { const int dv = p * 32 + kg * 8; float f[8], o[8]; unpack8(og[p], f);
                const f32x4 g0 = *(const f32x4*)(a.in[I_GLAG] + dv), g1 = *(const f32x4*)(a.in[I_GLAG] + dv + 4);
#pragma unroll
                for (int j = 0; j < 4; ++j) { o[j] = acc[2 * p][j] * rstd * g0[j] * f[j]; o[4 + j] = acc[2 * p + 1][j] * rstd * g1[j] * f[4 + j]; }
                *(u32x4*)(MIX + (size_t)row * D + h * 128 + dv) = pack8(o); }
        }
#undef G3_ROW
#undef G3_LOAD
    }
    {
        const int cgi = t & 7, pp = t >> 3;
        int hcur = -1; bf16x8 wf[4]; float bs = 0.f; f32x4 g0 = {0.f, 0.f, 0.f, 0.f}, g1 = g0;
        u32x4 nva, nvb, ngu[2]; f32x4 npa, npb, npc, npd;
#define C1_LOAD(v_) do { const int b_ = (v_) >> 8, n_ = ((v_) >> 3) & 31, hd_ = (v_) & 7, r0_ = b_ * SEQ + n_ * 128; \
        nva = *(const u32x4*)(Z + (size_t)(r0_ + 2 * pp) * ZW + ZC_VS + hd_ * 64 + cgi * 8); nvb = *(const u32x4*)(Z + (size_t)(r0_ + 2 * pp + 1) * ZW + ZC_VS + hd_ * 64 + cgi * 8); \
        const float* rp_ = rowss + (size_t)(r0_ + 2 * pp) * 8; npa = *(const f32x4*)rp_; npb = *(const f32x4*)(rp_ + 4); npc = *(const f32x4*)(rp_ + 8); npd = *(const f32x4*)(rp_ + 12); \
        _Pragma("unroll") for (int p = 0; p < 2; ++p) ngu[p] = *(const u32x4*)(Z + (size_t)(r0_ + w * 16 + ln) * ZW + ZC_U + hd_ * 64 + p * 32 + kg * 8); } while (0)
        if ((int)blockIdx.x < NU_LAT) C1_LOAD((int)blockIdx.x);
        for (int v = blockIdx.x; v < NU_LAT; v += G) {
            const int b = v >> 8, n = (v >> 3) & 31, hd = v & 7, r0 = b * SEQ + n * 128;
            if (hd != hcur) { hcur = hd;
#pragma unroll
                for (int ks = 0; ks < 4; ++ks) wf[ks] = *(const bf16x8*)(WSB + ((size_t)hd * 128 + w * 16 + ln) * 128 + ks * 32 + kg * 8);
                bs = a.in[I_BS][hd * 128 + w * 16 + ln];
                g0 = *(const f32x4*)(a.in[I_CMG] + hd * 64 + cgi * 8); g1 = *(const f32x4*)(a.in[I_CMG] + hd * 64 + cgi * 8 + 4); }
            const u32x4 va = nva, vb = nvb; const f32x4 pa = npa, pb = npb, pc = npc, pd = npd; u32x4 gu[2]; gu[0] = ngu[0]; gu[1] = ngu[1];
            if (v + G < NU_LAT) C1_LOAD(v + G);
            {
                float f0[8], f1[8]; unpack8(va, f0); unpack8(vb, f1);
                const float rs0 = rsqrtf((((pa.x + pa.y) + (pa.z + pa.w)) + ((pb.x + pb.y) + (pb.z + pb.w))) * (1.f / 512.f) + EPS), rs1 = rsqrtf((((pc.x + pc.y) + (pc.z + pc.w)) + ((pd.x + pd.y) + (pd.z + pd.w))) * (1.f / 512.f) + EPS);
#pragma unroll
                for (int j = 0; j < 8; ++j) { const float gj = j < 4 ? g0[j] : g1[j - 4]; const int ch = cgi * 8 + j, fsw = (ch ^ (ch >> 3)) & 15;
                    sV[ch * 64 + (((pp >> 2) ^ fsw) << 2) + (pp & 3)] = cvt_pk_bf16(f0[j] * rs0 * gj, f1[j] * rs1 * gj); }
            }
            LBAR();
            {
                f32x4 acc[4];
#pragma unroll
                for (int d = 0; d < 4; ++d) acc[d] = (f32x4){0.f, 0.f, 0.f, 0.f};
#pragma unroll
                for (int ks = 0; ks < 4; ++ks) {
#pragma unroll
                    for (int d = 0; d < 4; ++d) { const int ch = (d >> 1) * 32 + prow(d & 1, ln), fsw = (ch ^ (ch >> 3)) & 15; const bf16x8 vf = *(const bf16x8*)(sV + ch * 64 + (((ks * 4 + kg) ^ fsw) << 2)); acc[d] = mfma16(vf, wf[ks], acc[d]); }
                }
#pragma unroll
                for (int p = 0; p < 2; ++p) { const int ch = hd * 64 + p * 32 + kg * 8; float f[8], o[8]; unpack8(gu[p], f);
#pragma unroll
                    for (int j = 0; j < 4; ++j) { o[j] = (acc[2 * p][j] + bs) * f[j]; o[4 + j] = (acc[2 * p + 1][j] + bs) * f[4 + j]; }
                    *(u32x4*)(MIX + (size_t)(r0 + w * 16 + ln) * D + 512 + ch) = pack8(o); }
            }
            LBAR();
        }
#undef C1_LOAD
    }
}

#define LAS __attribute__((address_space(3)))
#define XB_TMO      128
#define XB_XCNT(j)  (256  + 64 * (j))
#define XB_XSUB(j)  (1280 + 64 * (j))
#define XB_XGEN(j)  (2304 + 64 * (j))
#define XB_TOP      3328
#define XB_TOPGEN   3392
#define XCD_BAR_WORDS 3456
#define XB_SPIN_CAP (1u << 18)

__device__ __forceinline__ unsigned xb_ld(unsigned* p)              { return __hip_atomic_load(p, __ATOMIC_RELAXED, __HIP_MEMORY_SCOPE_AGENT); }
__device__ __forceinline__ unsigned xb_add(unsigned* p, unsigned v) { return __hip_atomic_fetch_add(p, v, __ATOMIC_RELAXED, __HIP_MEMORY_SCOPE_AGENT); }
__device__ __forceinline__ unsigned xb_xcc_id() { return (unsigned)__builtin_amdgcn_s_getreg((3 << 11) | 20) & 0xFu; }
#define XB_SPIN(cond, bar) do { unsigned _sp = 0; while (cond) { __builtin_amdgcn_s_sleep(1); \
    if ((++_sp & 255u) == 0u) { if (xb_ld(&(bar)[XB_TMO])) break; if (_sp > XB_SPIN_CAP) { atomicAdd(&(bar)[XB_TMO], 1u); break; } } } } while (0)

struct XcdBarrier {
    unsigned* bar; unsigned x;
    volatile LAS unsigned* st;
};

__device__ __forceinline__ XcdBarrier xcd_barrier_post(unsigned* bar, volatile LAS unsigned* st) {
    XcdBarrier b; b.bar = bar; b.x = xb_xcc_id(); b.st = st;
    if (threadIdx.x == 0) (void)xb_add(&bar[XB_XCNT(b.x)], 1u);
    return b;
}
__device__ __forceinline__ void xcd_barrier_complete(unsigned* bar, unsigned x, unsigned& nloc, unsigned& nx) {
    const unsigned G = gridDim.x * gridDim.y * gridDim.z;
    unsigned sum, cnt, mine, sp = 0u;
    for (;;) {
        sum = 0u; cnt = 0u; mine = 0u;
#pragma unroll
        for (unsigned j = 0; j < 16; ++j) { const unsigned c = xb_ld(&bar[XB_XCNT(j)]); sum += c; cnt += (c > 0u) ? 1u : 0u; mine = (j == x) ? c : mine; }
        if (sum == G) break;
        __builtin_amdgcn_s_sleep(1);
        if ((++sp & 255u) == 0u) { if (xb_ld(&bar[XB_TMO])) break; if (sp > XB_SPIN_CAP) { atomicAdd(&bar[XB_TMO], 1u); break; } }
    }
    nloc = mine > 0u ? mine : 1u; nx = cnt > 0u ? cnt : 1u;
}

__device__ __forceinline__ void xcd_barrier(const XcdBarrier& b) {
    asm volatile("s_waitcnt vmcnt(0)" ::: "memory");
    __syncthreads();
    if (threadIdx.x == 0) {
        unsigned* bar = b.bar;
        __builtin_amdgcn_s_waitcnt(0);
        unsigned nloc = b.st[0], nx = b.st[1];
        if (nloc == 0u) { xcd_barrier_complete(bar, b.x, nloc, nx); b.st[0] = nloc; b.st[1] = nx; }
        const unsigned old = xb_add(&bar[XB_XSUB(b.x)], 1u);
        const unsigned gen = old / nloc;
        if (old + 1u == (gen + 1u) * nloc) {
            __builtin_amdgcn_fence(__ATOMIC_RELEASE, "agent");
            asm volatile("s_waitcnt vmcnt(0)" ::: "memory");
            const unsigned og = xb_add(&bar[XB_TOP], 1u);
            const unsigned tg = og / nx;
            if (og + 1u == (tg + 1u) * nx) xb_add(&bar[XB_TOPGEN], 1u);
            else XB_SPIN(xb_ld(&bar[XB_TOPGEN]) == tg, bar);
            __builtin_amdgcn_fence(__ATOMIC_ACQUIRE, "agent");
            xb_add(&bar[XB_XGEN(b.x)], 1u);
            asm volatile("s_waitcnt vmcnt(0)" ::: "memory");
        } else {
            XB_SPIN(xb_ld(&bar[XB_XGEN(b.x)]) == gen, bar);
            __builtin_amdgcn_fence(__ATOMIC_ACQUIRE, "agent");
            asm volatile("s_waitcnt vmcnt(0)" ::: "memory");
        }
    }
    __syncthreads();
}


constexpr int NPHASE = 15;
__global__ void __launch_bounds__(512, 2) fwd_kernel(Args a) {
    extern __shared__ __attribute__((aligned(16))) unsigned char lds[];
    const int G = gridDim.x, tid = threadIdx.x, lane = tid & 63, wave = __builtin_amdgcn_readfirstlane(tid >> 6);
    const int gw = blockIdx.x * 8 + wave, NGW = G * 8;
    unsigned char* ws = a.ws;
    const float* mod = (const float*)(ws + WS_MOD);
    bf16_t* XN = (bf16_t*)(ws + WS_XN); bf16_t* ZH = (bf16_t*)(ws + WS_ZH); float* X1C = (float*)(ws + WS_X1C);
    PG8_LAS unsigned char* ldsg = (PG8_LAS unsigned char*)lds;
    const int lo = a.ph_lo, hi = a.ph_hi;
    volatile LAS unsigned* bst = (volatile LAS unsigned*)(ldsg + (LDS_BYTES - 64));
    if (tid == 0) { bst[0] = 0u; bst[1] = 0u; }
    __syncthreads();
    XcdBarrier xbar; xbar.bar = (unsigned*)(ws + WS_CTL); xbar.x = 0; xbar.st = bst;
    if (hi - lo > 1) xbar = xcd_barrier_post((unsigned*)(ws + WS_CTL), bst);
#define IN(k) (lo <= (k) && (k) < hi)
#define SEAM(k) do { if (IN(k) && IN((k) + 1)) { if (a.ph_hi > 4096) cg::this_grid().sync(); else xcd_barrier(xbar); } } while (0)
    if (IN(0)) { p0_prep(a, lds, gw, NGW, wave, lane); } SEAM(0);
    if (IN(1)) { norm_mod_phase(a.in[I_X], a.in[I_CTX], MALL, a.in[I_N1G], mod, 0, 1, XN, gw, NGW, lane);
        shiftw_phase((const bf16_t*)(ws + WS_WIN), ZW, mod, 3, (float*)(ws + WS_SHW1), gw, NGW, lane); shiftw_phase((const bf16_t*)(ws + WS_W2A), NFF2, mod, 6, (float*)(ws + WS_SHW2), gw, NGW, lane); } SEAM(1);
    if (IN(2)) { pg8::Gemm g{XN, (const bf16_t*)(ws + WS_W1A), MALL, NFF2, D}; pg8::StaticOrder S; S.init(MALL, NFF2, G, (int)blockIdx.x); EpiSwiGLU<false> E{ZH, nullptr, nullptr};
        pg8::gemm_phase<EpiSwiGLU<false>, pg8::StaticOrder, true, true>(ldsg, g, S, E); } SEAM(2);
    if (IN(3)) { pg8::Gemm g{ZH, (const bf16_t*)(ws + WS_W1B), MALL, D, DFF}; pg8::StaticOrder S; S.init(MALL, D, G, (int)blockIdx.x); typedef EpiResid<2, true, true, 4> EpiT; EpiT E{a.in[I_X], a.in[I_CTX], a.out, X1C, mod, XN, a.in[I_N2G], (float*)(ws + WS_RS2)};
        pg8::gemm_phase<EpiT, pg8::StaticOrder, true, true>(ldsg, g, S, E); } SEAM(3);
    if (IN(5)) { pg8::Gemm g{XN, (const bf16_t*)(ws + WS_WIN), MALL, ZW, D}; pg8::StaticOrder S; S.init(MALL, ZW, G, (int)blockIdx.x); EpiZ E{ZH, (float*)(ws + WS_RSP), (const float*)(ws + WS_RS2), (const float*)(ws + WS_SHW1)};
        pg8::gemm_phase<EpiZ, pg8::StaticOrder, true, true>(ldsg, g, S, E); } SEAM(5);
    if (IN(6)) { conv_phase(ZH, a.in[I_CONVW], XN, G); } SEAM(6);
    if (IN(7)) { g1_phase(a, lds, G); } SEAM(7);
    if (IN(8)) { g2_phase(a, G); } SEAM(8);
    if (IN(9)) { g3c1_phase(a, lds, G); } SEAM(9);
    if (IN(10)) { pg8::Gemm g{(const bf16_t*)(ws + WS_KV), (const bf16_t*)(ws + WS_WOUT), MLAT, D, D}; pg8::StaticOrder S; S.init(MLAT, D, G, (int)blockIdx.x); typedef EpiResid<5, false, true, 7> EpiT; EpiT E{a.out, a.out, a.out, a.out, mod, XN, a.in[I_N3G], (float*)(ws + WS_RS3)};
        pg8::gemm_phase<EpiT, pg8::StaticOrder, true, true>(ldsg, g, S, E); } SEAM(10);
    if (IN(12)) { pg8::Gemm g{XN, (const bf16_t*)(ws + WS_W2A), MLAT, NFF2, D}; pg8::StaticOrder S; S.init(MLAT, NFF2, G, (int)blockIdx.x); EpiSwiGLU<true> E{ZH, (const float*)(ws + WS_RS3), (const float*)(ws + WS_SHW2)};
        pg8::gemm_phase<EpiSwiGLU<true>, pg8::StaticOrder, true, true>(ldsg, g, S, E); } SEAM(12);
    if (IN(13)) { pg8::Gemm g{ZH, (const bf16_t*)(ws + WS_W2B), MLAT, D, DFF}; pg8::StaticOrder S; S.init(MLAT, D, G, (int)blockIdx.x); typedef EpiResid<8, true, false, 0> EpiT; EpiT E{a.out, a.out, a.out, a.out, mod, nullptr, nullptr, nullptr};
        pg8::gemm_phase<EpiT, pg8::StaticOrder, true, true>(ldsg, g, S, E); } SEAM(13);
    if (IN(14)) { final_norm_phase(a.out, a.in[I_FING], gw, NGW, lane); }
#if defined(MK_EXTRA_SYNC) && MK_EXTRA_SYNC
    if (hi - lo > 1) for (int i = 0; i < MK_EXTRA_SYNC; ++i) cg::this_grid().sync();
#endif
#undef IN
#undef SEAM
}


extern "C" void kernel_launch(void* const* d_in, const int* in_sizes, int n_in, void* d_out, int out_size, void* d_ws, size_t ws_size, hipStream_t stream) {
    static int grid = 0;
    if (grid == 0) {
        if (n_in != 25 || out_size != MLAT * D || ws_size < WS_END) { fprintf(stderr, "kernel_launch: unexpected shapes (n_in %d, out %d, ws %zu; need ws >= %zu)\n", n_in, out_size, ws_size, (size_t)WS_END); grid = -1; return; }
        int dev = 0, cus = 0, per_cu = 0;
        (void)hipGetDevice(&dev); (void)hipDeviceGetAttribute(&cus, hipDeviceAttributeMultiprocessorCount, dev);
        if (hipFuncSetAttribute((const void*)fwd_kernel, hipFuncAttributeMaxDynamicSharedMemorySize, LDS_BYTES) != hipSuccess) { fprintf(stderr, "kernel_launch: hipFuncSetAttribute failed\n"); grid = -1; return; }
        if (hipOccupancyMaxActiveBlocksPerMultiprocessor(&per_cu, (const void*)fwd_kernel, 512, LDS_BYTES) != hipSuccess || per_cu < 1) { fprintf(stderr, "kernel_launch: occupancy query says %d\n", per_cu); per_cu = 1; }
        (void)hipGetLastError();
        grid = cus * per_cu;
    }
    if (grid < 0) return;
    (void)hipMemsetAsync((char*)d_ws + WS_CTL, 0, 1 << 20, stream);
    Args a{};
    for (int i = 0; i < 25; ++i) a.in[i] = (const float*)d_in[i];
    a.out = (float*)d_out; a.ws = (unsigned char*)d_ws;
#if MK_ONE_LAUNCH
    a.ph_lo = 0; a.ph_hi = NPHASE;
    void* args[] = {&a};
    hipError_t e = hipLaunchCooperativeKernel((const void*)fwd_kernel, dim3(grid), dim3(512), args, LDS_BYTES, stream);
    if (e != hipSuccess) fprintf(stderr, "cooperative launch failed: %s (grid %d)\n", hipGetErrorString(e), grid);
#if defined(MK_DUP) && MK_DUP
    for (int p = 0; p < NPHASE; ++p) if ((MK_DUP >> p) & 1) { a.ph_lo = p; a.ph_hi = p + 1; hipLaunchKernelGGL(fwd_kernel, dim3(grid), dim3(512), LDS_BYTES, stream, a); }
#endif
#else
    for (int p = 0; p < NPHASE; ++p) { a.ph_lo = p; a.ph_hi = p + 1; hipLaunchKernelGGL(fwd_kernel, dim3(grid), dim3(512), LDS_BYTES, stream, a); }
#endif
}
```

```cpp
#include <hip/hip_runtime.h>
#include <hip/hip_cooperative_groups.h>
#include <cstdio>
#include <cstdint>
namespace cg = cooperative_groups;
#ifndef MK_ONE_LAUNCH
#define MK_ONE_LAUNCH 1
#endif
#ifndef MK_DUP
#define MK_DUP 0
#endif
#ifndef MK_EXTRA_SYNC
#define MK_EXTRA_SYNC 0
#endif
namespace pg8 {
#define PG8_LAS __attribute__((address_space(3)))
typedef unsigned short bf16_t;
typedef short bf16x8 __attribute__((ext_vector_type(8)));
typedef float f32x4 __attribute__((ext_vector_type(4)));
typedef unsigned u32x4 __attribute__((ext_vector_type(4)));
constexpr int BM = 256, BK = 64, HALF = 128, HTB = HALF * BK * 2  , STAGE_BYTES = 8 * HTB, NXCD = 8, WGM = 8;

__host__ __device__ __forceinline__ int lds_byte(int r, int c) { const int st = (r >> 4) * 2 + (c >> 5), rr = r & 15, cc = c & 31, ob = rr * 64 + cc * 2; return st * 1024 + (ob ^ (((ob >> 9) & 1) << 5)); }
__host__ __device__ __forceinline__ void stage_rc(int b, int& R, int& C) { const int st = b / 1024, sb = b % 1024, swz = sb ^ (((sb >> 9) & 1) << 5); R = (st >> 1) * 16 + swz / 64; C = (st & 1) * 32 + (swz % 64) / 2; }
__host__ __device__ __forceinline__ int perm32(int rho) { const int n = rho >> 4, i = rho & 15; return 8 * (i >> 2) + 4 * n + (i & 3); }

struct Unit { int pm, pn; };
struct Gemm { const bf16_t* A; const bf16_t* Bt; int M, N, K; };

struct StaticOrder {
    int nM, nN, nwg, G, c;
    __host__ __device__ void init(int M, int N, int G_, int c_) { nM = M / BM; nN = N / BM; nwg = nM * nN; G = G_; c = c_; }
    __host__ __device__ bool next(int i, Unit& u) const {
        const long L = (long)i * G + c; if (L >= nwg) return false;
        int wgid = (int)L; { const int q = nwg / NXCD, r = nwg % NXCD, xcd = wgid % NXCD, off = wgid / NXCD; wgid = (xcd < r ? xcd * (q + 1) : r * (q + 1) + (xcd - r) * q) + off; }
        const int nig = WGM * nN, gid = wgid / nig, fm = gid * WGM, gsz = (nM - fm) < WGM ? (nM - fm) : WGM;
        u.pm = fm + ((wgid % nig) % gsz); u.pn = (wgid % nig) / gsz; return true;
    }
    __device__ __forceinline__ void a_ready(const Unit&) const {}
    __device__ __forceinline__ void done(const Unit&) const {}
};

typedef float f32x2_t __attribute__((ext_vector_type(2))); typedef __bf16 bf16x2_t __attribute__((ext_vector_type(2)));
__device__ __forceinline__ unsigned cvt_pk_bf16(float lo, float hi) { f32x2_t v = {lo, hi}; bf16x2_t b = __builtin_convertvector(v, bf16x2_t); return __builtin_bit_cast(unsigned, b); }
template <class Epi, class Sched, bool ALIGN_EPI = false, bool SP2 = false>
__device__ __forceinline__ void gemm_phase(PG8_LAS unsigned char* lds, const Gemm g, const Sched& S, const Epi& E) {
    const int tid = threadIdx.x, wid = __builtin_amdgcn_readfirstlane(tid >> 6), lane = tid & 63, wr = wid >> 2, wc = wid & 3, fr = lane & 15, fq = lane >> 4;
    const int K = g.K, nt = K / BK;
    unsigned voffA[2], voffB[2];
#pragma unroll
    for (int i = 0; i < 2; ++i) { int R, C; stage_rc(tid * 16 + i * 8192, R, C); const int Rb = Epi::PERM ? ((R & ~31) + perm32(R & 31)) : R;
        voffA[i] = (unsigned)(R * K + C) * 2u; voffB[i] = (unsigned)(Rb * K + C) * 2u; }
    const size_t kstep = (size_t)(BK * 2);
    const size_t hstep = (size_t)HALF * K * 2;
    const size_t tstep = 2 * hstep;
    const unsigned ldsw = (unsigned)wid * 1024u;
    const int aoff = lds_byte(wr * 64 + fr, fq * 8), boff = lds_byte(wc * 32 + fr, fq * 8);
#define PG8_SA(b, h) (((b) * 2 + (h)) * HTB)
#define PG8_SB(b, h) ((4 + (b) * 2 + (h)) * HTB)
#define PG8_STAGE(bufoff, gbase, voff) do { _Pragma("unroll") for (int _i = 0; _i < 2; ++_i) \
        __builtin_amdgcn_global_load_lds((const unsigned*)((const char*)(gbase) + (voff)[_i]), (PG8_LAS unsigned*)(lds + (bufoff) + ldsw + _i * 8192), 16, 0, 0); } while (0)
#define PG8_LDA(dst, b, h) do { _Pragma("unroll") for (int m = 0; m < 4; ++m) _Pragma("unroll") for (int k = 0; k < 2; ++k) dst[m][k] = *(const PG8_LAS bf16x8*)(lds + PG8_SA(b, h) + aoff + m * 2048 + k * 1024); } while (0)
#define PG8_LDB(dst, b, h) do { _Pragma("unroll") for (int n = 0; n < 2; ++n) _Pragma("unroll") for (int k = 0; k < 2; ++k) dst[n][k] = *(const PG8_LAS bf16x8*)(lds + PG8_SB(b, h) + boff + n * 2048 + k * 1024); } while (0)
#define PG8_MMA(ai, bj, At, Bt) do { __builtin_amdgcn_s_setprio(1); _Pragma("unroll") for (int m = 0; m < 4; ++m) _Pragma("unroll") for (int n = 0; n < 2; ++n) _Pragma("unroll") for (int k = 0; k < 2; ++k) \
        acc[ai][bj][m][n] = __builtin_amdgcn_mfma_f32_16x16x32_bf16(Bt[n][k], At[m][k], acc[ai][bj][m][n], 0, 0, 0); __builtin_amdgcn_s_setprio(0); } while (0)
#define PG8_WAIT_V(n) asm volatile("s_waitcnt vmcnt(" #n ")" ::: "memory")
#define PG8_WAIT_L(n) asm volatile("s_waitcnt lgkmcnt(" #n ")" ::: "memory")
#define PG8_BAR __builtin_amdgcn_s_barrier()
#define PG8_SCHED __builtin_amdgcn_sched_barrier(0)
    Unit cur, nxt; int ui = 0;
    if (!S.next(0, cur)) return;
    f32x4 acc[2][2][4][2];
#pragma unroll
    for (int a = 0; a < 2; ++a)
#pragma unroll
        for (int b = 0; b < 2; ++b)
#pragma unroll
            for (int m = 0; m < 4; ++m)
#pragma unroll
                for (int n = 0; n < 2; ++n) acc[a][b][m][n] = (f32x4){0.f, 0.f, 0.f, 0.f};
    bf16x8 At[4][2], B0[2][2], B1[2][2];
    const char* cA = (const char*)g.A + (size_t)cur.pm * tstep; const char* cB = (const char*)g.Bt + (size_t)cur.pn * tstep;
    S.a_ready(cur);
    if constexpr (SP2) {
        PG8_STAGE(PG8_SB(0, 0), cB, voffB); PG8_STAGE(PG8_SB(0, 1), cB + hstep, voffB); PG8_STAGE(PG8_SA(0, 0), cA, voffA); PG8_STAGE(PG8_SA(0, 1), cA + hstep, voffA);
        if (wr == 1) PG8_BAR;
        PG8_WAIT_V(2); PG8_BAR;
        PG8_STAGE(PG8_SB(1, 0), cB + kstep, voffB); PG8_STAGE(PG8_SA(1, 0), cA + kstep, voffA); PG8_STAGE(PG8_SB(1, 1), cB + hstep + kstep, voffB);
        PG8_WAIT_V(6); PG8_BAR;
    } else {
        PG8_STAGE(PG8_SB(0, 0), cB, voffB); PG8_STAGE(PG8_SA(0, 0), cA, voffA); PG8_STAGE(PG8_SB(0, 1), cB + hstep, voffB); PG8_STAGE(PG8_SA(0, 1), cA + hstep, voffA);
        if (wr == 1) PG8_BAR;
        PG8_WAIT_V(4); PG8_BAR;
        PG8_STAGE(PG8_SB(1, 0), cB + kstep, voffB); PG8_STAGE(PG8_SA(1, 0), cA + kstep, voffA); PG8_STAGE(PG8_SB(1, 1), cB + hstep + kstep, voffB);
        PG8_WAIT_V(6); PG8_BAR;
    }
    for (;;) {
        const bool has_next = S.next(ui + 1, nxt);
        const char* nA = has_next ? (const char*)g.A + (size_t)nxt.pm * tstep : cA; const char* nB = has_next ? (const char*)g.Bt + (size_t)nxt.pn * tstep : cB;
        for (int t = 0; t < nt; t += 2) {
            const bool last = (t == nt - 2);
            const char* a1 = cA + (size_t)(t + 1) * kstep;
            const char* a2 = last ? nA : cA + (size_t)(t + 2) * kstep; const char* b2 = last ? nB : cB + (size_t)(t + 2) * kstep;
            const char* a3 = a2 + kstep; const char* b3 = b2 + kstep;
            if (last && has_next) S.a_ready(nxt);
            if constexpr (SP2) {
            PG8_LDB(B0, 0, 0); PG8_LDB(B1, 0, 1); PG8_SCHED; PG8_LDA(At, 0, 0); PG8_STAGE(PG8_SA(1, 1), a1 + hstep, voffA);
            PG8_WAIT_V(8); PG8_WAIT_L(0); PG8_BAR; PG8_MMA(0, 0, At, B0); PG8_MMA(0, 1, At, B1); PG8_BAR; PG8_SCHED;
            PG8_LDA(At, 0, 1); PG8_STAGE(PG8_SB(0, 0), b2, voffB); PG8_STAGE(PG8_SB(0, 1), b2 + hstep, voffB); PG8_STAGE(PG8_SA(0, 0), a2, voffA);
            PG8_WAIT_V(8); PG8_WAIT_L(0); PG8_BAR; PG8_MMA(1, 0, At, B0); PG8_MMA(1, 1, At, B1); PG8_BAR; PG8_SCHED;
            PG8_LDB(B0, 1, 0); PG8_LDB(B1, 1, 1); PG8_SCHED; PG8_LDA(At, 1, 0); PG8_STAGE(PG8_SA(0, 1), a2 + hstep, voffA);
            PG8_WAIT_V(8); PG8_WAIT_L(0); PG8_BAR; PG8_MMA(0, 0, At, B0); PG8_MMA(0, 1, At, B1); PG8_BAR; PG8_SCHED;
            PG8_LDA(At, 1, 1); PG8_STAGE(PG8_SB(1, 0), b3, voffB); PG8_STAGE(PG8_SB(1, 1), b3 + hstep, voffB); PG8_STAGE(PG8_SA(1, 0), a3, voffA);
            PG8_WAIT_V(8); PG8_WAIT_L(0); PG8_BAR; PG8_MMA(1, 0, At, B0); PG8_MMA(1, 1, At, B1); PG8_BAR; PG8_SCHED;
            } else {
            PG8_LDB(B0, 0, 0); PG8_SCHED; PG8_LDA(At, 0, 0); PG8_STAGE(PG8_SA(1, 1), a1 + hstep, voffA);
            PG8_WAIT_L(8); PG8_BAR; PG8_WAIT_L(0); PG8_MMA(0, 0, At, B0); PG8_BAR; PG8_SCHED;
            PG8_LDB(B1, 0, 1); PG8_STAGE(PG8_SB(0, 0), b2, voffB);
            PG8_BAR; PG8_WAIT_L(0); PG8_MMA(0, 1, At, B1); PG8_BAR;
            PG8_LDA(At, 0, 1); PG8_STAGE(PG8_SA(0, 0), a2, voffA);
            PG8_BAR; PG8_WAIT_L(0); PG8_MMA(1, 0, At, B0); PG8_BAR; PG8_SCHED;
            PG8_STAGE(PG8_SB(0, 1), b2 + hstep, voffB);
            PG8_WAIT_V(6); PG8_BAR; PG8_MMA(1, 1, At, B1); PG8_BAR;
            PG8_LDB(B0, 1, 0); PG8_SCHED; PG8_LDA(At, 1, 0); PG8_STAGE(PG8_SA(0, 1), a2 + hstep, voffA);
            PG8_WAIT_L(8); PG8_BAR; PG8_WAIT_L(0); PG8_MMA(0, 0, At, B0); PG8_BAR; PG8_SCHED;
            PG8_LDB(B1, 1, 1); PG8_STAGE(PG8_SB(1, 0), b3, voffB);
            PG8_BAR; PG8_WAIT_L(0); PG8_MMA(0, 1, At, B1); PG8_BAR;
            PG8_LDA(At, 1, 1); PG8_STAGE(PG8_SA(1, 0), a3, voffA);
            PG8_BAR; PG8_WAIT_L(0); PG8_MMA(1, 0, At, B0); PG8_BAR; PG8_SCHED;
            PG8_STAGE(PG8_SB(1, 1), b3 + hstep, voffB);
            PG8_WAIT_V(6); PG8_BAR; PG8_MMA(1, 1, At, B1); PG8_BAR;
            }
        }
        if constexpr (ALIGN_EPI) { if (wr == 0) PG8_BAR; }
        if constexpr (!Epi::AFTER_DRAIN) { E(acc, cur, wr, wc, fr, fq); S.done(cur); }
        if (!has_next) break;
#pragma unroll
        for (int a = 0; a < 2; ++a)
#pragma unroll
            for (int b = 0; b < 2; ++b)
#pragma unroll
                for (int m = 0; m < 4; ++m)
#pragma unroll
                    for (int n = 0; n < 2; ++n) acc[a][b][m][n] = (f32x4){0.f, 0.f, 0.f, 0.f};
        cur = nxt; cA = nA; cB = nB; ++ui;
        if constexpr (ALIGN_EPI) { if (wr == 1) PG8_BAR; }
    }
    PG8_WAIT_V(0);
    if constexpr (!ALIGN_EPI) { if (wr == 0) PG8_BAR; }
    PG8_BAR;
    if constexpr (Epi::AFTER_DRAIN) { E.fused(acc, cur, wr, wc, fr, fq, lds, wid, lane); S.done(cur); }
#undef PG8_SA
#undef PG8_SB
#undef PG8_STAGE
#undef PG8_LDA
#undef PG8_LDB
#undef PG8_MMA
#undef PG8_WAIT_V
#undef PG8_WAIT_L
#undef PG8_BAR
#undef PG8_SCHED
}
}
using pg8::bf16_t; using pg8::bf16x8; using pg8::f32x4; using pg8::u32x4; using pg8::Unit; using pg8::cvt_pk_bf16;
typedef unsigned u32x2 __attribute__((ext_vector_type(2)));
#define DEV __device__ __forceinline__
constexpr int D = 1024, NB = 16, SEQ = 4096, MLAT = NB * SEQ, CTXL = 256, MCTX = NB * CTXL, MALL = MLAT + MCTX;
constexpr int DFF = 2816, NFF2 = 2 * DFF, ZW = 2816, NMOD = 9 * D;
constexpr int NU_LAT = NB * 64 * 4, NU_CTX = NB * 4 * 4, NU_ALL = NU_LAT + NU_CTX;
constexpr float EPS = 1e-6f;
constexpr int ZC_OG = 1024, ZC_U = 1536, ZC_VS = 2048, ZC_GLR = 2560;
constexpr size_t MiB = 1u << 20;
constexpr size_t WS_CTL = 0, WS_MOD = 64 * 1024;
static_assert(WS_MOD + 17 * 9216 * 4 <= (1u << 20), "MOD inside the zeroed region");
constexpr size_t WS_W1A = 2 * MiB, WS_W1B = 13 * MiB, WS_WIN = 19 * MiB, WS_WOUT = 25 * MiB, WS_W2A = 27 * MiB, WS_W2B = 38 * MiB, WS_WS = 44 * MiB;
constexpr size_t WS_DEC = 45 * MiB, WS_X1C = 48 * MiB, WS_XN = 64 * MiB, WS_ZH = 200 * MiB, WS_QT = 574 * MiB, WS_OI = 638 * MiB, WS_KV = 702 * MiB, WS_SB = 838 * MiB, WS_RSP = 966 * MiB, WS_RS2 = 969 * MiB, WS_RS3 = 974 * MiB, WS_SHW1 = 978 * MiB, WS_SHW2 = 979 * MiB, WS_END = 980 * MiB;
static_assert(WS_MOD + 17 * NMOD * 4 <= 2 * MiB && WS_RSP + (size_t)MALL * 8 * 4 <= WS_RS2 && WS_RS2 + (size_t)MALL * 16 * 4 <= WS_RS3 && WS_RS3 + (size_t)MLAT * 16 * 4 <= WS_SHW1 && WS_SHW1 + 17 * ZW * 4 <= WS_SHW2 && WS_SHW2 + 17 * NFF2 * 4 <= WS_END, "mod / row-stat / shift regions");
static_assert(WS_W1A + (size_t)NFF2 * D * 2 <= WS_W1B && WS_W1B + (size_t)D * DFF * 2 <= WS_WIN && WS_WIN + (size_t)ZW * D * 2 <= WS_WOUT && WS_WOUT + (size_t)D * D * 2 <= WS_W2A, "w map");
static_assert(WS_W2A + (size_t)NFF2 * D * 2 <= WS_W2B && WS_W2B + (size_t)D * DFF * 2 <= WS_WS && WS_WS + 8 * 128 * 128 * 2 <= WS_DEC && WS_DEC + (size_t)NU_ALL * 128 * 4 <= WS_X1C, "w map 2");
static_assert(WS_X1C + (size_t)MCTX * D * 4 <= WS_XN && WS_XN + (size_t)MALL * D * 2 <= WS_ZH && WS_ZH + (size_t)MALL * ZW * 2 <= WS_QT && WS_QT + (size_t)MLAT * 512 * 2 <= WS_OI, "act map");
static_assert(WS_OI + (size_t)MLAT * 512 * 2 <= WS_KV && WS_KV + (size_t)NU_ALL * 2 * 128 * 64 * 2 <= WS_SB && WS_SB + (size_t)NU_LAT * 2 * 128 * 64 * 2 <= WS_RSP, "act map 2");
static_assert(WS_KV + (size_t)MLAT * D * 2 <= WS_SB, "MIX overlays KV");
constexpr int LDS_BYTES = 147456;

DEV float bf_lo(unsigned w) { return __uint_as_float(w << 16); }
DEV float bf_hi(unsigned w) { return __uint_as_float(w & 0xffff0000u); }
DEV float silu_f(float x) { return x * __builtin_amdgcn_rcpf(1.f + __expf(-x)); }
DEV float gelu_f(float x) { const float t = 1.5957691216f * (x + 0.044715f * x * x * x); return x * __builtin_amdgcn_rcpf(1.f + __expf(-t)); }
DEV float wave_sum(float v) {
#pragma unroll
    for (int o = 1; o < 64; o <<= 1) v += __shfl_xor(v, o);
    return v;
}
#define LDS_WAIT() asm volatile("s_waitcnt lgkmcnt(0)" ::: "memory")
#define LBAR() do { asm volatile("s_waitcnt lgkmcnt(0)" ::: "memory"); __builtin_amdgcn_s_barrier(); asm volatile("" ::: "memory"); } while (0)
DEV void unpack8(const u32x4 w, float (&f)[8]) { f[0] = bf_lo(w.x); f[1] = bf_hi(w.x); f[2] = bf_lo(w.y); f[3] = bf_hi(w.y); f[4] = bf_lo(w.z); f[5] = bf_hi(w.z); f[6] = bf_lo(w.w); f[7] = bf_hi(w.w); }
DEV u32x4 pack8(const float (&f)[8]) { u32x4 w; w.x = cvt_pk_bf16(f[0], f[1]); w.y = cvt_pk_bf16(f[2], f[3]); w.z = cvt_pk_bf16(f[4], f[5]); w.w = cvt_pk_bf16(f[6], f[7]); return w; }
DEV f32x4 mfma16(bf16x8 a, bf16x8 b, f32x4 c) { return __builtin_amdgcn_mfma_f32_16x16x32_bf16(a, b, c, 0, 0, 0); }

DEV int prow(int n, int ln) { return 8 * (ln >> 2) + 4 * n + (ln & 3); }
DEV u32x4 pack8v(const f32x4 a, const f32x4 b) { u32x4 w; w.x = cvt_pk_bf16(a[0], a[1]); w.y = cvt_pk_bf16(a[2], a[3]); w.z = cvt_pk_bf16(b[0], b[1]); w.w = cvt_pk_bf16(b[2], b[3]); return w; }
DEV float row_rstd(const float* rs, int row, int fq) {
    const f32x4 p = *(const f32x4*)(rs + (size_t)row * 16 + fq * 4); float s = (p.x + p.y) + (p.z + p.w);
    s += __shfl_xor(s, 16); s += __shfl_xor(s, 32); return rsqrtf(s * (1.f / D) + EPS);
}
template <bool FUSED> struct EpiSwiGLU {
    static constexpr bool PERM = true, AFTER_DRAIN = false;
    bf16_t* H; const float* rs; const float* shw;
    DEV void operator()(const f32x4 (&acc)[2][2][4][2], const Unit& u, int wr, int wc, int fr, int fq) const {
        asm volatile("" : "+v"(fr), "+v"(fq));
        const int row0 = u.pm * 256 + wr * 64 + fr, col0 = u.pn * 128 + wc * 32 + 8 * fq;
        f32x4 sg[2], su[2];
        if (FUSED) { const int b = u.pm >> 4; const float* sp = shw + (size_t)b * NFF2 + u.pn * 256 + wc * 32 + 8 * fq;
            sg[0] = *(const f32x4*)sp; sg[1] = *(const f32x4*)(sp + 4); su[0] = *(const f32x4*)(sp + 128); su[1] = *(const f32x4*)(sp + 132); }
#pragma unroll
        for (int ai = 0; ai < 2; ++ai)
#pragma unroll
            for (int m = 0; m < 4; ++m) {
                const int row = row0 + ai * 128 + m * 16;
                float rstd = 1.f; if (FUSED) rstd = row_rstd(rs, row, fq);
                float h[8];
#pragma unroll
                for (int n = 0; n < 2; ++n)
#pragma unroll
                    for (int j = 0; j < 4; ++j) { float g = acc[ai][0][m][n][j], up = acc[ai][1][m][n][j]; if (FUSED) { g = g * rstd + sg[n][j]; up = up * rstd + su[n][j]; } h[4 * n + j] = silu_f(g) * up; }
                *(u32x4*)(H + (size_t)row * DFF + col0) = pack8(h);
            }
    }
};
template <int GATE_I, bool HALF, bool WITH_XN, int SCALE_I> struct EpiResid {
    static constexpr bool PERM = WITH_XN, AFTER_DRAIN = false; static constexpr int NS = PERM ? 4 : 16;
    const float* res_lat; const float* res_ctx; float* out_lat; float* out_ctx; const float* mod;
    bf16_t* xn; const float* g; float* rs;
    static constexpr int gate_i = GATE_I, scale_i = SCALE_I; static constexpr float coef = HALF ? 0.5f : 1.0f; static constexpr bool has_xn = WITH_XN;
    DEV void operator()(const f32x4 (&acc)[2][2][4][2], const Unit& u, int wr, int wc, int fr, int fq) const {
        asm volatile("" : "+v"(fr), "+v"(fq));
        const bool lat = u.pm < MLAT / 256; const int b = lat ? (u.pm >> 4) : 16;
        const float* res = lat ? res_lat : res_ctx; float* out = lat ? out_lat : out_ctx;
        const int grow0 = u.pm * 256 + wr * 64 + fr, row0 = (lat ? grow0 : grow0 - MLAT), col0 = u.pn * 256 + wc * 32 + (PERM ? 8 : 4) * fq;
        float ss[8];
#pragma unroll
        for (int i = 0; i < 8; ++i) ss[i] = 0.f;
#pragma unroll
        for (int bj = 0; bj < 2; ++bj) {
            f32x4 gv[2], gs[2];
#pragma unroll
            for (int n = 0; n < 2; ++n) { gv[n] = *(const f32x4*)(mod + (size_t)b * NMOD + gate_i * D + col0 + bj * 128 + NS * n) * coef;
                if (has_xn) gs[n] = *(const f32x4*)(g + col0 + bj * 128 + 4 * n) * (*(const f32x4*)(mod + (size_t)b * NMOD + scale_i * D + col0 + bj * 128 + 4 * n) + 1.f); }
#pragma unroll
            for (int ai = 0; ai < 2; ++ai)
#pragma unroll
                for (int m = 0; m < 4; ++m) {
                    const size_t p = (size_t)(row0 + ai * 128 + m * 16) * D + col0 + bj * 128;
                    const f32x4 r0 = *(const f32x4*)(res + p), r1 = *(const f32x4*)(res + p + NS);
                    const f32x4 o0 = r0 + gv[0] * acc[ai][bj][m][0], o1 = r1 + gv[1] * acc[ai][bj][m][1];
                    *(f32x4*)(out + p) = o0; *(f32x4*)(out + p + NS) = o1;
                    if (has_xn) { ss[ai * 4 + m] += (o0[0] * o0[0] + o0[1] * o0[1]) + (o0[2] * o0[2] + o0[3] * o0[3]) + (o1[0] * o1[0] + o1[1] * o1[1]) + (o1[2] * o1[2] + o1[3] * o1[3]);
                        *(u32x4*)(xn + (size_t)(grow0 + ai * 128 + m * 16) * D + col0 + bj * 128) = pack8v(o0 * gs[0], o1 * gs[1]); }
                }
        }
        if (has_xn) {
#pragma unroll
            for (int i = 0; i < 8; ++i) { float v = ss[i]; v += __shfl_xor(v, 16); v += __shfl_xor(v, 32); if (fq == 0) rs[(size_t)(grow0 + (i >> 2) * 128 + (i & 3) * 16) * 16 + u.pn * 4 + wc] = v; }
        }
    }
};
struct EpiZ {
    static constexpr bool PERM = true, AFTER_DRAIN = false;
    bf16_t* Z; float* rowss; const float* rs; const float* shw;
    DEV void operator()(const f32x4 (&acc)[2][2][4][2], const Unit& u, int wr, int wc, int fr, int fq) const {
        asm volatile("" : "+v"(fr), "+v"(fq));
        const int pn = u.pn; const int act = (pn < 4 || pn >= 10) ? 0 : (pn < 6 ? 1 : 2); const bool stat = (pn == 8 || pn == 9);
        const int row0 = u.pm * 256 + wr * 64 + fr, col0 = pn * 256 + wc * 32 + 8 * fq; const int b = u.pm < MLAT / 256 ? (u.pm >> 4) : 16;
        f32x4 sw[2][2];
#pragma unroll
        for (int bj = 0; bj < 2; ++bj)
#pragma unroll
            for (int n = 0; n < 2; ++n) sw[bj][n] = *(const f32x4*)(shw + (size_t)b * ZW + col0 + bj * 128 + 4 * n);
#pragma unroll
        for (int ai = 0; ai < 2; ++ai)
#pragma unroll
            for (int m = 0; m < 4; ++m) {
                const int row = row0 + ai * 128 + m * 16; float ss = 0.f; const float rstd = row_rstd(rs, row, fq);
#pragma unroll
                for (int bj = 0; bj < 2; ++bj) {
                    float v[8];
#pragma unroll
                    for (int n = 0; n < 2; ++n)
#pragma unroll
                        for (int j = 0; j < 4; ++j) { float x = acc[ai][bj][m][n][j] * rstd + sw[bj][n][j]; if (act == 1) x = silu_f(x); else if (act == 2) x = gelu_f(x); v[4 * n + j] = x; ss += x * x; }
                    *(u32x4*)(Z + (size_t)row * ZW + col0 + bj * 128) = pack8(v);
                }
                if (stat) { ss += __shfl_xor(ss, 16); ss += __shfl_xor(ss, 32); if (fq == 0) rowss[(size_t)row * 8 + (pn - 8) * 4 + wc] = ss; }
            }
    }
};

struct Args { const float* in[25]; float* out; unsigned char* ws; int ph_lo, ph_hi; };
enum { I_X = 0, I_C, I_CTX, I_CCTX, I_WADA, I_BADA, I_N1G, I_FF1IN, I_FF1OUT, I_N2G, I_WIN, I_CONVW, I_WGF, I_BGF, I_WGB, I_BGB, I_GLAG, I_CMG, I_WS, I_BS, I_WOUT, I_N3G, I_FF2IN, I_FF2OUT, I_FING };

DEV void transpose_item(const float* W, int K, int N, bf16_t* WT, int n0, int drow0, int k0, float* scr, int lane) {
    float tv[32];
#pragma unroll
    for (int i = 0; i < 32; ++i) tv[i] = W[(size_t)(k0 + 2 * i + (lane >> 5)) * N + n0 + (lane & 31)];
#pragma unroll
    for (int i = 0; i < 32; ++i) scr[(2 * i + (lane >> 5)) * 33 + (lane & 31)] = tv[i];
    LDS_WAIT();
    const int c = lane & 7;
#pragma unroll
    for (int j = 0; j < 4; ++j) { const int n = (lane >> 3) + 8 * j; const float* s = scr + (8 * c) * 33 + n;
        u32x4 o; o.x = cvt_pk_bf16(s[0 * 33], s[1 * 33]); o.y = cvt_pk_bf16(s[2 * 33], s[3 * 33]); o.z = cvt_pk_bf16(s[4 * 33], s[5 * 33]); o.w = cvt_pk_bf16(s[6 * 33], s[7 * 33]);
        *(u32x4*)(WT + (size_t)(drow0 + n) * K + k0 + 8 * c) = o; }
    LDS_WAIT();
}
DEV int ffin_rowmap(int n0) { const int up = n0 >= DFF, j = up ? n0 - DFF : n0; return (j >> 7) * 256 + up * 128 + (j & 127); }
DEV int win_rowmap(int n0) { return n0 < 1024 ? n0 : (n0 < 1056 ? n0 - 1024 + ZC_GLR : n0 - 1056 + ZC_OG); }
DEV void p0_prep(const Args& a, unsigned char* lds, int gw, int NGW, int wave, int lane) {
    unsigned char* ws = a.ws;
    float* scr = (float*)(lds + wave * 16384);
    constexpr int I_A = (D / 64) * (NFF2 / 32), I_B = (DFF / 64) * (D / 32), I_IN = (D / 64) * (2592 / 32), I_O = (D / 64) * (D / 32), I_ADA = (NMOD / 16) * 8;
    constexpr int NIT = 2 * I_A + 2 * I_B + I_IN + I_O + I_ADA;
    for (int r = gw; r < I_ADA; r += NGW) {
        {
            const int cgi = r % (NMOD / 16), kc = r / (NMOD / 16), n0 = cgi * 16, k0 = kc * 128, col = lane & 15, kq = lane >> 4;
            {
                float cv[34];
#pragma unroll
                for (int i = 0; i < 34; ++i) cv[i] = ((i >> 1) < 16) ? a.in[I_C][(i >> 1) * D + k0 + lane + 64 * (i & 1)] : a.in[I_CCTX][k0 + lane + 64 * (i & 1)];
#pragma unroll
                for (int i = 0; i < 34; ++i) scr[lane + 64 * i] = silu_f(cv[i]);
            }
            const float* wp = a.in[I_WADA] + (size_t)(k0 + kq * 32) * NMOD + n0 + col;
            float acc[17];
#pragma unroll
            for (int b = 0; b < 17; ++b) acc[b] = 0.f;
            LDS_WAIT();
#pragma unroll 1
            for (int kb = 0; kb < 2; ++kb) {
                float wv[16];
#pragma unroll
                for (int kk = 0; kk < 16; ++kk) wv[kk] = wp[(size_t)(kb * 16 + kk) * NMOD];
#pragma unroll
                for (int kk = 0; kk < 16; ++kk) {
#pragma unroll
                    for (int b = 0; b < 17; ++b) acc[b] += scr[b * 128 + kq * 32 + kb * 16 + kk] * wv[kk]; }
            }
            LDS_WAIT();
            float* mod = (float*)(ws + WS_MOD);
            const float bias = (kc == 0) ? a.in[I_BADA][n0 + col] : 0.f;
#pragma unroll
            for (int b = 0; b < 17; ++b) { float v = acc[b]; v += __shfl_xor(v, 16); v += __shfl_xor(v, 32); if (kq == 0) atomicAdd(mod + b * NMOD + n0 + col, v + bias); }
        }
    }
    {
        constexpr int NT = NIT - I_ADA;
        const float* nW = nullptr; bf16_t* nWT = nullptr; int nK = 0, nN = 0, nn0 = 0, nd0 = 0, nk0 = 0; float tvn[32];
#define T_DEC(r_) do { int q_ = (r_); \
        if (q_ < I_A) { nW = a.in[I_FF1IN]; nWT = (bf16_t*)(ws + WS_W1A); nK = D; nN = NFF2; nn0 = (q_ % (NFF2 / 32)) * 32; nd0 = ffin_rowmap(nn0); nk0 = (q_ / (NFF2 / 32)) * 64; } \
        else if ((q_ -= I_A) < I_A) { nW = a.in[I_FF2IN]; nWT = (bf16_t*)(ws + WS_W2A); nK = D; nN = NFF2; nn0 = (q_ % (NFF2 / 32)) * 32; nd0 = ffin_rowmap(nn0); nk0 = (q_ / (NFF2 / 32)) * 64; } \
        else if ((q_ -= I_A) < I_B) { nW = a.in[I_FF1OUT]; nWT = (bf16_t*)(ws + WS_W1B); nK = DFF; nN = D; nn0 = (q_ % (D / 32)) * 32; nd0 = nn0; nk0 = (q_ / (D / 32)) * 64; } \
        else if ((q_ -= I_B) < I_B) { nW = a.in[I_FF2OUT]; nWT = (bf16_t*)(ws + WS_W2B); nK = DFF; nN = D; nn0 = (q_ % (D / 32)) * 32; nd0 = nn0; nk0 = (q_ / (D / 32)) * 64; } \
        else if ((q_ -= I_B) < I_IN) { nW = a.in[I_WIN]; nWT = (bf16_t*)(ws + WS_WIN); nK = D; nN = 2592; nn0 = (q_ % (2592 / 32)) * 32; nd0 = win_rowmap(nn0); nk0 = (q_ / (2592 / 32)) * 64; } \
        else { q_ -= I_IN; nW = a.in[I_WOUT]; nWT = (bf16_t*)(ws + WS_WOUT); nK = D; nN = D; nn0 = (q_ % (D / 32)) * 32; nd0 = nn0; nk0 = (q_ / (D / 32)) * 64; } \
        _Pragma("unroll") for (int i = 0; i < 32; ++i) tvn[i] = nW[(size_t)(nk0 + 2 * i + (lane >> 5)) * nN + nn0 + (lane & 31)]; } while (0)
        if (gw < NT) T_DEC(gw);
        for (int r = gw; r < NT; r += NGW) {
            bf16_t* const cWT = nWT; const int cK = nK, cd0 = nd0, ck0 = nk0;
#pragma unroll
            for (int i = 0; i < 32; ++i) scr[(2 * i + (lane >> 5)) * 33 + (lane & 31)] = tvn[i];
            if (r + NGW < NT) T_DEC(r + NGW);
            LDS_WAIT();
            const int c = lane & 7;
#pragma unroll
            for (int j = 0; j < 4; ++j) { const int n = (lane >> 3) + 8 * j; const float* sp = scr + (8 * c) * 33 + n;
                u32x4 o; o.x = cvt_pk_bf16(sp[0 * 33], sp[1 * 33]); o.y = cvt_pk_bf16(sp[2 * 33], sp[3 * 33]); o.z = cvt_pk_bf16(sp[4 * 33], sp[5 * 33]); o.w = cvt_pk_bf16(sp[6 * 33], sp[7 * 33]);
                *(u32x4*)(cWT + (size_t)(cd0 + n) * cK + ck0 + 8 * c) = o; }
            LDS_WAIT();
        }
#undef T_DEC
    }
    const int gt = gw * 64 + lane, NGT = NGW * 64;
    for (int i = gt; i < 8 * 128 * 128 / 2; i += NGT) { const float2 v = ((const float2*)a.in[I_WS])[i]; ((unsigned*)(ws + WS_WS))[i] = cvt_pk_bf16(v.x, v.y); }
    for (int i = gt; i < (ZW - 2592) * D / 2; i += NGT) ((unsigned*)(ws + WS_WIN + (size_t)2592 * D * 2))[i] = 0u;
}

DEV void norm_mod_phase(const float* src_lat, const float* src_ctx, int nrows, const float* g, const float* mod, int shift_i, int scale_i, bf16_t* XN, int gw, int NGW, int lane) {
    for (int row = 2 * gw; row < nrows; row += 2 * NGW) {
        const bool lat = row < MLAT; const int b = lat ? (row >> 12) : 16;
        const f32x4* xr = (const f32x4*)(lat ? src_lat + (size_t)row * D : src_ctx + (size_t)(row - MLAT) * D) + lane;
        f32x4 v[2][4], gm[4], sh[4];
#pragma unroll
        for (int r = 0; r < 2; ++r)
#pragma unroll
            for (int j = 0; j < 4; ++j) v[r][j] = __builtin_nontemporal_load(&xr[r * 256 + 64 * j]);
        const f32x4* gp = (const f32x4*)g + lane; const f32x4* scp = (const f32x4*)(mod + (size_t)b * NMOD + scale_i * D) + lane; const f32x4* shp = (const f32x4*)(mod + (size_t)b * NMOD + shift_i * D) + lane;
#pragma unroll
        for (int j = 0; j < 4; ++j) { gm[j] = gp[64 * j] * (scp[64 * j] + 1.f); sh[j] = shp[64 * j]; }
#pragma unroll
        for (int r = 0; r < 2; ++r) {
            float s = 0.f;
#pragma unroll
            for (int j = 0; j < 4; ++j) s += (v[r][j].x * v[r][j].x + v[r][j].y * v[r][j].y) + (v[r][j].z * v[r][j].z + v[r][j].w * v[r][j].w);
            const float rstd = rsqrtf(wave_sum(s) * (1.f / D) + EPS);
            u32x2* o8 = (u32x2*)(XN + (size_t)(row + r) * D) + lane;
#pragma unroll
            for (int j = 0; j < 4; ++j) { const f32x4 y = (v[r][j] * rstd) * gm[j] + sh[j]; u32x2 w; w.x = cvt_pk_bf16(y.x, y.y); w.y = cvt_pk_bf16(y.z, y.w); o8[64 * j] = w; }
        }
    }
}
DEV void final_norm_phase(float* xo, const float* g, int gw, int NGW, int lane) {
    const f32x4* gp = (const f32x4*)g + lane;
    f32x4 gm[4];
#pragma unroll
    for (int j = 0; j < 4; ++j) gm[j] = gp[64 * j];
    for (int vr = 2 * gw; vr < MLAT; vr += 2 * NGW) {
        const int rnd = 3 - (vr >> 14), wv = vr & 16383, row = (((wv >> 11) * 32 + rnd * 8 + ((wv >> 8) & 7)) << 8) + (wv & 255);
        f32x4* xr = (f32x4*)(xo + (size_t)row * D) + lane;
        f32x4 v[2][4];
#pragma unroll
        for (int r = 0; r < 2; ++r)
#pragma unroll
            for (int j = 0; j < 4; ++j) v[r][j] = xr[r * 256 + 64 * j];
#pragma unroll
        for (int r = 0; r < 2; ++r) {
            float s = 0.f;
#pragma unroll
            for (int j = 0; j < 4; ++j) s += (v[r][j].x * v[r][j].x + v[r][j].y * v[r][j].y) + (v[r][j].z * v[r][j].z + v[r][j].w * v[r][j].w);
            const float rstd = rsqrtf(wave_sum(s) * (1.f / D) + EPS);
#pragma unroll
            for (int j = 0; j < 4; ++j) __builtin_nontemporal_store((v[r][j] * rstd) * gm[j], &xr[r * 256 + 64 * j]);
        }
    }
}

DEV void shiftw_phase(const bf16_t* Wt, int N, const float* mod, int shift_i, float* shw, int gw, int NGW, int lane, bool with_ctx) {
    const int ln = lane & 15, kg = lane >> 4;
    for (int it = gw; it < N / 16; it += NGW) {
        const int n0 = it * 16;
        f32x4 acc0 = {0.f, 0.f, 0.f, 0.f}, acc1 = {0.f, 0.f, 0.f, 0.f};
        const bf16_t* wrow = Wt + (size_t)(n0 + ln) * D + kg * 8;
        const float* srow = mod + (size_t)ln * NMOD + shift_i * D + kg * 8;
        const float* crow = mod + (size_t)16 * NMOD + shift_i * D + kg * 8;
#pragma unroll 8
        for (int ks = 0; ks < 32; ++ks) {
            const bf16x8 wf = *(const bf16x8*)(wrow + ks * 32);
            const f32x4 s0 = *(const f32x4*)(srow + ks * 32), s1 = *(const f32x4*)(srow + ks * 32 + 4);
            const u32x4 sp = pack8v(s0, s1);
            acc0 = mfma16(wf, __builtin_bit_cast(bf16x8, sp), acc0);
            if (with_ctx) {
                f32x4 c0 = {0.f, 0.f, 0.f, 0.f}, c1 = c0;
                if (ln == 0) { c0 = *(const f32x4*)(crow + ks * 32); c1 = *(const f32x4*)(crow + ks * 32 + 4); }
                const u32x4 cp = pack8v(c0, c1);
                acc1 = mfma16(wf, __builtin_bit_cast(bf16x8, cp), acc1);
            }
        }
        *(f32x4*)(shw + (size_t)ln * N + n0 + kg * 4) = acc0;
        if (with_ctx && ln == 0) *(f32x4*)(shw + (size_t)16 * N + n0 + kg * 4) = acc1;
    }
}

DEV void conv_phase(const bf16_t* Z, const float* cw, bf16_t* QKV, int G) {
    const int gt = blockIdx.x * 512 + threadIdx.x, cgi = gt & 127, ch0 = cgi * 8;
    float w[9][8];
#pragma unroll
    for (int t = 0; t < 9; ++t) { const f32x4 a = *(const f32x4*)(cw + t * 1024 + ch0), b = *(const f32x4*)(cw + t * 1024 + ch0 + 4); w[t][0] = a.x; w[t][1] = a.y; w[t][2] = a.z; w[t][3] = a.w; w[t][4] = b.x; w[t][5] = b.y; w[t][6] = b.z; w[t][7] = b.w; }
    const float qs = (ch0 < 256) ? 0.125f : 1.f;
    const u32x4 zero4 = {0u, 0u, 0u, 0u};
    for (int sid = gt >> 7; sid < NB * 64; sid += (G * 512) >> 7) {
        const int cc = sid & 63, b = sid >> 6; const bool hasL = cc > 0, hasR = cc < 63;
        const bf16_t* zp = Z + (size_t)(b * SEQ + cc) * ZW + ch0;
        bf16_t* op = QKV + (size_t)(b * SEQ + cc) * D + ch0;
        float win[3][3][8];
        u32x4 raw[3];
#define CV_LOAD(r_) do { const bf16_t* q_ = zp + (size_t)(r_) * 64 * ZW; const bool v_ = (r_) < 64; \
        raw[0] = (v_ && hasL) ? *(const u32x4*)(q_ - ZW) : zero4; raw[1] = v_ ? *(const u32x4*)q_ : zero4; raw[2] = (v_ && hasR) ? *(const u32x4*)(q_ + ZW) : zero4; } while (0)
#define CV_UNPACK(slot_) do { unpack8(raw[0], win[slot_][0]); unpack8(raw[1], win[slot_][1]); unpack8(raw[2], win[slot_][2]); } while (0)
#define CV_STEP(r_, top_, mid_, bot_) do { if ((r_) < 64) { float acc[8]; \
        _Pragma("unroll") for (int j = 0; j < 8; ++j) { float s_ = 0.f; \
            _Pragma("unroll") for (int dx = 0; dx < 3; ++dx) s_ += w[dx][j] * win[top_][dx][j] + w[3 + dx][j] * win[mid_][dx][j] + w[6 + dx][j] * win[bot_][dx][j]; \
            acc[j] = silu_f(s_) * qs; } \
        *(u32x4*)(op + (size_t)(r_) * 64 * D) = pack8(acc); \
        CV_UNPACK(top_); CV_LOAD((r_) + 3); } } while (0)
#pragma unroll
        for (int dx = 0; dx < 3; ++dx)
#pragma unroll
            for (int j = 0; j < 8; ++j) win[2][dx][j] = 0.f;
        CV_LOAD(0); CV_UNPACK(0); CV_LOAD(1); CV_UNPACK(1); CV_LOAD(2);
        for (int r = 0; r < 66; r += 3) { CV_STEP(r, 2, 0, 1); CV_STEP(r + 1, 0, 1, 2); CV_STEP(r + 2, 1, 2, 0); }
#undef CV_LOAD
#undef CV_UNPACK
#undef CV_STEP
    }
    for (int row = MLAT + (gt >> 7); row < MALL; row += (G * 512) >> 7) {
        float acc[8];
#pragma unroll
        for (int j = 0; j < 8; ++j) acc[j] = 0.f;
        const int t = (row - MLAT) & 255;
#pragma unroll
        for (int dx = -1; dx <= 1; ++dx) { const int t2 = t + dx;
            if (t2 >= 0 && t2 < 256) { float f[8]; unpack8(*(const u32x4*)(Z + (size_t)(row + dx) * ZW + ch0), f);
#pragma unroll
                for (int j = 0; j < 8; ++j) acc[j] += w[3 + dx + 1][j] * f[j]; } }
#pragma unroll
        for (int j = 0; j < 8; ++j) acc[j] = silu_f(acc[j]) * qs;
        *(u32x4*)(QKV + (size_t)row * D + ch0) = pack8(acc);
    }
}

constexpr int L_GLR = 0, L_B = 8192, BP = 68, L_TOT = L_B + 2 * 64 * BP * 4, L_Q = L_TOT + 2048, QP = 72, L_K = L_Q + 2 * 64 * QP * 2, L_KHT = L_K + 2 * 64 * QP * 2, L_VT = L_KHT + 2 * 64 * QP * 2,
              L_P = L_VT + 128 * QP * 2, PP = 136, L_G1END = L_P + 64 * PP * 2;
static_assert(L_G1END <= LDS_BYTES, "G1 LDS");
DEV void gla_unit_rows(int u, int& b, int& c, int& h, int& row0) {
    if (u < NU_LAT) { b = u >> 8; c = (u >> 2) & 63; h = u & 3; row0 = b * SEQ + c * 64; }
    else { const int v = u - NU_LAT; b = v >> 4; c = (v >> 2) & 3; h = v & 3; row0 = MLAT + b * CTXL + c * 64; }
}
DEV void g1_phase(const Args& a, unsigned char* lds, int G) {
    unsigned char* ws = a.ws;
    const bf16_t* Z = (const bf16_t*)(ws + WS_ZH); const bf16_t* QKV = (const bf16_t*)(ws + WS_XN);
    bf16_t* QT = (bf16_t*)(ws + WS_QT); bf16_t* OI = (bf16_t*)(ws + WS_OI); bf16_t* KV = (bf16_t*)(ws + WS_KV); float* DEC = (float*)(ws + WS_DEC);
    const int t = threadIdx.x, lane = t & 63, w = t >> 6, ln = lane & 15, kg = lane >> 4;
    float* sB = (float*)(lds + L_B);
    bf16_t* sQ = (bf16_t*)(lds + L_Q); bf16_t* sK = (bf16_t*)(lds + L_K); bf16_t* sKhT = (bf16_t*)(lds + L_KHT); bf16_t* sVT = (bf16_t*)(lds + L_VT); bf16_t* sP = (bf16_t*)(lds + L_P);
    const int gdir = w >> 2, dkt = w & 3;
#define G1_LOAD(u_) do { int b_, c_, h_, r_; gla_unit_rows((u_), b_, c_, h_, r_); \
        _Pragma("unroll") for (int pt = 0; pt < 4; ++pt) gfn[pt] = (kg < 2) ? *(const u32x4*)(Z + (size_t)(r_ + pt * 16 + ln) * ZW + ZC_GLR + gdir * 16 + kg * 8) : (u32x4){0u, 0u, 0u, 0u}; \
        const bf16_t* qp_ = QKV + (size_t)(r_ + (t & 63)) * D + (t >> 6) * 8; \
        qn = *(const u32x4*)(qp_ + h_ * 64); kn = *(const u32x4*)(qp_ + 256 + h_ * 64); vn0 = *(const u32x4*)(qp_ + 512 + h_ * 128); vn1 = *(const u32x4*)(qp_ + 512 + h_ * 128 + 64); } while (0)
#define G1_WLOAD(h_) do { const float* wg_ = a.in[gdir ? I_WGB : I_WGF] + (h_) * 64 + dkt * 16 + ln; float wv_[8]; \
        _Pragma("unroll") for (int j = 0; j < 8; ++j) wv_[j] = (kg < 2) ? wg_[(kg * 8 + j) * 256] : 0.f; \
        const u32x4 wp_ = pack8(wv_); wfrag = __builtin_bit_cast(bf16x8, wp_); bias4 = *(const f32x4*)(a.in[gdir ? I_BGB : I_BGF] + (h_) * 64 + dkt * 16 + kg * 4); } while (0)
#define DPP_SHR(x_, n_) __builtin_bit_cast(float, __builtin_amdgcn_update_dpp(0, __builtin_bit_cast(int, (x_)), 0x110 | (n_), 0xf, 0xf, true))
    u32x4 qn, kn, vn0, vn1, gfn[4];
    if ((int)blockIdx.x < NU_ALL) G1_LOAD((int)blockIdx.x);
    bf16x8 wfrag; f32x4 bias4; int hcur = blockIdx.x & 3;
    G1_WLOAD(hcur);
    for (int u = blockIdx.x; u < NU_ALL; u += G) {
        int b, c, h, row0; gla_unit_rows(u, b, c, h, row0); const bool lat = u < NU_LAT;
        if (h != hcur) { hcur = h; G1_WLOAD(h); }
        const int pos = t & 63, g8 = t >> 6;
        const u32x4 qraw = qn, kraw = kn, vraw0 = vn0, vraw1 = vn1;
        u32x4 gf[4];
#pragma unroll
        for (int pt = 0; pt < 4; ++pt) gf[pt] = gfn[pt];
        if (u + G < NU_ALL) G1_LOAD(u + G);
        {
            float gl[4][4], cs[4][4], tot[4];
#pragma unroll
            for (int pt = 0; pt < 4; ++pt) {
                f32x4 pre = mfma16(wfrag, __builtin_bit_cast(bf16x8, gf[pt]), bias4);
#pragma unroll
                for (int r = 0; r < 4; ++r) { const float x = pre[r]; const float ls = (fminf(x, 0.f) - __logf(1.f + __expf(-fabsf(x)))) * (1.f / 16.f); gl[pt][r] = ls;
                    float sc = ls; sc += DPP_SHR(sc, 1); sc += DPP_SHR(sc, 2); sc += DPP_SHR(sc, 4); sc += DPP_SHR(sc, 8); cs[pt][r] = sc; }
            }
#pragma unroll
            for (int r = 0; r < 4; ++r) { float off = 0.f;
#pragma unroll
                for (int pt = 0; pt < 4; ++pt) { const float tt = __shfl(cs[pt][r], (lane & 48) | 15); cs[pt][r] += off; off += tt; }
                tot[r] = off; }
            if (gdir) {
#pragma unroll
                for (int pt = 0; pt < 4; ++pt)
#pragma unroll
                    for (int r = 0; r < 4; ++r) cs[pt][r] = tot[r] - cs[pt][r] + gl[pt][r];
            }
#pragma unroll
            for (int pt = 0; pt < 4; ++pt) *(f32x4*)(sB + (gdir * 64 + pt * 16 + ln) * BP + dkt * 16 + kg * 4) = (f32x4){cs[pt][0], cs[pt][1], cs[pt][2], cs[pt][3]};
            if (ln == 15) *(f32x4*)(DEC + ((size_t)u * 2 + gdir) * 64 + dkt * 16 + kg * 4) = (f32x4){__expf(tot[0]), __expf(tot[1]), __expf(tot[2]), __expf(tot[3])};
        }
        LBAR();
        {
            float q[8], k[8]; unpack8(qraw, q); unpack8(kraw, k);
            const unsigned tsel = (lane & 1) ? 0x03020706u : 0x05040100u;
#pragma unroll
            for (int dir = 0; dir < 2; ++dir) {
                const float* bp = sB + (dir * 64 + pos) * BP + g8 * 8; const float* bl = sB + (dir * 64 + (dir ? 0 : 63)) * BP + g8 * 8;
                const f32x4 b0 = *(const f32x4*)bp, b1 = *(const f32x4*)(bp + 4), l0 = *(const f32x4*)bl, l1 = *(const f32x4*)(bl + 4);
                float qt[8], kt[8], kh[8];
#pragma unroll
                for (int j = 0; j < 8; ++j) { const float bb = j < 4 ? b0[j] : b1[j - 4], ll = j < 4 ? l0[j] : l1[j - 4]; qt[j] = q[j] * __expf(bb); kt[j] = k[j] * __expf(-bb); kh[j] = k[j] * __expf(ll - bb); }
                const u32x4 qw = pack8(qt), kw = pack8(kt), hw = pack8(kh);
                *(u32x4*)(sQ + (dir * 64 + pos) * QP + g8 * 8) = qw;
                *(u32x4*)(sK + (dir * 64 + pos) * QP + g8 * 8) = kw;
                { unsigned* kp = (unsigned*)(sKhT + (dir * 64 + g8 * 8 + (lane & 1)) * QP + (pos & ~1));
#pragma unroll
                  for (int d = 0; d < 4; ++d) { const unsigned own = hw[d], oth = (unsigned)__builtin_amdgcn_update_dpp(0, (int)own, 0xB1, 0xf, 0xf, true);
                      kp[d * QP] = __builtin_amdgcn_perm(oth, own, tsel); } }
            }
#pragma unroll
            for (int i = 0; i < 2; ++i) { const u32x4 vw = i ? vraw1 : vraw0; unsigned* vp = (unsigned*)(sVT + ((g8 + 8 * i) * 8 + (lane & 1)) * QP + (pos & ~1));
#pragma unroll
                for (int d = 0; d < 4; ++d) { const unsigned own = vw[d], oth = (unsigned)__builtin_amdgcn_update_dpp(0, (int)own, 0xB1, 0xf, 0xf, true);
                    vp[d * QP] = __builtin_amdgcn_perm(oth, own, tsel); } }
        }
        LBAR();
        if (lat) {
            const int p2 = t >> 3, g2 = (t & 7) * 8;
#pragma unroll
            for (int dir = 0; dir < 2; ++dir) *(u32x4*)(QT + (size_t)(row0 + p2) * 512 + dir * 256 + h * 64 + g2) = *(const u32x4*)(sQ + (dir * 64 + p2) * QP + g2);
        }
        {
            const int dir = w >> 2, it = w & 3;
            bf16x8 qf[2];
#pragma unroll
            for (int ks = 0; ks < 2; ++ks) qf[ks] = *(const bf16x8*)(sQ + (dir * 64 + it * 16 + ln) * QP + ks * 32 + kg * 8);
#pragma unroll
            for (int jt = 0; jt < 4; ++jt) {
                f32x4 acc = {0.f, 0.f, 0.f, 0.f};
                const bool live = dir ? (jt >= it) : (jt <= it);
                if (live) {
#pragma unroll
                    for (int ks = 0; ks < 2; ++ks) { const bf16x8 kf = *(const bf16x8*)(sK + (dir * 64 + jt * 16 + ln) * QP + ks * 32 + kg * 8); acc = mfma16(kf, qf[ks], acc); }
                }
                const int i = it * 16 + ln, j0 = jt * 16 + kg * 4;
                float pv[4];
#pragma unroll
                for (int r = 0; r < 4; ++r) { const int j = j0 + r; const bool keep = dir ? (j >= i) : (j <= i); pv[r] = keep ? acc[r] : 0.f; }
                u32x2 pw; pw.x = cvt_pk_bf16(pv[0], pv[1]); pw.y = cvt_pk_bf16(pv[2], pv[3]);
                *(u32x2*)(sP + i * PP + dir * 64 + j0) = pw;
            }
        }
        LBAR();
        if (lat) {
            const int it = w & 3, half = w >> 2;
            f32x4 acc[4];
#pragma unroll
            for (int d = 0; d < 4; ++d) acc[d] = (f32x4){0.f, 0.f, 0.f, 0.f};
#pragma unroll
            for (int ks = 0; ks < 4; ++ks) {
                const bf16x8 pf = *(const bf16x8*)(sP + (it * 16 + ln) * PP + ks * 32 + kg * 8);
#pragma unroll
                for (int d = 0; d < 4; ++d) { const bf16x8 vf = *(const bf16x8*)(sVT + (half * 64 + (d >> 1) * 32 + prow(d & 1, ln)) * QP + (ks & 1) * 32 + kg * 8); acc[d] = mfma16(vf, pf, acc[d]); }
            }
#pragma unroll
            for (int p = 0; p < 2; ++p) *(u32x4*)(OI + (size_t)(row0 + it * 16 + ln) * 512 + h * 128 + half * 64 + p * 32 + kg * 8) = pack8v(acc[2 * p], acc[2 * p + 1]);
        }
        {
            const int dir = w >> 2;
#pragma unroll
            for (int e = 0; e < 2; ++e) {
                const int dvt = (w & 3) * 2 + e;
                bf16x8 vf[2];
#pragma unroll
                for (int ks = 0; ks < 2; ++ks) vf[ks] = *(const bf16x8*)(sVT + (dvt * 16 + ln) * QP + ks * 32 + kg * 8);
#pragma unroll
                for (int p = 0; p < 2; ++p) {
                    f32x4 acc[2];
#pragma unroll
                    for (int n = 0; n < 2; ++n) { acc[n] = (f32x4){0.f, 0.f, 0.f, 0.f};
#pragma unroll
                        for (int ks = 0; ks < 2; ++ks) { const bf16x8 kf = *(const bf16x8*)(sKhT + (dir * 64 + p * 32 + prow(n, ln)) * QP + ks * 32 + kg * 8); acc[n] = mfma16(kf, vf[ks], acc[n]); } }
                    *(u32x4*)(KV + (((size_t)u * 2 + dir) * 128 + dvt * 16 + ln) * 64 + p * 32 + kg * 8) = pack8v(acc[0], acc[1]);
                }
            }
        }
        LBAR();
    }
}

DEV void g2_phase(const Args& a, int G) {
    unsigned char* ws = a.ws;
    const bf16_t* KV = (const bf16_t*)(ws + WS_KV); const float* DEC = (const float*)(ws + WS_DEC); bf16_t* SB = (bf16_t*)(ws + WS_SB);
    for (int gt = blockIdx.x * 512 + threadIdx.x; gt < 128 * 1024; gt += G * 512) {
        const int s = gt >> 10, rem = gt & 1023, dv = rem >> 3, k8 = (rem & 7) * 8;
        const int b = s >> 3, h = (s >> 1) & 3, dir = s & 1;
        float S[8];
#pragma unroll
        for (int j = 0; j < 8; ++j) S[j] = 0.f;
#pragma unroll 1
        for (int blk = 0; blk < 17; ++blk) {
            u32x4 kvr[4]; f32x4 d0[4], d1[4]; size_t offs[4];
#pragma unroll
            for (int i = 0; i < 4; ++i) {
                const int step = blk * 4 + i; int u;
                if (step < 4) { const int c = dir ? 3 - step : step; u = NU_LAT + b * 16 + c * 4 + h; }
                else { const int c = dir ? 67 - step : step - 4; u = b * 256 + c * 4 + h; }
                offs[i] = (((size_t)u * 2 + dir) * 128 + dv) * 64 + k8;
                kvr[i] = *(const u32x4*)(KV + offs[i]);
                const float* dp = DEC + ((size_t)u * 2 + dir) * 64 + k8; d0[i] = *(const f32x4*)dp; d1[i] = *(const f32x4*)(dp + 4);
            }
#pragma unroll
            for (int i = 0; i < 4; ++i) {
                if (blk > 0) *(u32x4*)(SB + offs[i]) = pack8(S);
                float kv[8]; unpack8(kvr[i], kv);
#pragma unroll
                for (int j = 0; j < 8; ++j) S[j] = (j < 4 ? d0[i][j] : d1[i][j - 4]) * S[j] + kv[j];
            }
        }
    }
}

DEV void g3c1_phase(const Args& a, unsigned char* lds, int G) {
    unsigned char* ws = a.ws;
    const bf16_t* Z = (const bf16_t*)(ws + WS_ZH); const bf16_t* QT = (const bf16_t*)(ws + WS_QT); const bf16_t* OI = (const bf16_t*)(ws + WS_OI); const bf16_t* SB = (const bf16_t*)(ws + WS_SB);
    const bf16_t* WSB = (const bf16_t*)(ws + WS_WS); const float* rowss = (const float*)(ws + WS_RSP); bf16_t* MIX = (bf16_t*)(ws + WS_KV);
    const int t = threadIdx.x, lane = t & 63, w = t >> 6, ln = lane & 15, kg = lane >> 4;
    unsigned* sV = (unsigned*)lds;
    {
        bf16x8 nqf[4]; u32x4 noi[4], nog[4];
#define G3_ROW(pu_) ({ const int u_ = 2 * (pu_) + (w >> 2); (u_ >> 8) * SEQ + ((u_ >> 2) & 63) * 64 + (w & 3) * 16 + ln; })
#define G3_LOAD(pu_) do { const int u_ = 2 * (pu_) + (w >> 2), h_ = u_ & 3; const size_t r_ = (size_t)G3_ROW(pu_); \
        _Pragma("unroll") for (int ks = 0; ks < 4; ++ks) { const int k = ks * 32 + kg * 8; nqf[ks] = *(const bf16x8*)(QT + r_ * 512 + (k >> 6) * 256 + h_ * 64 + (k & 63)); } \
        _Pragma("unroll") for (int p = 0; p < 4; ++p) { noi[p] = *(const u32x4*)(OI + r_ * 512 + h_ * 128 + p * 32 + kg * 8); nog[p] = *(const u32x4*)(Z + r_ * ZW + ZC_OG + h_ * 128 + p * 32 + kg * 8); } } while (0)
        if ((int)blockIdx.x < NU_LAT / 2) G3_LOAD((int)blockIdx.x);
        for (int pu = blockIdx.x; pu < NU_LAT / 2; pu += G) {
            const int u = 2 * pu + (w >> 2), h = u & 3, row = G3_ROW(pu);
            bf16x8 qf[4]; u32x4 oi[4], og[4];
#pragma unroll
            for (int i = 0; i < 4; ++i) { qf[i] = nqf[i]; oi[i] = noi[i]; og[i] = nog[i]; }
            if (pu + G < NU_LAT / 2) G3_LOAD(pu + G);
            f32x4 acc[8];
#pragma unroll
            for (int d = 0; d < 8; ++d) acc[d] = (f32x4){0.f, 0.f, 0.f, 0.f};
#pragma unroll
            for (int ks = 0; ks < 4; ++ks) {
                const int k = ks * 32 + kg * 8, dir = k >> 6, kk = k & 63;
                bf16x8 sf[8];
#pragma unroll
                for (int d = 0; d < 8; ++d) sf[d] = *(const bf16x8*)(SB + (((size_t)u * 2 + dir) * 128 + (d >> 1) * 32 + prow(d & 1, ln)) * 64 + kk);
#pragma unroll
                for (int d = 0; d < 8; ++d) acc[d] = mfma16(sf[d], qf[ks], acc[d]);
            }
            float ss = 0.f;
#pragma unroll
            for (int p = 0; p < 4; ++p) { float f[8]; unpack8(oi[p], f);
#pragma unroll
                for (int j = 0; j < 4; ++j) { acc[2 * p][j] += f[j]; acc[2 * p + 1][j] += f[4 + j]; ss += acc[2 * p][j] * acc[2 * p][j] + acc[2 * p + 1][j] * acc[2 * p + 1][j]; } }
            ss += __shfl_xor(ss, 16); ss += __shfl_xor(ss, 32);
            const float rstd = rsqrtf(ss * (1.f / 128.f) + EPS);
#pragma unroll
            for (int p = 0; p < 4; ++p) { const int dv = p * 32 + kg * 8; float f[8], o[8]; unpack8(og[p], f);
                const f32x4 g0 = *(const f32x4*)(a.in[I_GLAG] + dv), g1 = *(const f32x4*)(a.in[I_GLAG] + dv + 4);
#pragma unroll
                for (int j = 0; j < 4; ++j) { o[j] = acc[2 * p][j] * rstd * g0[j] * f[j]; o[4 + j] = acc[2 * p + 1][j] * rstd * g1[j] * f[4 + j]; }
                *(u32x4*)(MIX + (size_t)row * D + h * 128 + dv) = pack8(o); }
        }
#undef G3_ROW
#undef G3_LOAD
    }
    {
        const int cgi = t & 7, pp = t >> 3;
        int hcur = -1; bf16x8 wf[4]; float bs = 0.f; f32x4 g0 = {0.f, 0.f, 0.f, 0.f}, g1 = g0;
        u32x4 nva, nvb, ngu[2]; f32x4 npa, npb, npc, npd;
#define C1_LOAD(v_) do { const int b_ = (v_) >> 8, n_ = ((v_) >> 3) & 31, hd_ = (v_) & 7, r0_ = b_ * SEQ + n_ * 128; \
        nva = *(const u32x4*)(Z + (size_t)(r0_ + 2 * pp) * ZW + ZC_VS + hd_ * 64 + cgi * 8); nvb = *(const u32x4*)(Z + (size_t)(r0_ + 2 * pp + 1) * ZW + ZC_VS + hd_ * 64 + cgi * 8); \
        const float* rp_ = rowss + (size_t)(r0_ + 2 * pp) * 8; npa = *(const f32x4*)rp_; npb = *(const f32x4*)(rp_ + 4); npc = *(const f32x4*)(rp_ + 8); npd = *(const f32x4*)(rp_ + 12); \
        _Pragma("unroll") for (int p = 0; p < 2; ++p) ngu[p] = *(const u32x4*)(Z + (size_t)(r0_ + w * 16 + ln) * ZW + ZC_U + hd_ * 64 + p * 32 + kg * 8); } while (0)
        if ((int)blockIdx.x < NU_LAT) C1_LOAD((int)blockIdx.x);
        for (int v = blockIdx.x; v < NU_LAT; v += G) {
            const int b = v >> 8, n = (v >> 3) & 31, hd = v & 7, r0 = b * SEQ + n * 128;
            if (hd != hcur) { hcur = hd;
#pragma unroll
                for (int ks = 0; ks < 4; ++ks) wf[ks] = *(const bf16x8*)(WSB + ((size_t)hd * 128 + w * 16 + ln) * 128 + ks * 32 + kg * 8);
                bs = a.in[I_BS][hd * 128 + w * 16 + ln];
                g0 = *(const f32x4*)(a.in[I_CMG] + hd * 64 + cgi * 8); g1 = *(const f32x4*)(a.in[I_CMG] + hd * 64 + cgi * 8 + 4); }
            const u32x4 va = nva, vb = nvb; const f32x4 pa = npa, pb = npb, pc = npc, pd = npd; u32x4 gu[2]; gu[0] = ngu[0]; gu[1] = ngu[1];
            if (v + G < NU_LAT) C1_LOAD(v + G);
            {
                float f0[8], f1[8]; unpack8(va, f0); unpack8(vb, f1);
                const float rs0 = rsqrtf((((pa.x + pa.y) + (pa.z + pa.w)) + ((pb.x + pb.y) + (pb.z + pb.w))) * (1.f / 512.f) + EPS), rs1 = rsqrtf((((pc.x + pc.y) + (pc.z + pc.w)) + ((pd.x + pd.y) + (pd.z + pd.w))) * (1.f / 512.f) + EPS);
#pragma unroll
                for (int j = 0; j < 8; ++j) { const float gj = j < 4 ? g0[j] : g1[j - 4]; const int ch = cgi * 8 + j, fsw = (ch ^ (ch >> 3)) & 15;
                    sV[ch * 64 + (((pp >> 2) ^ fsw) << 2) + (pp & 3)] = cvt_pk_bf16(f0[j] * rs0 * gj, f1[j] * rs1 * gj); }
            }
            LBAR();
            {
                f32x4 acc[4];
#pragma unroll
                for (int d = 0; d < 4; ++d) acc[d] = (f32x4){0.f, 0.f, 0.f, 0.f};
#pragma unroll
                for (int ks = 0; ks < 4; ++ks) {
#pragma unroll
                    for (int d = 0; d < 4; ++d) { const int ch = (d >> 1) * 32 + prow(d & 1, ln), fsw = (ch ^ (ch >> 3)) & 15; const bf16x8 vf = *(const bf16x8*)(sV + ch * 64 + (((ks * 4 + kg) ^ fsw) << 2)); acc[d] = mfma16(vf, wf[ks], acc[d]); }
                }
#pragma unroll
                for (int p = 0; p < 2; ++p) { const int ch = hd * 64 + p * 32 + kg * 8; float f[8], o[8]; unpack8(gu[p], f);
#pragma unroll
                    for (int j = 0; j < 4; ++j) { o[j] = (acc[2 * p][j] + bs) * f[j]; o[4 + j] = (acc[2 * p + 1][j] + bs) * f[4 + j]; }
                    *(u32x4*)(MIX + (size_t)(r0 + w * 16 + ln) * D + 512 + ch) = pack8(o); }
            }
            LBAR();
        }
#undef C1_LOAD
    }
}

#define LAS __attribute__((address_space(3)))
#define XB_TMO      128
#define XB_XCNT(j)  (256  + 64 * (j))
#define XB_XSUB(j)  (1280 + 64 * (j))
#define XB_XGEN(j)  (2304 + 64 * (j))
#define XB_TOP      3328
#define XB_TOPGEN   3392
#define XCD_BAR_WORDS 3456
#define XB_SPIN_CAP (1u << 18)

__device__ __forceinline__ unsigned xb_ld(unsigned* p)              { return __hip_atomic_load(p, __ATOMIC_RELAXED, __HIP_MEMORY_SCOPE_AGENT); }
__device__ __forceinline__ unsigned xb_add(unsigned* p, unsigned v) { return __hip_atomic_fetch_add(p, v, __ATOMIC_RELAXED, __HIP_MEMORY_SCOPE_AGENT); }
__device__ __forceinline__ unsigned xb_xcc_id() { return (unsigned)__builtin_amdgcn_s_getreg((3 << 11) | 20) & 0xFu; }
#define XB_SPIN(cond, bar) do { unsigned _sp = 0; while (cond) { __builtin_amdgcn_s_sleep(1); \
    if ((++_sp & 255u) == 0u) { if (xb_ld(&(bar)[XB_TMO])) break; if (_sp > XB_SPIN_CAP) { atomicAdd(&(bar)[XB_TMO], 1u); break; } } } } while (0)

struct XcdBarrier {
    unsigned* bar; unsigned x;
    volatile LAS unsigned* st;
};

__device__ __forceinline__ XcdBarrier xcd_barrier_post(unsigned* bar, volatile LAS unsigned* st) {
    XcdBarrier b; b.bar = bar; b.x = xb_xcc_id(); b.st = st;
    if (threadIdx.x == 0) (void)xb_add(&bar[XB_XCNT(b.x)], 1u);
    return b;
}
__device__ __forceinline__ void xcd_barrier_complete(unsigned* bar, unsigned x, unsigned& nloc, unsigned& nx) {
    const unsigned G = gridDim.x * gridDim.y * gridDim.z;
    unsigned sum, cnt, mine, sp = 0u;
    for (;;) {
        sum = 0u; cnt = 0u; mine = 0u;
#pragma unroll
        for (unsigned j = 0; j < 16; ++j) { const unsigned c = xb_ld(&bar[XB_XCNT(j)]); sum += c; cnt += (c > 0u) ? 1u : 0u; mine = (j == x) ? c : mine; }
        if (sum == G) break;
        __builtin_amdgcn_s_sleep(1);
        if ((++sp & 255u) == 0u) { if (xb_ld(&bar[XB_TMO])) break; if (sp > XB_SPIN_CAP) { atomicAdd(&bar[XB_TMO], 1u); break; } }
    }
    nloc = mine > 0u ? mine : 1u; nx = cnt > 0u ? cnt : 1u;
}

__device__ __forceinline__ void xcd_barrier(const XcdBarrier& b) {
    asm volatile("s_waitcnt vmcnt(0)" ::: "memory");
    __syncthreads();
    if (threadIdx.x == 0) {
        unsigned* bar = b.bar;
        __builtin_amdgcn_s_waitcnt(0);
        unsigned nloc = b.st[0], nx = b.st[1];
        if (nloc == 0u) { xcd_barrier_complete(bar, b.x, nloc, nx); b.st[0] = nloc; b.st[1] = nx; }
        const unsigned old = xb_add(&bar[XB_XSUB(b.x)], 1u);
        const unsigned gen = old / nloc;
        if (old + 1u == (gen + 1u) * nloc) {
            __builtin_amdgcn_fence(__ATOMIC_RELEASE, "agent");
            asm volatile("s_waitcnt vmcnt(0)" ::: "memory");
            const unsigned og = xb_add(&bar[XB_TOP], 1u);
            const unsigned tg = og / nx;
            if (og + 1u == (tg + 1u) * nx) xb_add(&bar[XB_TOPGEN], 1u);
            else XB_SPIN(xb_ld(&bar[XB_TOPGEN]) == tg, bar);
            __builtin_amdgcn_fence(__ATOMIC_ACQUIRE, "agent");
            xb_add(&bar[XB_XGEN(b.x)], 1u);
            asm volatile("s_waitcnt vmcnt(0)" ::: "memory");
        } else {
            XB_SPIN(xb_ld(&bar[XB_XGEN(b.x)]) == gen, bar);
            __builtin_amdgcn_fence(__ATOMIC_ACQUIRE, "agent");
            asm volatile("s_waitcnt vmcnt(0)" ::: "memory");
        }
    }
    __syncthreads();
}


constexpr int NPHASE = 15;
__global__ void __launch_bounds__(512, 2) fwd_kernel(Args a) {
    extern __shared__ __attribute__((aligned(16))) unsigned char lds[];
    const int G = gridDim.x, tid = threadIdx.x, lane = tid & 63, wave = __builtin_amdgcn_readfirstlane(tid >> 6);
    const int gw = blockIdx.x * 8 + wave, NGW = G * 8;
    unsigned char* ws = a.ws;
    const float* mod = (const float*)(ws + WS_MOD);
    bf16_t* XN = (bf16_t*)(ws + WS_XN); bf16_t* ZH = (bf16_t*)(ws + WS_ZH); float* X1C = (float*)(ws + WS_X1C);
    PG8_LAS unsigned char* ldsg = (PG8_LAS unsigned char*)lds;
    const int lo = a.ph_lo, hi = a.ph_hi;
    volatile LAS unsigned* bst = (volatile LAS unsigned*)(ldsg + (LDS_BYTES - 64));
    if (tid == 0) { bst[0] = 0u; bst[1] = 0u; }
    __syncthreads();
    XcdBarrier xbar; xbar.bar = (unsigned*)(ws + WS_CTL); xbar.x = 0; xbar.st = bst;
    if (hi - lo > 1) xbar = xcd_barrier_post((unsigned*)(ws + WS_CTL), bst);
#define IN(k) (lo <= (k) && (k) < hi)
#define SEAM(k) do { if (IN(k) && IN((k) + 1)) { if (a.ph_hi > 4096) cg::this_grid().sync(); else xcd_barrier(xbar); } } while (0)
    if (IN(0)) { p0_prep(a, lds, gw, NGW, wave, lane); } SEAM(0);
    if (IN(1)) { norm_mod_phase(a.in[I_X], a.in[I_CTX], MALL, a.in[I_N1G], mod, 0, 1, XN, gw, NGW, lane);
        shiftw_phase((const bf16_t*)(ws + WS_WIN), ZW, mod, 3, (float*)(ws + WS_SHW1), gw, NGW, lane, true); shiftw_phase((const bf16_t*)(ws + WS_W2A), NFF2, mod, 6, (float*)(ws + WS_SHW2), NGW - 1 - gw, NGW, lane, false); } SEAM(1);
    if (IN(2)) { pg8::Gemm g{XN, (const bf16_t*)(ws + WS_W1A), MALL, NFF2, D}; pg8::StaticOrder S; S.init(MALL, NFF2, G, (int)blockIdx.x); EpiSwiGLU<false> E{ZH, nullptr, nullptr};
        pg8::gemm_phase<EpiSwiGLU<false>, pg8::StaticOrder, true, true>(ldsg, g, S, E); } SEAM(2);
    if (IN(3)) { pg8::Gemm g{ZH, (const bf16_t*)(ws + WS_W1B), MALL, D, DFF}; pg8::StaticOrder S; S.init(MALL, D, G, (int)blockIdx.x); typedef EpiResid<2, true, true, 4> EpiT; EpiT E{a.in[I_X], a.in[I_CTX], a.out, X1C, mod, XN, a.in[I_N2G], (float*)(ws + WS_RS2)};
        pg8::gemm_phase<EpiT, pg8::StaticOrder, true, true>(ldsg, g, S, E); } SEAM(3);
    if (IN(5)) { pg8::Gemm g{XN, (const bf16_t*)(ws + WS_WIN), MALL, ZW, D}; pg8::StaticOrder S; S.init(MALL, ZW, G, (int)blockIdx.x); EpiZ E{ZH, (float*)(ws + WS_RSP), (const float*)(ws + WS_RS2), (const float*)(ws + WS_SHW1)};
        pg8::gemm_phase<EpiZ, pg8::StaticOrder, true, true>(ldsg, g, S, E); } SEAM(5);
    if (IN(6)) { conv_phase(ZH, a.in[I_CONVW], XN, G); } SEAM(6);
    if (IN(7)) { g1_phase(a, lds, G); } SEAM(7);
    if (IN(8)) { g2_phase(a, G); } SEAM(8);
    if (IN(9)) { g3c1_phase(a, lds, G); } SEAM(9);
    if (IN(10)) { pg8::Gemm g{(const bf16_t*)(ws + WS_KV), (const bf16_t*)(ws + WS_WOUT), MLAT, D, D}; pg8::StaticOrder S; S.init(MLAT, D, G, (int)blockIdx.x); typedef EpiResid<5, false, true, 7> EpiT; EpiT E{a.out, a.out, a.out, a.out, mod, XN, a.in[I_N3G], (float*)(ws + WS_RS3)};
        pg8::gemm_phase<EpiT, pg8::StaticOrder, true, true>(ldsg, g, S, E); } SEAM(10);
    if (IN(12)) { pg8::Gemm g{XN, (const bf16_t*)(ws + WS_W2A), MLAT, NFF2, D}; pg8::StaticOrder S; S.init(MLAT, NFF2, G, (int)blockIdx.x); EpiSwiGLU<true> E{ZH, (const float*)(ws + WS_RS3), (const float*)(ws + WS_SHW2)};
        pg8::gemm_phase<EpiSwiGLU<true>, pg8::StaticOrder, true, true>(ldsg, g, S, E); } SEAM(12);
    if (IN(13)) { pg8::Gemm g{ZH, (const bf16_t*)(ws + WS_W2B), MLAT, D, DFF}; pg8::StaticOrder S; S.init(MLAT, D, G, (int)blockIdx.x); typedef EpiResid<8, true, false, 0> EpiT; EpiT E{a.out, a.out, a.out, a.out, mod, nullptr, nullptr, nullptr};
        pg8::gemm_phase<EpiT, pg8::StaticOrder, true, true>(ldsg, g, S, E); } SEAM(13);
    if (IN(14)) { final_norm_phase(a.out, a.in[I_FING], gw, NGW, lane); }
#if defined(MK_EXTRA_SYNC) && MK_EXTRA_SYNC
    if (hi - lo > 1) for (int i = 0; i < MK_EXTRA_SYNC; ++i) cg::this_grid().sync();
#endif
#undef IN
#undef SEAM
}


extern "C" void kernel_launch(void* const* d_in, const int* in_sizes, int n_in, void* d_out, int out_size, void* d_ws, size_t ws_size, hipStream_t stream) {
    static int grid = 0;
    if (grid == 0) {
        if (n_in != 25 || out_size != MLAT * D || ws_size < WS_END) { fprintf(stderr, "kernel_launch: unexpected shapes (n_in %d, out %d, ws %zu; need ws >= %zu)\n", n_in, out_size, ws_size, (size_t)WS_END); grid = -1; return; }
        int dev = 0, cus = 0, per_cu = 0;
        (void)hipGetDevice(&dev); (void)hipDeviceGetAttribute(&cus, hipDeviceAttributeMultiprocessorCount, dev);
        if (hipFuncSetAttribute((const void*)fwd_kernel, hipFuncAttributeMaxDynamicSharedMemorySize, LDS_BYTES) != hipSuccess) { fprintf(stderr, "kernel_launch: hipFuncSetAttribute failed\n"); grid = -1; return; }
        if (hipOccupancyMaxActiveBlocksPerMultiprocessor(&per_cu, (const void*)fwd_kernel, 512, LDS_BYTES) != hipSuccess || per_cu < 1) { fprintf(stderr, "kernel_launch: occupancy query says %d\n", per_cu); per_cu = 1; }
        (void)hipGetLastError();
        grid = cus * per_cu;
    }
    if (grid < 0) return;
    (void)hipMemsetAsync((char*)d_ws + WS_CTL, 0, 1 << 20, stream);
    Args a{};
    for (int i = 0; i < 25; ++i) a.in[i] = (const float*)d_in[i];
    a.out = (float*)d_out; a.ws = (unsigned char*)d_ws;
#if MK_ONE_LAUNCH
    a.ph_lo = 0; a.ph_hi = NPHASE;
    void* args[] = {&a};
    hipError_t e = hipLaunchCooperativeKernel((const void*)fwd_kernel, dim3(grid), dim3(512), args, LDS_BYTES, stream);
    if (e != hipSuccess) fprintf(stderr, "cooperative launch failed: %s (grid %d)\n", hipGetErrorString(e), grid);
#if defined(MK_DUP) && MK_DUP
    for (int p = 0; p < NPHASE; ++p) if ((MK_DUP >> p) & 1) { a.ph_lo = p; a.ph_hi = p + 1; hipLaunchKernelGGL(fwd_kernel, dim3(grid), dim3(512), LDS_BYTES, stream, a); }
#endif
#else
    for (int p = 0; p < NPHASE; ++p) { a.ph_lo = p; a.ph_hi = p + 1; hipLaunchKernelGGL(fwd_kernel, dim3(grid), dim3(512), LDS_BYTES, stream, a); }
#endif
}
```

```cpp
#include <hip/hip_runtime.h>
#include <hip/hip_cooperative_groups.h>
#include <cstdio>
#include <cstdint>
namespace cg = cooperative_groups;
#ifndef MK_ONE_LAUNCH
#define MK_ONE_LAUNCH 1
#endif
#ifndef MK_DUP
#define MK_DUP 0
#endif
#ifndef MK_EXTRA_SYNC
#define MK_EXTRA_SYNC 0
#endif
namespace pg8 {
#define PG8_LAS __attribute__((address_space(3)))
typedef unsigned short bf16_t;
typedef short bf16x8 __attribute__((ext_vector_type(8)));
typedef float f32x4 __attribute__((ext_vector_type(4)));
typedef unsigned u32x4 __attribute__((ext_vector_type(4)));
constexpr int BM = 256, BK = 64, HALF = 128, HTB = HALF * BK * 2  , STAGE_BYTES = 8 * HTB, NXCD = 8, WGM = 8;

__host__ __device__ __forceinline__ int lds_byte(int r, int c) { const int st = (r >> 4) * 2 + (c >> 5), rr = r & 15, cc = c & 31, ob = rr * 64 + cc * 2; return st * 1024 + (ob ^ (((ob >> 9) & 1) << 5)); }
__host__ __device__ __forceinline__ void stage_rc(int b, int& R, int& C) { const int st = b / 1024, sb = b % 1024, swz = sb ^ (((sb >> 9) & 1) << 5); R = (st >> 1) * 16 + swz / 64; C = (st & 1) * 32 + (swz % 64) / 2; }
__host__ __device__ __forceinline__ int perm32(int rho) { const int n = rho >> 4, i = rho & 15; return 8 * (i >> 2) + 4 * n + (i & 3); }

struct Unit { int pm, pn; };
struct Gemm { const bf16_t* A; const bf16_t* Bt; int M, N, K; };

struct StaticOrder {
    int nM, nN, nwg, G, c;
    __host__ __device__ void init(int M, int N, int G_, int c_) { nM = M / BM; nN = N / BM; nwg = nM * nN; G = G_; c = c_; }
    __host__ __device__ bool next(int i, Unit& u) const {
        const long L = (long)i * G + c; if (L >= nwg) return false;
        int wgid = (int)L; { const int q = nwg / NXCD, r = nwg % NXCD, xcd = wgid % NXCD, off = wgid / NXCD; wgid = (xcd < r ? xcd * (q + 1) : r * (q + 1) + (xcd - r) * q) + off; }
        const int nig = WGM * nN, gid = wgid / nig, fm = gid * WGM, gsz = (nM - fm) < WGM ? (nM - fm) : WGM;
        u.pm = fm + ((wgid % nig) % gsz); u.pn = (wgid % nig) / gsz; return true;
    }
    __device__ __forceinline__ void a_ready(const Unit&) const {}
    __device__ __forceinline__ void done(const Unit&) const {}
};

typedef float f32x2_t __attribute__((ext_vector_type(2))); typedef __bf16 bf16x2_t __attribute__((ext_vector_type(2)));
__device__ __forceinline__ unsigned cvt_pk_bf16(float lo, float hi) { f32x2_t v = {lo, hi}; bf16x2_t b = __builtin_convertvector(v, bf16x2_t); return __builtin_bit_cast(unsigned, b); }
template <class Epi, class Sched, bool ALIGN_EPI = false, bool SP2 = false>
__device__ __forceinline__ void gemm_phase(PG8_LAS unsigned char* lds, const Gemm g, const Sched& S, const Epi& E) {
    const int tid = threadIdx.x, wid = __builtin_amdgcn_readfirstlane(tid >> 6), lane = tid & 63, wr = wid >> 2, wc = wid & 3, fr = lane & 15, fq = lane >> 4;
    const int K = g.K, nt = K / BK;
    unsigned voffA[2], voffB[2];
#pragma unroll
    for (int i = 0; i < 2; ++i) { int R, C; stage_rc(tid * 16 + i * 8192, R, C); const int Rb = Epi::PERM ? ((R & ~31) + perm32(R & 31)) : R;
        voffA[i] = (unsigned)(R * K + C) * 2u; voffB[i] = (unsigned)(Rb * K + C) * 2u; }
    const size_t kstep = (size_t)(BK * 2);
    const size_t hstep = (size_t)HALF * K * 2;
    const size_t tstep = 2 * hstep;
    const unsigned ldsw = (unsigned)wid * 1024u;
    const int aoff = lds_byte(wr * 64 + fr, fq * 8), boff = lds_byte(wc * 32 + fr, fq * 8);
#define PG8_SA(b, h) (((b) * 2 + (h)) * HTB)
#define PG8_SB(b, h) ((4 + (b) * 2 + (h)) * HTB)
#define PG8_STAGE(bufoff, gbase, voff) do { _Pragma("unroll") for (int _i = 0; _i < 2; ++_i) \
        __builtin_amdgcn_global_load_lds((const unsigned*)((const char*)(gbase) + (voff)[_i]), (PG8_LAS unsigned*)(lds + (bufoff) + ldsw + _i * 8192), 16, 0, 0); } while (0)
#define PG8_LDA(dst, b, h) do { _Pragma("unroll") for (int m = 0; m < 4; ++m) _Pragma("unroll") for (int k = 0; k < 2; ++k) dst[m][k] = *(const PG8_LAS bf16x8*)(lds + PG8_SA(b, h) + aoff + m * 2048 + k * 1024); } while (0)
#define PG8_LDB(dst, b, h) do { _Pragma("unroll") for (int n = 0; n < 2; ++n) _Pragma("unroll") for (int k = 0; k < 2; ++k) dst[n][k] = *(const PG8_LAS bf16x8*)(lds + PG8_SB(b, h) + boff + n * 2048 + k * 1024); } while (0)
#define PG8_MMA(ai, bj, At, Bt) do { __builtin_amdgcn_s_setprio(1); _Pragma("unroll") for (int m = 0; m < 4; ++m) _Pragma("unroll") for (int n = 0; n < 2; ++n) _Pragma("unroll") for (int k = 0; k < 2; ++k) \
        acc[ai][bj][m][n] = __builtin_amdgcn_mfma_f32_16x16x32_bf16(Bt[n][k], At[m][k], acc[ai][bj][m][n], 0, 0, 0); __builtin_amdgcn_s_setprio(0); } while (0)
#define PG8_WAIT_V(n) asm volatile("s_waitcnt vmcnt(" #n ")" ::: "memory")
#define PG8_WAIT_L(n) asm volatile("s_waitcnt lgkmcnt(" #n ")" ::: "memory")
#define PG8_BAR __builtin_amdgcn_s_barrier()
#define PG8_SCHED __builtin_amdgcn_sched_barrier(0)
    Unit cur, nxt; int ui = 0;
    if (!S.next(0, cur)) return;
    f32x4 acc[2][2][4][2];
#pragma unroll
    for (int a = 0; a < 2; ++a)
#pragma unroll
        for (int b = 0; b < 2; ++b)
#pragma unroll
            for (int m = 0; m < 4; ++m)
#pragma unroll
                for (int n = 0; n < 2; ++n) acc[a][b][m][n] = (f32x4){0.f, 0.f, 0.f, 0.f};
    bf16x8 At[4][2], B0[2][2], B1[2][2];
    const char* cA = (const char*)g.A + (size_t)cur.pm * tstep; const char* cB = (const char*)g.Bt + (size_t)cur.pn * tstep;
    S.a_ready(cur);
    if constexpr (SP2) {
        PG8_STAGE(PG8_SB(0, 0), cB, voffB); PG8_STAGE(PG8_SB(0, 1), cB + hstep, voffB); PG8_STAGE(PG8_SA(0, 0), cA, voffA); PG8_STAGE(PG8_SA(0, 1), cA + hstep, voffA);
        if (wr == 1) PG8_BAR;
        PG8_WAIT_V(2); PG8_BAR;
        PG8_STAGE(PG8_SB(1, 0), cB + kstep, voffB); PG8_STAGE(PG8_SA(1, 0), cA + kstep, voffA); PG8_STAGE(PG8_SB(1, 1), cB + hstep + kstep, voffB);
        PG8_WAIT_V(6); PG8_BAR;
    } else {
        PG8_STAGE(PG8_SB(0, 0), cB, voffB); PG8_STAGE(PG8_SA(0, 0), cA, voffA); PG8_STAGE(PG8_SB(0, 1), cB + hstep, voffB); PG8_STAGE(PG8_SA(0, 1), cA + hstep, voffA);
        if (wr == 1) PG8_BAR;
        PG8_WAIT_V(4); PG8_BAR;
        PG8_STAGE(PG8_SB(1, 0), cB + kstep, voffB); PG8_STAGE(PG8_SA(1, 0), cA + kstep, voffA); PG8_STAGE(PG8_SB(1, 1), cB + hstep + kstep, voffB);
        PG8_WAIT_V(6); PG8_BAR;
    }
    for (;;) {
        const bool has_next = S.next(ui + 1, nxt);
        const char* nA = has_next ? (const char*)g.A + (size_t)nxt.pm * tstep : cA; const char* nB = has_next ? (const char*)g.Bt + (size_t)nxt.pn * tstep : cB;
        for (int t = 0; t < nt; t += 2) {
            const bool last = (t == nt - 2);
            const char* a1 = cA + (size_t)(t + 1) * kstep;
            const char* a2 = last ? nA : cA + (size_t)(t + 2) * kstep; const char* b2 = last ? nB : cB + (size_t)(t + 2) * kstep;
            const char* a3 = a2 + kstep; const char* b3 = b2 + kstep;
            if (last && has_next) S.a_ready(nxt);
            if constexpr (SP2) {
            PG8_LDB(B0, 0, 0); PG8_LDB(B1, 0, 1); PG8_SCHED; PG8_LDA(At, 0, 0); PG8_STAGE(PG8_SA(1, 1), a1 + hstep, voffA);
            PG8_WAIT_V(8); PG8_WAIT_L(0); PG8_BAR; PG8_MMA(0, 0, At, B0); PG8_MMA(0, 1, At, B1); PG8_BAR; PG8_SCHED;
            PG8_LDA(At, 0, 1); PG8_STAGE(PG8_SB(0, 0), b2, voffB); PG8_STAGE(PG8_SB(0, 1), b2 + hstep, voffB); PG8_STAGE(PG8_SA(0, 0), a2, voffA);
            PG8_WAIT_V(8); PG8_WAIT_L(0); PG8_BAR; PG8_MMA(1, 0, At, B0); PG8_MMA(1, 1, At, B1); PG8_BAR; PG8_SCHED;
            PG8_LDB(B0, 1, 0); PG8_LDB(B1, 1, 1); PG8_SCHED; PG8_LDA(At, 1, 0); PG8_STAGE(PG8_SA(0, 1), a2 + hstep, voffA);
            PG8_WAIT_V(8); PG8_WAIT_L(0); PG8_BAR; PG8_MMA(0, 0, At, B0); PG8_MMA(0, 1, At, B1); PG8_BAR; PG8_SCHED;
            PG8_LDA(At, 1, 1); PG8_STAGE(PG8_SB(1, 0), b3, voffB); PG8_STAGE(PG8_SB(1, 1), b3 + hstep, voffB); PG8_STAGE(PG8_SA(1, 0), a3, voffA);
            PG8_WAIT_V(8); PG8_WAIT_L(0); PG8_BAR; PG8_MMA(1, 0, At, B0); PG8_MMA(1, 1, At, B1); PG8_BAR; PG8_SCHED;
            } else {
            PG8_LDB(B0, 0, 0); PG8_SCHED; PG8_LDA(At, 0, 0); PG8_STAGE(PG8_SA(1, 1), a1 + hstep, voffA);
            PG8_WAIT_L(8); PG8_BAR; PG8_WAIT_L(0); PG8_MMA(0, 0, At, B0); PG8_BAR; PG8_SCHED;
            PG8_LDB(B1, 0, 1); PG8_STAGE(PG8_SB(0, 0), b2, voffB);
            PG8_BAR; PG8_WAIT_L(0); PG8_MMA(0, 1, At, B1); PG8_BAR;
            PG8_LDA(At, 0, 1); PG8_STAGE(PG8_SA(0, 0), a2, voffA);
            PG8_BAR; PG8_WAIT_L(0); PG8_MMA(1, 0, At, B0); PG8_BAR; PG8_SCHED;
            PG8_STAGE(PG8_SB(0, 1), b2 + hstep, voffB);
            PG8_WAIT_V(6); PG8_BAR; PG8_MMA(1, 1, At, B1); PG8_BAR;
            PG8_LDB(B0, 1, 0); PG8_SCHED; PG8_LDA(At, 1, 0); PG8_STAGE(PG8_SA(0, 1), a2 + hstep, voffA);
            PG8_WAIT_L(8); PG8_BAR; PG8_WAIT_L(0); PG8_MMA(0, 0, At, B0); PG8_BAR; PG8_SCHED;
            PG8_LDB(B1, 1, 1); PG8_STAGE(PG8_SB(1, 0), b3, voffB);
            PG8_BAR; PG8_WAIT_L(0); PG8_MMA(0, 1, At, B1); PG8_BAR;
            PG8_LDA(At, 1, 1); PG8_STAGE(PG8_SA(1, 0), a3, voffA);
            PG8_BAR; PG8_WAIT_L(0); PG8_MMA(1, 0, At, B0); PG8_BAR; PG8_SCHED;
            PG8_STAGE(PG8_SB(1, 1), b3 + hstep, voffB);
            PG8_WAIT_V(6); PG8_BAR; PG8_MMA(1, 1, At, B1); PG8_BAR;
            }
        }
        if constexpr (ALIGN_EPI) { if (wr == 0) PG8_BAR; }
        if constexpr (!Epi::AFTER_DRAIN) { E(acc, cur, wr, wc, fr, fq); S.done(cur); }
        if (!has_next) break;
#pragma unroll
        for (int a = 0; a < 2; ++a)
#pragma unroll
            for (int b = 0; b < 2; ++b)
#pragma unroll
                for (int m = 0; m < 4; ++m)
#pragma unroll
                    for (int n = 0; n < 2; ++n) acc[a][b][m][n] = (f32x4){0.f, 0.f, 0.f, 0.f};
        cur = nxt; cA = nA; cB = nB; ++ui;
        if constexpr (ALIGN_EPI) { if (wr == 1) PG8_BAR; }
    }
    PG8_WAIT_V(0);
    if constexpr (!ALIGN_EPI) { if (wr == 0) PG8_BAR; }
    PG8_BAR;
    if constexpr (Epi::AFTER_DRAIN) { E.fused(acc, cur, wr, wc, fr, fq, lds, wid, lane); S.done(cur); }
#undef PG8_SA
#undef PG8_SB
#undef PG8_STAGE
#undef PG8_LDA
#undef PG8_LDB
#undef PG8_MMA
#undef PG8_WAIT_V
#undef PG8_WAIT_L
#undef PG8_BAR
#undef PG8_SCHED
}
}
using pg8::bf16_t; using pg8::bf16x8; using pg8::f32x4; using pg8::u32x4; using pg8::Unit; using pg8::cvt_pk_bf16;
typedef unsigned u32x2 __attribute__((ext_vector_type(2)));
#define DEV __device__ __forceinline__
constexpr int D = 1024, NB = 16, SEQ = 4096, MLAT = NB * SEQ, CTXL = 256, MCTX = NB * CTXL, MALL = MLAT + MCTX;
constexpr int DFF = 2816, NFF2 = 2 * DFF, ZW = 2816, NMOD = 9 * D;
constexpr int NU_LAT = NB * 64 * 4, NU_CTX = NB * 4 * 4, NU_ALL = NU_LAT + NU_CTX;
constexpr float EPS = 1e-6f;
constexpr int ZC_OG = 1024, ZC_U = 1536, ZC_VS = 2048, ZC_GLR = 2560;
constexpr size_t MiB = 1u << 20;
constexpr size_t WS_CTL = 0, WS_MOD = 64 * 1024;
static_assert(WS_MOD + 17 * 9216 * 4 <= (1u << 20), "MOD inside the zeroed region");
constexpr size_t WS_W1A = 2 * MiB, WS_W1B = 13 * MiB, WS_WIN = 19 * MiB, WS_WOUT = 25 * MiB, WS_W2A = 27 * MiB, WS_W2B = 38 * MiB, WS_WS = 44 * MiB;
constexpr size_t WS_DEC = 45 * MiB, WS_X1C = 48 * MiB, WS_XN = 64 * MiB, WS_ZH = 200 * MiB, WS_QT = 574 * MiB, WS_OI = 638 * MiB, WS_KV = 702 * MiB, WS_SB = 838 * MiB, WS_RSP = 966 * MiB, WS_RS2 = 969 * MiB, WS_RS3 = 974 * MiB, WS_SHW1 = 978 * MiB, WS_SHW2 = 979 * MiB, WS_END = 980 * MiB;
static_assert(WS_MOD + 17 * NMOD * 4 <= 2 * MiB && WS_RSP + (size_t)MALL * 8 * 4 <= WS_RS2 && WS_RS2 + (size_t)MALL * 16 * 4 <= WS_RS3 && WS_RS3 + (size_t)MLAT * 16 * 4 <= WS_SHW1 && WS_SHW1 + 17 * ZW * 4 <= WS_SHW2 && WS_SHW2 + 17 * NFF2 * 4 <= WS_END, "mod / row-stat / shift regions");
static_assert(WS_W1A + (size_t)NFF2 * D * 2 <= WS_W1B && WS_W1B + (size_t)D * DFF * 2 <= WS_WIN && WS_WIN + (size_t)ZW * D * 2 <= WS_WOUT && WS_WOUT + (size_t)D * D * 2 <= WS_W2A, "w map");
static_assert(WS_W2A + (size_t)NFF2 * D * 2 <= WS_W2B && WS_W2B + (size_t)D * DFF * 2 <= WS_WS && WS_WS + 8 * 128 * 128 * 2 <= WS_DEC && WS_DEC + (size_t)NU_ALL * 128 * 4 <= WS_X1C, "w map 2");
static_assert(WS_X1C + (size_t)MCTX * D * 4 <= WS_XN && WS_XN + (size_t)MALL * D * 2 <= WS_ZH && WS_ZH + (size_t)MALL * ZW * 2 <= WS_QT && WS_QT + (size_t)MLAT * 512 * 2 <= WS_OI, "act map");
static_assert(WS_OI + (size_t)MLAT * 512 * 2 <= WS_KV && WS_KV + (size_t)NU_ALL * 2 * 128 * 64 * 2 <= WS_SB && WS_SB + (size_t)NU_LAT * 2 * 128 * 64 * 2 <= WS_RSP, "act map 2");
static_assert(WS_KV + (size_t)MLAT * D * 2 <= WS_SB, "MIX overlays KV");
constexpr int LDS_BYTES = 147456;

DEV float bf_lo(unsigned w) { return __uint_as_float(w << 16); }
DEV float bf_hi(unsigned w) { return __uint_as_float(w & 0xffff0000u); }
DEV float silu_f(float x) { return x * __builtin_amdgcn_rcpf(1.f + __expf(-x)); }
DEV float gelu_f(float x) { const float t = 1.5957691216f * (x + 0.044715f * x * x * x); return x * __builtin_amdgcn_rcpf(1.f + __expf(-t)); }
DEV float wave_sum(float v) {
#pragma unroll
    for (int o = 1; o < 64; o <<= 1) v += __shfl_xor(v, o);
    return v;
}
#define LDS_WAIT() asm volatile("s_waitcnt lgkmcnt(0)" ::: "memory")
#define LBAR() do { asm volatile("s_waitcnt lgkmcnt(0)" ::: "memory"); __builtin_amdgcn_s_barrier(); asm volatile("" ::: "memory"); } while (0)
DEV void unpack8(const u32x4 w, float (&f)[8]) { f[0] = bf_lo(w.x); f[1] = bf_hi(w.x); f[2] = bf_lo(w.y); f[3] = bf_hi(w.y); f[4] = bf_lo(w.z); f[5] = bf_hi(w.z); f[6] = bf_lo(w.w); f[7] = bf_hi(w.w); }
DEV u32x4 pack8(const float (&f)[8]) { u32x4 w; w.x = cvt_pk_bf16(f[0], f[1]); w.y = cvt_pk_bf16(f[2], f[3]); w.z = cvt_pk_bf16(f[4], f[5]); w.w = cvt_pk_bf16(f[6], f[7]); return w; }
DEV f32x4 mfma16(bf16x8 a, bf16x8 b, f32x4 c) { return __builtin_amdgcn_mfma_f32_16x16x32_bf16(a, b, c, 0, 0, 0); }

DEV int prow(int n, int ln) { return 8 * (ln >> 2) + 4 * n + (ln & 3); }
DEV u32x4 pack8v(const f32x4 a, const f32x4 b) { u32x4 w; w.x = cvt_pk_bf16(a[0], a[1]); w.y = cvt_pk_bf16(a[2], a[3]); w.z = cvt_pk_bf16(b[0], b[1]); w.w = cvt_pk_bf16(b[2], b[3]); return w; }
DEV float row_rstd(const float* rs, int row, int fq) {
    const f32x4 p = *(const f32x4*)(rs + (size_t)row * 16 + fq * 4); float s = (p.x + p.y) + (p.z + p.w);
    s += __shfl_xor(s, 16); s += __shfl_xor(s, 32); return rsqrtf(s * (1.f / D) + EPS);
}
DEV void row_rstd8(const float* rs, int row0, int fq, float (&rstd)[8]) {
    f32x4 p[8];
#pragma unroll
    for (int i = 0; i < 8; ++i) p[i] = *(const f32x4*)(rs + (size_t)(row0 + (i >> 2) * 128 + (i & 3) * 16) * 16 + fq * 4);
#pragma unroll
    for (int i = 0; i < 8; ++i) { float s = (p[i].x + p[i].y) + (p[i].z + p[i].w); s += __shfl_xor(s, 16); s += __shfl_xor(s, 32); rstd[i] = rsqrtf(s * (1.f / D) + EPS); }
}
template <bool FUSED> struct EpiSwiGLU {
    static constexpr bool PERM = true, AFTER_DRAIN = false;
    bf16_t* H; const float* rs; const float* shw;
    DEV void operator()(const f32x4 (&acc)[2][2][4][2], const Unit& u, int wr, int wc, int fr, int fq) const {
        asm volatile("" : "+v"(fr), "+v"(fq));
        const int row0 = u.pm * 256 + wr * 64 + fr, col0 = u.pn * 128 + wc * 32 + 8 * fq;
        f32x4 sg[2], su[2];
        if (FUSED) { const int b = u.pm >> 4; const float* sp = shw + (size_t)b * NFF2 + u.pn * 256 + wc * 32 + 8 * fq;
            sg[0] = *(const f32x4*)sp; sg[1] = *(const f32x4*)(sp + 4); su[0] = *(const f32x4*)(sp + 128); su[1] = *(const f32x4*)(sp + 132); }
        float rstd8[8];
        if (FUSED) row_rstd8(rs, row0, fq, rstd8);
#pragma unroll
        for (int ai = 0; ai < 2; ++ai)
#pragma unroll
            for (int m = 0; m < 4; ++m) {
                const int row = row0 + ai * 128 + m * 16;
                const float rstd = FUSED ? rstd8[ai * 4 + m] : 1.f;
                float h[8];
#pragma unroll
                for (int n = 0; n < 2; ++n)
#pragma unroll
                    for (int j = 0; j < 4; ++j) { float g = acc[ai][0][m][n][j], up = acc[ai][1][m][n][j]; if (FUSED) { g = g * rstd + sg[n][j]; up = up * rstd + su[n][j]; } h[4 * n + j] = silu_f(g) * up; }
                *(u32x4*)(H + (size_t)row * DFF + col0) = pack8(h);
            }
    }
};
template <int GATE_I, bool HALF, bool WITH_XN, int SCALE_I> struct EpiResid {
    static constexpr bool PERM = WITH_XN, AFTER_DRAIN = false; static constexpr int NS = PERM ? 4 : 16;
    const float* res_lat; const float* res_ctx; float* out_lat; float* out_ctx; const float* mod;
    bf16_t* xn; const float* g; float* rs;
    static constexpr int gate_i = GATE_I, scale_i = SCALE_I; static constexpr float coef = HALF ? 0.5f : 1.0f; static constexpr bool has_xn = WITH_XN;
    DEV void operator()(const f32x4 (&acc)[2][2][4][2], const Unit& u, int wr, int wc, int fr, int fq) const {
        asm volatile("" : "+v"(fr), "+v"(fq));
        const bool lat = u.pm < MLAT / 256; const int b = lat ? (u.pm >> 4) : 16;
        const float* res = lat ? res_lat : res_ctx; float* out = lat ? out_lat : out_ctx;
        const int grow0 = u.pm * 256 + wr * 64 + fr, row0 = (lat ? grow0 : grow0 - MLAT), col0 = u.pn * 256 + wc * 32 + (PERM ? 8 : 4) * fq;
        float ss[8];
#pragma unroll
        for (int i = 0; i < 8; ++i) ss[i] = 0.f;
#pragma unroll
        for (int bj = 0; bj < 2; ++bj) {
            f32x4 gv[2], gs[2];
#pragma unroll
            for (int n = 0; n < 2; ++n) { gv[n] = *(const f32x4*)(mod + (size_t)b * NMOD + gate_i * D + col0 + bj * 128 + NS * n) * coef;
                if (has_xn) gs[n] = *(const f32x4*)(g + col0 + bj * 128 + 4 * n) * (*(const f32x4*)(mod + (size_t)b * NMOD + scale_i * D + col0 + bj * 128 + 4 * n) + 1.f); }
#pragma unroll
            for (int ai = 0; ai < 2; ++ai)
#pragma unroll
                for (int m = 0; m < 4; ++m) {
                    const size_t p = (size_t)(row0 + ai * 128 + m * 16) * D + col0 + bj * 128;
                    const f32x4 r0 = *(const f32x4*)(res + p), r1 = *(const f32x4*)(res + p + NS);
                    const f32x4 o0 = r0 + gv[0] * acc[ai][bj][m][0], o1 = r1 + gv[1] * acc[ai][bj][m][1];
                    *(f32x4*)(out + p) = o0; *(f32x4*)(out + p + NS) = o1;
                    if (has_xn) { ss[ai * 4 + m] += (o0[0] * o0[0] + o0[1] * o0[1]) + (o0[2] * o0[2] + o0[3] * o0[3]) + (o1[0] * o1[0] + o1[1] * o1[1]) + (o1[2] * o1[2] + o1[3] * o1[3]);
                        *(u32x4*)(xn + (size_t)(grow0 + ai * 128 + m * 16) * D + col0 + bj * 128) = pack8v(o0 * gs[0], o1 * gs[1]); }
                }
        }
        if (has_xn) {
#pragma unroll
            for (int i = 0; i < 8; ++i) { float v = ss[i]; v += __shfl_xor(v, 16); v += __shfl_xor(v, 32); if (fq == 0) rs[(size_t)(grow0 + (i >> 2) * 128 + (i & 3) * 16) * 16 + u.pn * 4 + wc] = v; }
        }
    }
};
struct EpiZ {
    static constexpr bool PERM = true, AFTER_DRAIN = false;
    bf16_t* Z; float* rowss; const float* rs; const float* shw;
    DEV void operator()(const f32x4 (&acc)[2][2][4][2], const Unit& u, int wr, int wc, int fr, int fq) const {
        asm volatile("" : "+v"(fr), "+v"(fq));
        const int pn = u.pn; const int act = (pn < 4 || pn >= 10) ? 0 : (pn < 6 ? 1 : 2); const bool stat = (pn == 8 || pn == 9);
        const int row0 = u.pm * 256 + wr * 64 + fr, col0 = pn * 256 + wc * 32 + 8 * fq; const int b = u.pm < MLAT / 256 ? (u.pm >> 4) : 16;
        f32x4 sw[2][2];
#pragma unroll
        for (int bj = 0; bj < 2; ++bj)
#pragma unroll
            for (int n = 0; n < 2; ++n) sw[bj][n] = *(const f32x4*)(shw + (size_t)b * ZW + col0 + bj * 128 + 4 * n);
        float rstd8[8]; row_rstd8(rs, row0, fq, rstd8);
#pragma unroll
        for (int ai = 0; ai < 2; ++ai)
#pragma unroll
            for (int m = 0; m < 4; ++m) {
                const int row = row0 + ai * 128 + m * 16; float ss = 0.f; const float rstd = rstd8[ai * 4 + m];
#pragma unroll
                for (int bj = 0; bj < 2; ++bj) {
                    float v[8];
#pragma unroll
                    for (int n = 0; n < 2; ++n)
#pragma unroll
                        for (int j = 0; j < 4; ++j) { float x = acc[ai][bj][m][n][j] * rstd + sw[bj][n][j]; if (act == 1) x = silu_f(x); else if (act == 2) x = gelu_f(x); v[4 * n + j] = x; ss += x * x; }
                    *(u32x4*)(Z + (size_t)row * ZW + col0 + bj * 128) = pack8(v);
                }
                if (stat) { ss += __shfl_xor(ss, 16); ss += __shfl_xor(ss, 32); if (fq == 0) rowss[(size_t)row * 8 + (pn - 8) * 4 + wc] = ss; }
            }
    }
};

struct Args { const float* in[25]; float* out; unsigned char* ws; int ph_lo, ph_hi; };
enum { I_X = 0, I_C, I_CTX, I_CCTX, I_WADA, I_BADA, I_N1G, I_FF1IN, I_FF1OUT, I_N2G, I_WIN, I_CONVW, I_WGF, I_BGF, I_WGB, I_BGB, I_GLAG, I_CMG, I_WS, I_BS, I_WOUT, I_N3G, I_FF2IN, I_FF2OUT, I_FING };

DEV void transpose_item(const float* W, int K, int N, bf16_t* WT, int n0, int drow0, int k0, float* scr, int lane) {
    float tv[32];
#pragma unroll
    for (int i = 0; i < 32; ++i) tv[i] = W[(size_t)(k0 + 2 * i + (lane >> 5)) * N + n0 + (lane & 31)];
#pragma unroll
    for (int i = 0; i < 32; ++i) scr[(2 * i + (lane >> 5)) * 33 + (lane & 31)] = tv[i];
    LDS_WAIT();
    const int c = lane & 7;
#pragma unroll
    for (int j = 0; j < 4; ++j) { const int n = (lane >> 3) + 8 * j; const float* s = scr + (8 * c) * 33 + n;
        u32x4 o; o.x = cvt_pk_bf16(s[0 * 33], s[1 * 33]); o.y = cvt_pk_bf16(s[2 * 33], s[3 * 33]); o.z = cvt_pk_bf16(s[4 * 33], s[5 * 33]); o.w = cvt_pk_bf16(s[6 * 33], s[7 * 33]);
        *(u32x4*)(WT + (size_t)(drow0 + n) * K + k0 + 8 * c) = o; }
    LDS_WAIT();
}
DEV int ffin_rowmap(int n0) { const int up = n0 >= DFF, j = up ? n0 - DFF : n0; return (j >> 7) * 256 + up * 128 + (j & 127); }
DEV int win_rowmap(int n0) { return n0 < 1024 ? n0 : (n0 < 1056 ? n0 - 1024 + ZC_GLR : n0 - 1056 + ZC_OG); }
DEV void p0_prep(const Args& a, unsigned char* lds, int gw, int NGW, int wave, int lane) {
    unsigned char* ws = a.ws;
    float* scr = (float*)(lds + wave * 16384);
    constexpr int I_A = (D / 64) * (NFF2 / 32), I_B = (DFF / 64) * (D / 32), I_IN = (D / 64) * (2592 / 32), I_O = (D / 64) * (D / 32), I_ADA = (NMOD / 16) * 8;
    constexpr int NIT = 2 * I_A + 2 * I_B + I_IN + I_O + I_ADA;
    for (int r = gw; r < I_ADA; r += NGW) {
        {
            const int cgi = r % (NMOD / 16), kc = r / (NMOD / 16), n0 = cgi * 16, k0 = kc * 128, col = lane & 15, kq = lane >> 4;
            {
                float cv[34];
#pragma unroll
                for (int i = 0; i < 34; ++i) cv[i] = ((i >> 1) < 16) ? a.in[I_C][(i >> 1) * D + k0 + lane + 64 * (i & 1)] : a.in[I_CCTX][k0 + lane + 64 * (i & 1)];
#pragma unroll
                for (int i = 0; i < 34; ++i) scr[lane + 64 * i] = silu_f(cv[i]);
            }
            const float* wp = a.in[I_WADA] + (size_t)(k0 + kq * 32) * NMOD + n0 + col;
            float acc[17];
#pragma unroll
            for (int b = 0; b < 17; ++b) acc[b] = 0.f;
            LDS_WAIT();
#pragma unroll 1
            for (int kb = 0; kb < 2; ++kb) {
                float wv[16];
#pragma unroll
                for (int kk = 0; kk < 16; ++kk) wv[kk] = wp[(size_t)(kb * 16 + kk) * NMOD];
#pragma unroll
                for (int kk = 0; kk < 16; ++kk) {
#pragma unroll
                    for (int b = 0; b < 17; ++b) acc[b] += scr[b * 128 + kq * 32 + kb * 16 + kk] * wv[kk]; }
            }
            LDS_WAIT();
            float* mod = (float*)(ws + WS_MOD);
            const float bias = (kc == 0) ? a.in[I_BADA][n0 + col] : 0.f;
#pragma unroll
            for (int b = 0; b < 17; ++b) { float v = acc[b]; v += __shfl_xor(v, 16); v += __shfl_xor(v, 32); if (kq == 0) atomicAdd(mod + b * NMOD + n0 + col, v + bias); }
        }
    }
    {
        constexpr int NT = NIT - I_ADA;
        const float* nW = nullptr; bf16_t* nWT = nullptr; int nK = 0, nN = 0, nn0 = 0, nd0 = 0, nk0 = 0; float tvn[32];
#define T_DEC(r_) do { int q_ = (r_); \
        if (q_ < I_A) { nW = a.in[I_FF1IN]; nWT = (bf16_t*)(ws + WS_W1A); nK = D; nN = NFF2; nn0 = (q_ % (NFF2 / 32)) * 32; nd0 = ffin_rowmap(nn0); nk0 = (q_ / (NFF2 / 32)) * 64; } \
        else if ((q_ -= I_A) < I_A) { nW = a.in[I_FF2IN]; nWT = (bf16_t*)(ws + WS_W2A); nK = D; nN = NFF2; nn0 = (q_ % (NFF2 / 32)) * 32; nd0 = ffin_rowmap(nn0); nk0 = (q_ / (NFF2 / 32)) * 64; } \
        else if ((q_ -= I_A) < I_B) { nW = a.in[I_FF1OUT]; nWT = (bf16_t*)(ws + WS_W1B); nK = DFF; nN = D; nn0 = (q_ % (D / 32)) * 32; nd0 = nn0; nk0 = (q_ / (D / 32)) * 64; } \
        else if ((q_ -= I_B) < I_B) { nW = a.in[I_FF2OUT]; nWT = (bf16_t*)(ws + WS_W2B); nK = DFF; nN = D; nn0 = (q_ % (D / 32)) * 32; nd0 = nn0; nk0 = (q_ / (D / 32)) * 64; } \
        else if ((q_ -= I_B) < I_IN) { nW = a.in[I_WIN]; nWT = (bf16_t*)(ws + WS_WIN); nK = D; nN = 2592; nn0 = (q_ % (2592 / 32)) * 32; nd0 = win_rowmap(nn0); nk0 = (q_ / (2592 / 32)) * 64; } \
        else { q_ -= I_IN; nW = a.in[I_WOUT]; nWT = (bf16_t*)(ws + WS_WOUT); nK = D; nN = D; nn0 = (q_ % (D / 32)) * 32; nd0 = nn0; nk0 = (q_ / (D / 32)) * 64; } \
        _Pragma("unroll") for (int i = 0; i < 32; ++i) tvn[i] = nW[(size_t)(nk0 + 2 * i + (lane >> 5)) * nN + nn0 + (lane & 31)]; } while (0)
        if (gw < NT) T_DEC(gw);
        for (int r = gw; r < NT; r += NGW) {
            bf16_t* const cWT = nWT; const int cK = nK, cd0 = nd0, ck0 = nk0;
#pragma unroll
            for (int i = 0; i < 32; ++i) scr[(2 * i + (lane >> 5)) * 33 + (lane & 31)] = tvn[i];
            if (r + NGW < NT) T_DEC(r + NGW);
            LDS_WAIT();
            const int c = lane & 7;
#pragma unroll
            for (int j = 0; j < 4; ++j) { const int n = (lane >> 3) + 8 * j; const float* sp = scr + (8 * c) * 33 + n;
                u32x4 o; o.x = cvt_pk_bf16(sp[0 * 33], sp[1 * 33]); o.y = cvt_pk_bf16(sp[2 * 33], sp[3 * 33]); o.z = cvt_pk_bf16(sp[4 * 33], sp[5 * 33]); o.w = cvt_pk_bf16(sp[6 * 33], sp[7 * 33]);
                *(u32x4*)(cWT + (size_t)(cd0 + n) * cK + ck0 + 8 * c) = o; }
            LDS_WAIT();
        }
#undef T_DEC
    }
    const int gt = gw * 64 + lane, NGT = NGW * 64;
    for (int i = gt; i < 8 * 128 * 128 / 2; i += NGT) { const float2 v = ((const float2*)a.in[I_WS])[i]; ((unsigned*)(ws + WS_WS))[i] = cvt_pk_bf16(v.x, v.y); }
    for (int i = gt; i < (ZW - 2592) * D / 2; i += NGT) ((unsigned*)(ws + WS_WIN + (size_t)2592 * D * 2))[i] = 0u;
}

DEV void norm_mod_phase(const float* src_lat, const float* src_ctx, int nrows, const float* g, const float* mod, int shift_i, int scale_i, bf16_t* XN, int gw, int NGW, int lane) {
    for (int row = 2 * gw; row < nrows; row += 2 * NGW) {
        const bool lat = row < MLAT; const int b = lat ? (row >> 12) : 16;
        const f32x4* xr = (const f32x4*)(lat ? src_lat + (size_t)row * D : src_ctx + (size_t)(row - MLAT) * D) + lane;
        f32x4 v[2][4], gm[4], sh[4];
#pragma unroll
        for (int r = 0; r < 2; ++r)
#pragma unroll
            for (int j = 0; j < 4; ++j) v[r][j] = __builtin_nontemporal_load(&xr[r * 256 + 64 * j]);
        const f32x4* gp = (const f32x4*)g + lane; const f32x4* scp = (const f32x4*)(mod + (size_t)b * NMOD + scale_i * D) + lane; const f32x4* shp = (const f32x4*)(mod + (size_t)b * NMOD + shift_i * D) + lane;
#pragma unroll
        for (int j = 0; j < 4; ++j) { gm[j] = gp[64 * j] * (scp[64 * j] + 1.f); sh[j] = shp[64 * j]; }
#pragma unroll
        for (int r = 0; r < 2; ++r) {
            float s = 0.f;
#pragma unroll
            for (int j = 0; j < 4; ++j) s += (v[r][j].x * v[r][j].x + v[r][j].y * v[r][j].y) + (v[r][j].z * v[r][j].z + v[r][j].w * v[r][j].w);
            const float rstd = rsqrtf(wave_sum(s) * (1.f / D) + EPS);
            u32x2* o8 = (u32x2*)(XN + (size_t)(row + r) * D) + lane;
#pragma unroll
            for (int j = 0; j < 4; ++j) { const f32x4 y = (v[r][j] * rstd) * gm[j] + sh[j]; u32x2 w; w.x = cvt_pk_bf16(y.x, y.y); w.y = cvt_pk_bf16(y.z, y.w); o8[64 * j] = w; }
        }
    }
}
DEV void final_norm_phase(float* xo, const float* g, int gw, int NGW, int lane) {
    const f32x4* gp = (const f32x4*)g + lane;
    f32x4 gm[4];
#pragma unroll
    for (int j = 0; j < 4; ++j) gm[j] = gp[64 * j];
    for (int vr = 2 * gw; vr < MLAT; vr += 2 * NGW) {
        const int rnd = 3 - (vr >> 14), wv = vr & 16383, row = (((wv >> 11) * 32 + rnd * 8 + ((wv >> 8) & 7)) << 8) + (wv & 255);
        f32x4* xr = (f32x4*)(xo + (size_t)row * D) + lane;
        f32x4 v[2][4];
#pragma unroll
        for (int r = 0; r < 2; ++r)
#pragma unroll
            for (int j = 0; j < 4; ++j) v[r][j] = xr[r * 256 + 64 * j];
#pragma unroll
        for (int r = 0; r < 2; ++r) {
            float s = 0.f;
#pragma unroll
            for (int j = 0; j < 4; ++j) s += (v[r][j].x * v[r][j].x + v[r][j].y * v[r][j].y) + (v[r][j].z * v[r][j].z + v[r][j].w * v[r][j].w);
            const float rstd = rsqrtf(wave_sum(s) * (1.f / D) + EPS);
#pragma unroll
            for (int j = 0; j < 4; ++j) __builtin_nontemporal_store((v[r][j] * rstd) * gm[j], &xr[r * 256 + 64 * j]);
        }
    }
}

DEV void shiftw_phase(const bf16_t* Wt, int N, const float* mod, int shift_i, float* shw, int gw, int NGW, int lane, bool with_ctx) {
    const int ln = lane & 15, kg = lane >> 4;
    for (int it = gw; it < N / 16; it += NGW) {
        const int n0 = it * 16;
        f32x4 acc0 = {0.f, 0.f, 0.f, 0.f}, acc1 = {0.f, 0.f, 0.f, 0.f};
        const bf16_t* wrow = Wt + (size_t)(n0 + ln) * D + kg * 8;
        const float* srow = mod + (size_t)ln * NMOD + shift_i * D + kg * 8;
        const float* crow = mod + (size_t)16 * NMOD + shift_i * D + kg * 8;
#pragma unroll 8
        for (int ks = 0; ks < 32; ++ks) {
            const bf16x8 wf = *(const bf16x8*)(wrow + ks * 32);
            const f32x4 s0 = *(const f32x4*)(srow + ks * 32), s1 = *(const f32x4*)(srow + ks * 32 + 4);
            const u32x4 sp = pack8v(s0, s1);
            acc0 = mfma16(wf, __builtin_bit_cast(bf16x8, sp), acc0);
            if (with_ctx) {
                f32x4 c0 = {0.f, 0.f, 0.f, 0.f}, c1 = c0;
                if (ln == 0) { c0 = *(const f32x4*)(crow + ks * 32); c1 = *(const f32x4*)(crow + ks * 32 + 4); }
                const u32x4 cp = pack8v(c0, c1);
                acc1 = mfma16(wf, __builtin_bit_cast(bf16x8, cp), acc1);
            }
        }
        *(f32x4*)(shw + (size_t)ln * N + n0 + kg * 4) = acc0;
        if (with_ctx && ln == 0) *(f32x4*)(shw + (size_t)16 * N + n0 + kg * 4) = acc1;
    }
}

DEV void conv_phase(const bf16_t* Z, const float* cw, bf16_t* QKV, int G) {
    const int gt = blockIdx.x * 512 + threadIdx.x, cgi = gt & 127, ch0 = cgi * 8;
    float w[9][8];
#pragma unroll
    for (int t = 0; t < 9; ++t) { const f32x4 a = *(const f32x4*)(cw + t * 1024 + ch0), b = *(const f32x4*)(cw + t * 1024 + ch0 + 4); w[t][0] = a.x; w[t][1] = a.y; w[t][2] = a.z; w[t][3] = a.w; w[t][4] = b.x; w[t][5] = b.y; w[t][6] = b.z; w[t][7] = b.w; }
    const float qs = (ch0 < 256) ? 0.125f : 1.f;
    const u32x4 zero4 = {0u, 0u, 0u, 0u};
    for (int sid = gt >> 7; sid < NB * 64; sid += (G * 512) >> 7) {
        const int cc = sid & 63, b = sid >> 6; const bool hasL = cc > 0, hasR = cc < 63;
        const bf16_t* zp = Z + (size_t)(b * SEQ + cc) * ZW + ch0;
        bf16_t* op = QKV + (size_t)(b * SEQ + cc) * D + ch0;
        float win[3][3][8];
        u32x4 raw[3];
#define CV_LOAD(r_) do { const bf16_t* q_ = zp + (size_t)(r_) * 64 * ZW; const bool v_ = (r_) < 64; \
        raw[0] = (v_ && hasL) ? *(const u32x4*)(q_ - ZW) : zero4; raw[1] = v_ ? *(const u32x4*)q_ : zero4; raw[2] = (v_ && hasR) ? *(const u32x4*)(q_ + ZW) : zero4; } while (0)
#define CV_UNPACK(slot_) do { unpack8(raw[0], win[slot_][0]); unpack8(raw[1], win[slot_][1]); unpack8(raw[2], win[slot_][2]); } while (0)
#define CV_STEP(r_, top_, mid_, bot_) do { if ((r_) < 64) { float acc[8]; \
        _Pragma("unroll") for (int j = 0; j < 8; ++j) { float s_ = 0.f; \
            _Pragma("unroll") for (int dx = 0; dx < 3; ++dx) s_ += w[dx][j] * win[top_][dx][j] + w[3 + dx][j] * win[mid_][dx][j] + w[6 + dx][j] * win[bot_][dx][j]; \
            acc[j] = silu_f(s_) * qs; } \
        *(u32x4*)(op + (size_t)(r_) * 64 * D) = pack8(acc); \
        CV_UNPACK(top_); CV_LOAD((r_) + 3); } } while (0)
#pragma unroll
        for (int dx = 0; dx < 3; ++dx)
#pragma unroll
            for (int j = 0; j < 8; ++j) win[2][dx][j] = 0.f;
        CV_LOAD(0); CV_UNPACK(0); CV_LOAD(1); CV_UNPACK(1); CV_LOAD(2);
        for (int r = 0; r < 66; r += 3) { CV_STEP(r, 2, 0, 1); CV_STEP(r + 1, 0, 1, 2); CV_STEP(r + 2, 1, 2, 0); }
#undef CV_LOAD
#undef CV_UNPACK
#undef CV_STEP
    }
    for (int row = MLAT + (gt >> 7); row < MALL; row += (G * 512) >> 7) {
        float acc[8];
#pragma unroll
        for (int j = 0; j < 8; ++j) acc[j] = 0.f;
        const int t = (row - MLAT) & 255;
#pragma unroll
        for (int dx = -1; dx <= 1; ++dx) { const int t2 = t + dx;
            if (t2 >= 0 && t2 < 256) { float f[8]; unpack8(*(const u32x4*)(Z + (size_t)(row + dx) * ZW + ch0), f);
#pragma unroll
                for (int j = 0; j < 8; ++j) acc[j] += w[3 + dx + 1][j] * f[j]; } }
#pragma unroll
        for (int j = 0; j < 8; ++j) acc[j] = silu_f(acc[j]) * qs;
        *(u32x4*)(QKV + (size_t)row * D + ch0) = pack8(acc);
    }
}

constexpr int L_GLR = 0, L_B = 8192, BP = 68, L_TOT = L_B + 2 * 64 * BP * 4, L_Q = L_TOT + 2048, QP = 72, L_K = L_Q + 2 * 64 * QP * 2, L_KHT = L_K + 2 * 64 * QP * 2, L_VT = L_KHT + 2 * 64 * QP * 2,
              L_P = L_VT + 128 * QP * 2, PP = 136, L_G1END = L_P + 64 * PP * 2;
static_assert(L_G1END <= LDS_BYTES, "G1 LDS");
DEV void gla_unit_rows(int u, int& b, int& c, int& h, int& row0) {
    if (u < NU_LAT) { b = u >> 8; c = (u >> 2) & 63; h = u & 3; row0 = b * SEQ + c * 64; }
    else { const int v = u - NU_LAT; b = v >> 4; c = (v >> 2) & 3; h = v & 3; row0 = MLAT + b * CTXL + c * 64; }
}
DEV void g1_phase(const Args& a, unsigned char* lds, int G) {
    unsigned char* ws = a.ws;
    const bf16_t* Z = (const bf16_t*)(ws + WS_ZH); const bf16_t* QKV = (const bf16_t*)(ws + WS_XN);
    bf16_t* QT = (bf16_t*)(ws + WS_QT); bf16_t* OI = (bf16_t*)(ws + WS_OI); bf16_t* KV = (bf16_t*)(ws + WS_KV); float* DEC = (float*)(ws + WS_DEC);
    const int t = threadIdx.x, lane = t & 63, w = t >> 6, ln = lane & 15, kg = lane >> 4;
    float* sB = (float*)(lds + L_B);
    bf16_t* sQ = (bf16_t*)(lds + L_Q); bf16_t* sK = (bf16_t*)(lds + L_K); bf16_t* sKhT = (bf16_t*)(lds + L_KHT); bf16_t* sVT = (bf16_t*)(lds + L_VT); bf16_t* sP = (bf16_t*)(lds + L_P);
    const int gdir = w >> 2, dkt = w & 3;
#define G1_LOAD(u_) do { int b_, c_, h_, r_; gla_unit_rows((u_), b_, c_, h_, r_); \
        _Pragma("unroll") for (int pt = 0; pt < 4; ++pt) gfn[pt] = (kg < 2) ? *(const u32x4*)(Z + (size_t)(r_ + pt * 16 + ln) * ZW + ZC_GLR + gdir * 16 + kg * 8) : (u32x4){0u, 0u, 0u, 0u}; \
        const bf16_t* qp_ = QKV + (size_t)(r_ + (t & 63)) * D + (t >> 6) * 8; \
        qn = *(const u32x4*)(qp_ + h_ * 64); kn = *(const u32x4*)(qp_ + 256 + h_ * 64); vn0 = *(const u32x4*)(qp_ + 512 + h_ * 128); vn1 = *(const u32x4*)(qp_ + 512 + h_ * 128 + 64); } while (0)
#define G1_WLOAD(h_) do { const float* wg_ = a.in[gdir ? I_WGB : I_WGF] + (h_) * 64 + dkt * 16 + ln; float wv_[8]; \
        _Pragma("unroll") for (int j = 0; j < 8; ++j) wv_[j] = (kg < 2) ? wg_[(kg * 8 + j) * 256] : 0.f; \
        const u32x4 wp_ = pack8(wv_); wfrag = __builtin_bit_cast(bf16x8, wp_); bias4 = *(const f32x4*)(a.in[gdir ? I_BGB : I_BGF] + (h_) * 64 + dkt * 16 + kg * 4); } while (0)
#define DPP_SHR(x_, n_) __builtin_bit_cast(float, __builtin_amdgcn_update_dpp(0, __builtin_bit_cast(int, (x_)), 0x110 | (n_), 0xf, 0xf, true))
    u32x4 qn, kn, vn0, vn1, gfn[4];
    if ((int)blockIdx.x < NU_ALL) G1_LOAD((int)blockIdx.x);
    bf16x8 wfrag; f32x4 bias4; int hcur = blockIdx.x & 3;
    G1_WLOAD(hcur);
    for (int u = blockIdx.x; u < NU_ALL; u += G) {
        int b, c, h, row0; gla_unit_rows(u, b, c, h, row0); const bool lat = u < NU_LAT;
        if (h != hcur) { hcur = h; G1_WLOAD(h); }
        const int pos = t & 63, g8 = t >> 6;
        const u32x4 qraw = qn, kraw = kn, vraw0 = vn0, vraw1 = vn1;
        u32x4 gf[4];
#pragma unroll
        for (int pt = 0; pt < 4; ++pt) gf[pt] = gfn[pt];
        if (u + G < NU_ALL) G1_LOAD(u + G);
        {
            float gl[4][4], cs[4][4], tot[4];
#pragma unroll
            for (int pt = 0; pt < 4; ++pt) {
                f32x4 pre = mfma16(wfrag, __builtin_bit_cast(bf16x8, gf[pt]), bias4);
#pragma unroll
                for (int r = 0; r < 4; ++r) { const float x = pre[r]; const float ls = (fminf(x, 0.f) - __logf(1.f + __expf(-fabsf(x)))) * (1.f / 16.f); gl[pt][r] = ls;
                    float sc = ls; sc += DPP_SHR(sc, 1); sc += DPP_SHR(sc, 2); sc += DPP_SHR(sc, 4); sc += DPP_SHR(sc, 8); cs[pt][r] = sc; }
            }
#pragma unroll
            for (int r = 0; r < 4; ++r) { float off = 0.f;
#pragma unroll
                for (int pt = 0; pt < 4; ++pt) { const float tt = __shfl(cs[pt][r], (lane & 48) | 15); cs[pt][r] += off; off += tt; }
                tot[r] = off; }
            if (gdir) {
#pragma unroll
                for (int pt = 0; pt < 4; ++pt)
#pragma unroll
                    for (int r = 0; r < 4; ++r) cs[pt][r] = tot[r] - cs[pt][r] + gl[pt][r];
            }
#pragma unroll
            for (int pt = 0; pt < 4; ++pt) *(f32x4*)(sB + (gdir * 64 + pt * 16 + ln) * BP + dkt * 16 + kg * 4) = (f32x4){cs[pt][0], cs[pt][1], cs[pt][2], cs[pt][3]};
            if (ln == 15) *(f32x4*)(DEC + ((size_t)u * 2 + gdir) * 64 + dkt * 16 + kg * 4) = (f32x4){__expf(tot[0]), __expf(tot[1]), __expf(tot[2]), __expf(tot[3])};
        }
        LBAR();
        {
            float q[8], k[8]; unpack8(qraw, q); unpack8(kraw, k);
            const unsigned tsel = (lane & 1) ? 0x03020706u : 0x05040100u;
#pragma unroll
            for (int dir = 0; dir < 2; ++dir) {
                const float* bp = sB + (dir * 64 + pos) * BP + g8 * 8; const float* bl = sB + (dir * 64 + (dir ? 0 : 63)) * BP + g8 * 8;
                const f32x4 b0 = *(const f32x4*)bp, b1 = *(const f32x4*)(bp + 4), l0 = *(const f32x4*)bl, l1 = *(const f32x4*)(bl + 4);
                float qt[8], kt[8], kh[8];
#pragma unroll
                for (int j = 0; j < 8; ++j) { const float bb = j < 4 ? b0[j] : b1[j - 4], ll = j < 4 ? l0[j] : l1[j - 4]; qt[j] = q[j] * __expf(bb); kt[j] = k[j] * __expf(-bb); kh[j] = k[j] * __expf(ll - bb); }
                const u32x4 qw = pack8(qt), kw = pack8(kt), hw = pack8(kh);
                *(u32x4*)(sQ + (dir * 64 + pos) * QP + g8 * 8) = qw;
                *(u32x4*)(sK + (dir * 64 + pos) * QP + g8 * 8) = kw;
                { unsigned* kp = (unsigned*)(sKhT + (dir * 64 + g8 * 8 + (lane & 1)) * QP + (pos & ~1));
#pragma unroll
                  for (int d = 0; d < 4; ++d) { const unsigned own = hw[d], oth = (unsigned)__builtin_amdgcn_update_dpp(0, (int)own, 0xB1, 0xf, 0xf, true);
                      kp[d * QP] = __builtin_amdgcn_perm(oth, own, tsel); } }
            }
#pragma unroll
            for (int i = 0; i < 2; ++i) { const u32x4 vw = i ? vraw1 : vraw0; unsigned* vp = (unsigned*)(sVT + ((g8 + 8 * i) * 8 + (lane & 1)) * QP + (pos & ~1));
#pragma unroll
                for (int d = 0; d < 4; ++d) { const unsigned own = vw[d], oth = (unsigned)__builtin_amdgcn_update_dpp(0, (int)own, 0xB1, 0xf, 0xf, true);
                    vp[d * QP] = __builtin_amdgcn_perm(oth, own, tsel); } }
        }
        LBAR();
        if (lat) {
            const int p2 = t >> 3, g2 = (t & 7) * 8;
#pragma unroll
            for (int dir = 0; dir < 2; ++dir) *(u32x4*)(QT + (size_t)(row0 + p2) * 512 + dir * 256 + h * 64 + g2) = *(const u32x4*)(sQ + (dir * 64 + p2) * QP + g2);
        }
        {
            const int dir = w >> 2, it = w & 3;
            bf16x8 qf[2];
#pragma unroll
            for (int ks = 0; ks < 2; ++ks) qf[ks] = *(const bf16x8*)(sQ + (dir * 64 + it * 16 + ln) * QP + ks * 32 + kg * 8);
#pragma unroll
            for (int jt = 0; jt < 4; ++jt) {
                f32x4 acc = {0.f, 0.f, 0.f, 0.f};
                const bool live = dir ? (jt >= it) : (jt <= it);
                if (live) {
#pragma unroll
                    for (int ks = 0; ks < 2; ++ks) { const bf16x8 kf = *(const bf16x8*)(sK + (dir * 64 + jt * 16 + ln) * QP + ks * 32 + kg * 8); acc = mfma16(kf, qf[ks], acc); }
                }
                const int i = it * 16 + ln, j0 = jt * 16 + kg * 4;
                float pv[4];
#pragma unroll
                for (int r = 0; r < 4; ++r) { const int j = j0 + r; const bool keep = dir ? (j >= i) : (j <= i); pv[r] = keep ? acc[r] : 0.f; }
                u32x2 pw; pw.x = cvt_pk_bf16(pv[0], pv[1]); pw.y = cvt_pk_bf16(pv[2], pv[3]);
                *(u32x2*)(sP + i * PP + dir * 64 + j0) = pw;
            }
        }
        LBAR();
        if (lat) {
            const int it = w & 3, half = w >> 2;
            f32x4 acc[4];
#pragma unroll
            for (int d = 0; d < 4; ++d) acc[d] = (f32x4){0.f, 0.f, 0.f, 0.f};
#pragma unroll
            for (int ks = 0; ks < 4; ++ks) {
                const bf16x8 pf = *(const bf16x8*)(sP + (it * 16 + ln) * PP + ks * 32 + kg * 8);
#pragma unroll
                for (int d = 0; d < 4; ++d) { const bf16x8 vf = *(const bf16x8*)(sVT + (half * 64 + (d >> 1) * 32 + prow(d & 1, ln)) * QP + (ks & 1) * 32 + kg * 8); acc[d] = mfma16(vf, pf, acc[d]); }
            }
#pragma unroll
            for (int p = 0; p < 2; ++p) *(u32x4*)(OI + (size_t)(row0 + it * 16 + ln) * 512 + h * 128 + half * 64 + p * 32 + kg * 8) = pack8v(acc[2 * p], acc[2 * p + 1]);
        }
        {
            const int dir = w >> 2;
#pragma unroll
            for (int e = 0; e < 2; ++e) {
                const int dvt = (w & 3) * 2 + e;
                bf16x8 vf[2];
#pragma unroll
                for (int ks = 0; ks < 2; ++ks) vf[ks] = *(const bf16x8*)(sVT + (dvt * 16 + ln) * QP + ks * 32 + kg * 8);
#pragma unroll
                for (int p = 0; p < 2; ++p) {
                    f32x4 acc[2];
#pragma unroll
                    for (int n = 0; n < 2; ++n) { acc[n] = (f32x4){0.f, 0.f, 0.f, 0.f};
#pragma unroll
                        for (int ks = 0; ks < 2; ++ks) { const bf16x8 kf = *(const bf16x8*)(sKhT + (dir * 64 + p * 32 + prow(n, ln)) * QP + ks * 32 + kg * 8); acc[n] = mfma16(kf, vf[ks], acc[n]); } }
                    *(u32x4*)(KV + (((size_t)u * 2 + dir) * 128 + dvt * 16 + ln) * 64 + p * 32 + kg * 8) = pack8v(acc[0], acc[1]);
                }
            }
        }
        LBAR();
    }
}

DEV void g2_phase(const Args& a, int G) {
    unsigned char* ws = a.ws;
    const bf16_t* KV = (const bf16_t*)(ws + WS_KV); const float* DEC = (const float*)(ws + WS_DEC); bf16_t* SB = (bf16_t*)(ws + WS_SB);
    for (int gt = blockIdx.x * 512 + threadIdx.x; gt < 128 * 1024; gt += G * 512) {
        const int s = gt >> 10, rem = gt & 1023, dv = rem >> 3, k8 = (rem & 7) * 8;
        const int b = s >> 3, h = (s >> 1) & 3, dir = s & 1;
        float S[8];
#pragma unroll
        for (int j = 0; j < 8; ++j) S[j] = 0.f;
#pragma unroll 1
        for (int blk = 0; blk < 17; ++blk) {
            u32x4 kvr[4]; f32x4 d0[4], d1[4]; size_t offs[4];
#pragma unroll
            for (int i = 0; i < 4; ++i) {
                const int step = blk * 4 + i; int u;
                if (step < 4) { const int c = dir ? 3 - step : step; u = NU_LAT + b * 16 + c * 4 + h; }
                else { const int c = dir ? 67 - step : step - 4; u = b * 256 + c * 4 + h; }
                offs[i] = (((size_t)u * 2 + dir) * 128 + dv) * 64 + k8;
                kvr[i] = *(const u32x4*)(KV + offs[i]);
                const float* dp = DEC + ((size_t)u * 2 + dir) * 64 + k8; d0[i] = *(const f32x4*)dp; d1[i] = *(const f32x4*)(dp + 4);
            }
#pragma unroll
            for (int i = 0; i < 4; ++i) {
                if (blk > 0) *(u32x4*)(SB + offs[i]) = pack8(S);
                float kv[8]; unpack8(kvr[i], kv);
#pragma unroll
                for (int j = 0; j < 8; ++j) S[j] = (j < 4 ? d0[i][j] : d1[i][j - 4]) * S[j] + kv[j];
            }
        }
    }
}

DEV void g3c1_phase(const Args& a, unsigned char* lds, int G) {
    unsigned char* ws = a.ws;
    const bf16_t* Z = (const bf16_t*)(ws + WS_ZH); const bf16_t* QT = (const bf16_t*)(ws + WS_QT); const bf16_t* OI = (const bf16_t*)(ws + WS_OI); const bf16_t* SB = (const bf16_t*)(ws + WS_SB);
    const bf16_t* WSB = (const bf16_t*)(ws + WS_WS); const float* rowss = (const float*)(ws + WS_RSP); bf16_t* MIX = (bf16_t*)(ws + WS_KV);
    const int t = threadIdx.x, lane = t & 63, w = t >> 6, ln = lane & 15, kg = lane >> 4;
    unsigned* sV = (unsigned*)lds;
    {
        bf16x8 nqf[4]; u32x4 noi[4], nog[4];
        f32x4 glag[4][2];
#pragma unroll
        for (int p = 0; p < 4; ++p) { glag[p][0] = *(const f32x4*)(a.in[I_GLAG] + p * 32 + kg * 8); glag[p][1] = *(const f32x4*)(a.in[I_GLAG] + p * 32 + kg * 8 + 4); }
#define G3_ROW(pu_) ({ const int u_ = 2 * (pu_) + (w >> 2); (u_ >> 8) * SEQ + ((u_ >> 2) & 63) * 64 + (w & 3) * 16 + ln; })
#define G3_LOAD(pu_) do { const int u_ = 2 * (pu_) + (w >> 2), h_ = u_ & 3; const size_t r_ = (size_t)G3_ROW(pu_); \
        _Pragma("unroll") for (int ks = 0; ks < 4; ++ks) { const int k = ks * 32 + kg * 8; nqf[ks] = *(const bf16x8*)(QT + r_ * 512 + (k >> 6) * 256 + h_ * 64 + (k & 63)); } \
        _Pragma("unroll") for (int p = 0; p < 4; ++p) { noi[p] = *(const u32x4*)(OI + r_ * 512 + h_ * 128 + p * 32 + kg * 8); nog[p] = *(const u32x4*)(Z + r_ * ZW + ZC_OG + h_ * 128 + p * 32 + kg * 8); } } while (0)
        if ((int)blockIdx.x < NU_LAT / 2) G3_LOAD((int)blockIdx.x);
        for (int pu = blockIdx.x; pu < NU_LAT / 2; pu += G) {
            const int u = 2 * pu + (w >> 2), h = u & 3, row = G3_ROW(pu);
            bf16x8 qf[4]; u32x4 oi[4], og[4];
#pragma unroll
            for (int i = 0; i < 4; ++i) { qf[i] = nqf[i]; oi[i] = noi[i]; og[i] = nog[i]; }
            if (pu + G < NU_LAT / 2) G3_LOAD(pu + G);
            f32x4 acc[8];
#pragma unroll
            for (int d = 0; d < 8; ++d) acc[d] = (f32x4){0.f, 0.f, 0.f, 0.f};
#pragma unroll
            for (int ks = 0; ks < 4; ++ks) {
                const int k = ks * 32 + kg * 8, dir = k >> 6, kk = k & 63;
                bf16x8 sf[8];
#pragma unroll
                for (int d = 0; d < 8; ++d) sf[d] = *(const bf16x8*)(SB + (((size_t)u * 2 + dir) * 128 + (d >> 1) * 32 + prow(d & 1, ln)) * 64 + kk);
#pragma unroll
                for (int d = 0; d < 8; ++d) acc[d] = mfma16(sf[d], qf[ks], acc[d]);
            }
            float ss = 0.f;
#pragma unroll
            for (int p = 0; p < 4; ++p) { float f[8]; unpack8(oi[p], f);
#pragma unroll
                for (int j = 0; j < 4; ++j) { acc[2 * p][j] += f[j]; acc[2 * p + 1][j] += f[4 + j]; ss += acc[2 * p][j] * acc[2 * p][j] + acc[2 * p + 1][j] * acc[2 * p + 1][j]; } }
            ss += __shfl_xor(ss, 16); ss += __shfl_xor(ss, 32);
            const float rstd = rsqrtf(ss * (1.f / 128.f) + EPS);
#pragma unroll
            for (int p = 0; p < 4; ++p) { const int dv = p * 32 + kg * 8; float f[8], o[8]; unpack8(og[p], f);
#pragma unroll
                for (int j = 0; j < 4; ++j) { o[j] = acc[2 * p][j] * rstd * glag[p][0][j] * f[j]; o[4 + j] = acc[2 * p + 1][j] * rstd * glag[p][1][j] * f[4 + j]; }
                *(u32x4*)(MIX + (size_t)row * D + h * 128 + dv) = pack8(o); }
        }
#undef G3_ROW
#undef G3_LOAD
    }
    {
        const int cgi = t & 7, pp = t >> 3;
        int hcur = -1; bf16x8 wf[4]; float bs = 0.f; f32x4 g0 = {0.f, 0.f, 0.f, 0.f}, g1 = g0;
        u32x4 nva, nvb, ngu[2]; f32x4 npa, npb, npc, npd;
#define C1_LOAD(v_) do { const int b_ = (v_) >> 8, n_ = ((v_) >> 3) & 31, hd_ = (v_) & 7, r0_ = b_ * SEQ + n_ * 128; \
        nva = *(const u32x4*)(Z + (size_t)(r0_ + 2 * pp) * ZW + ZC_VS + hd_ * 64 + cgi * 8); nvb = *(const u32x4*)(Z + (size_t)(r0_ + 2 * pp + 1) * ZW + ZC_VS + hd_ * 64 + cgi * 8); \
        const float* rp_ = rowss + (size_t)(r0_ + 2 * pp) * 8; npa = *(const f32x4*)rp_; npb = *(const f32x4*)(rp_ + 4); npc = *(const f32x4*)(rp_ + 8); npd = *(const f32x4*)(rp_ + 12); \
        _Pragma("unroll") for (int p = 0; p < 2; ++p) ngu[p] = *(const u32x4*)(Z + (size_t)(r0_ + w * 16 + ln) * ZW + ZC_U + hd_ * 64 + p * 32 + kg * 8); } while (0)
        if ((int)blockIdx.x < NU_LAT) C1_LOAD((int)blockIdx.x);
        for (int v = blockIdx.x; v < NU_LAT; v += G) {
            const int b = v >> 8, n = (v >> 3) & 31, hd = v & 7, r0 = b * SEQ + n * 128;
            if (hd != hcur) { hcur = hd;
#pragma unroll
                for (int ks = 0; ks < 4; ++ks) wf[ks] = *(const bf16x8*)(WSB + ((size_t)hd * 128 + w * 16 + ln) * 128 + ks * 32 + kg * 8);
                bs = a.in[I_BS][hd * 128 + w * 16 + ln];
                g0 = *(const f32x4*)(a.in[I_CMG] + hd * 64 + cgi * 8); g1 = *(const f32x4*)(a.in[I_CMG] + hd * 64 + cgi * 8 + 4); }
            const u32x4 va = nva, vb = nvb; const f32x4 pa = npa, pb = npb, pc = npc, pd = npd; u32x4 gu[2]; gu[0] = ngu[0]; gu[1] = ngu[1];
            if (v + G < NU_LAT) C1_LOAD(v + G);
            {
                float f0[8], f1[8]; unpack8(va, f0); unpack8(vb, f1);
                const float rs0 = rsqrtf((((pa.x + pa.y) + (pa.z + pa.w)) + ((pb.x + pb.y) + (pb.z + pb.w))) * (1.f / 512.f) + EPS), rs1 = rsqrtf((((pc.x + pc.y) + (pc.z + pc.w)) + ((pd.x + pd.y) + (pd.z + pd.w))) * (1.f / 512.f) + EPS);
#pragma unroll
                for (int j = 0; j < 8; ++j) { const float gj = j < 4 ? g0[j] : g1[j - 4]; const int ch = cgi * 8 + j, fsw = (ch ^ (ch >> 3)) & 15;
                    sV[ch * 64 + (((pp >> 2) ^ fsw) << 2) + (pp & 3)] = cvt_pk_bf16(f0[j] * rs0 * gj, f1[j] * rs1 * gj); }
            }
            LBAR();
            {
                f32x4 acc[4];
#pragma unroll
                for (int d = 0; d < 4; ++d) acc[d] = (f32x4){0.f, 0.f, 0.f, 0.f};
#pragma unroll
                for (int ks = 0; ks < 4; ++ks) {
#pragma unroll
                    for (int d = 0; d < 4; ++d) { const int ch = (d >> 1) * 32 + prow(d & 1, ln), fsw = (ch ^ (ch >> 3)) & 15; const bf16x8 vf = *(const bf16x8*)(sV + ch * 64 + (((ks * 4 + kg) ^ fsw) << 2)); acc[d] = mfma16(vf, wf[ks], acc[d]); }
                }
#pragma unroll
                for (int p = 0; p < 2; ++p) { const int ch = hd * 64 + p * 32 + kg * 8; float f[8], o[8]; unpack8(gu[p], f);
#pragma unroll
                    for (int j = 0; j < 4; ++j) { o[j] = (acc[2 * p][j] + bs) * f[j]; o[4 + j] = (acc[2 * p + 1][j] + bs) * f[4 + j]; }
                    *(u32x4*)(MIX + (size_t)(r0 + w * 16 + ln) * D + 512 + ch) = pack8(o); }
            }
            LBAR();
        }
#undef C1_LOAD
    }
}

#define LAS __attribute__((address_space(3)))
#define XB_TMO      128
#define XB_XCNT(j)  (256  + 64 * (j))
#define XB_XSUB(j)  (1280 + 64 * (j))
#define XB_XGEN(j)  (2304 + 64 * (j))
#define XB_TOP      3328
#define XB_TOPGEN   3392
#define XCD_BAR_WORDS 3456
#define XB_SPIN_CAP (1u << 18)

__device__ __forceinline__ unsigned xb_ld(unsigned* p)              { return __hip_atomic_load(p, __ATOMIC_RELAXED, __HIP_MEMORY_SCOPE_AGENT); }
__device__ __forceinline__ unsigned xb_add(unsigned* p, unsigned v) { return __hip_atomic_fetch_add(p, v, __ATOMIC_RELAXED, __HIP_MEMORY_SCOPE_AGENT); }
__device__ __forceinline__ unsigned xb_xcc_id() { return (unsigned)__builtin_amdgcn_s_getreg((3 << 11) | 20) & 0xFu; }
#define XB_SPIN(cond, bar) do { unsigned _sp = 0; while (cond) { __builtin_amdgcn_s_sleep(1); \
    if ((++_sp & 255u) == 0u) { if (xb_ld(&(bar)[XB_TMO])) break; if (_sp > XB_SPIN_CAP) { atomicAdd(&(bar)[XB_TMO], 1u); break; } } } } while (0)

struct XcdBarrier {
    unsigned* bar; unsigned x;
    volatile LAS unsigned* st;
};

__device__ __forceinline__ XcdBarrier xcd_barrier_post(unsigned* bar, volatile LAS unsigned* st) {
    XcdBarrier b; b.bar = bar; b.x = xb_xcc_id(); b.st = st;
    if (threadIdx.x == 0) (void)xb_add(&bar[XB_XCNT(b.x)], 1u);
    return b;
}
__device__ __forceinline__ void xcd_barrier_complete(unsigned* bar, unsigned x, unsigned& nloc, unsigned& nx) {
    const unsigned G = gridDim.x * gridDim.y * gridDim.z;
    unsigned sum, cnt, mine, sp = 0u;
    for (;;) {
        sum = 0u; cnt = 0u; mine = 0u;
#pragma unroll
        for (unsigned j = 0; j < 16; ++j) { const unsigned c = xb_ld(&bar[XB_XCNT(j)]); sum += c; cnt += (c > 0u) ? 1u : 0u; mine = (j == x) ? c : mine; }
        if (sum == G) break;
        __builtin_amdgcn_s_sleep(1);
        if ((++sp & 255u) == 0u) { if (xb_ld(&bar[XB_TMO])) break; if (sp > XB_SPIN_CAP) { atomicAdd(&bar[XB_TMO], 1u); break; } }
    }
    nloc = mine > 0u ? mine : 1u; nx = cnt > 0u ? cnt : 1u;
}

__device__ __forceinline__ void xcd_barrier(const XcdBarrier& b) {
    asm volatile("s_waitcnt vmcnt(0)" ::: "memory");
    __syncthreads();
    if (threadIdx.x == 0) {
        unsigned* bar = b.bar;
        __builtin_amdgcn_s_waitcnt(0);
        unsigned nloc = b.st[0], nx = b.st[1];
        if (nloc == 0u) { xcd_barrier_complete(bar, b.x, nloc, nx); b.st[0] = nloc; b.st[1] = nx; }
        const unsigned old = xb_add(&bar[XB_XSUB(b.x)], 1u);
        const unsigned gen = old / nloc;
        if (old + 1u == (gen + 1u) * nloc) {
            __builtin_amdgcn_fence(__ATOMIC_RELEASE, "agent");
            asm volatile("s_waitcnt vmcnt(0)" ::: "memory");
            const unsigned og = xb_add(&bar[XB_TOP], 1u);
            const unsigned tg = og / nx;
            if (og + 1u == (tg + 1u) * nx) xb_add(&bar[XB_TOPGEN], 1u);
            else XB_SPIN(xb_ld(&bar[XB_TOPGEN]) == tg, bar);
            __builtin_amdgcn_fence(__ATOMIC_ACQUIRE, "agent");
            xb_add(&bar[XB_XGEN(b.x)], 1u);
            asm volatile("s_waitcnt vmcnt(0)" ::: "memory");
        } else {
            XB_SPIN(xb_ld(&bar[XB_XGEN(b.x)]) == gen, bar);
            __builtin_amdgcn_fence(__ATOMIC_ACQUIRE, "agent");
            asm volatile("s_waitcnt vmcnt(0)" ::: "memory");
        }
    }
    __syncthreads();
}


constexpr int NPHASE = 15;
__global__ void __launch_bounds__(512, 2) fwd_kernel(Args a) {
    extern __shared__ __attribute__((aligned(16))) unsigned char lds[];
    const int G = gridDim.x, tid = threadIdx.x, lane = tid & 63, wave = __builtin_amdgcn_readfirstlane(tid >> 6);
    const int gw = blockIdx.x * 8 + wave, NGW = G * 8;
    unsigned char* ws = a.ws;
    const float* mod = (const float*)(ws + WS_MOD);
    bf16_t* XN = (bf16_t*)(ws + WS_XN); bf16_t* ZH = (bf16_t*)(ws + WS_ZH); float* X1C = (float*)(ws + WS_X1C);
    PG8_LAS unsigned char* ldsg = (PG8_LAS unsigned char*)lds;
    const int lo = a.ph_lo, hi = a.ph_hi;
    volatile LAS unsigned* bst = (volatile LAS unsigned*)(ldsg + (LDS_BYTES - 64));
    if (tid == 0) { bst[0] = 0u; bst[1] = 0u; }
    __syncthreads();
    XcdBarrier xbar; xbar.bar = (unsigned*)(ws + WS_CTL); xbar.x = 0; xbar.st = bst;
    if (hi - lo > 1) xbar = xcd_barrier_post((unsigned*)(ws + WS_CTL), bst);
#define IN(k) (lo <= (k) && (k) < hi)
#define SEAM(k) do { if (IN(k) && IN((k) + 1)) { if (a.ph_hi > 4096) cg::this_grid().sync(); else xcd_barrier(xbar); } } while (0)
    if (IN(0)) { p0_prep(a, lds, gw, NGW, wave, lane); } SEAM(0);
    if (IN(1)) { norm_mod_phase(a.in[I_X], a.in[I_CTX], MALL, a.in[I_N1G], mod, 0, 1, XN, gw, NGW, lane);
        shiftw_phase((const bf16_t*)(ws + WS_WIN), ZW, mod, 3, (float*)(ws + WS_SHW1), gw, NGW, lane, true); shiftw_phase((const bf16_t*)(ws + WS_W2A), NFF2, mod, 6, (float*)(ws + WS_SHW2), NGW - 1 - gw, NGW, lane, false); } SEAM(1);
    if (IN(2)) { pg8::Gemm g{XN, (const bf16_t*)(ws + WS_W1A), MALL, NFF2, D}; pg8::StaticOrder S; S.init(MALL, NFF2, G, (int)blockIdx.x); EpiSwiGLU<false> E{ZH, nullptr, nullptr};
        pg8::gemm_phase<EpiSwiGLU<false>, pg8::StaticOrder, true, true>(ldsg, g, S, E); } SEAM(2);
    if (IN(3)) { pg8::Gemm g{ZH, (const bf16_t*)(ws + WS_W1B), MALL, D, DFF}; pg8::StaticOrder S; S.init(MALL, D, G, (int)blockIdx.x); typedef EpiResid<2, true, true, 4> EpiT; EpiT E{a.in[I_X], a.in[I_CTX], a.out, X1C, mod, XN, a.in[I_N2G], (float*)(ws + WS_RS2)};
        pg8::gemm_phase<EpiT, pg8::StaticOrder, true, true>(ldsg, g, S, E); } SEAM(3);
    if (IN(5)) { pg8::Gemm g{XN, (const bf16_t*)(ws + WS_WIN), MALL, ZW, D}; pg8::StaticOrder S; S.init(MALL, ZW, G, (int)blockIdx.x); EpiZ E{ZH, (float*)(ws + WS_RSP), (const float*)(ws + WS_RS2), (const float*)(ws + WS_SHW1)};
        pg8::gemm_phase<EpiZ, pg8::StaticOrder, true, true>(ldsg, g, S, E); } SEAM(5);
    if (IN(6)) { conv_phase(ZH, a.in[I_CONVW], XN, G); } SEAM(6);
    if (IN(7)) { g1_phase(a, lds, G); } SEAM(7);
    if (IN(8)) { g2_phase(a, G); } SEAM(8);
    if (IN(9)) { g3c1_phase(a, lds, G); } SEAM(9);
    if (IN(10)) { pg8::Gemm g{(const bf16_t*)(ws + WS_KV), (const bf16_t*)(ws + WS_WOUT), MLAT, D, D}; pg8::StaticOrder S; S.init(MLAT, D, G, (int)blockIdx.x); typedef EpiResid<5, false, true, 7> EpiT; EpiT E{a.out, a.out, a.out, a.out, mod, XN, a.in[I_N3G], (float*)(ws + WS_RS3)};
        pg8::gemm_phase<EpiT, pg8::StaticOrder, true, true>(ldsg, g, S, E); } SEAM(10);
    if (IN(12)) { pg8::Gemm g{XN, (const bf16_t*)(ws + WS_W2A), MLAT, NFF2, D}; pg8::StaticOrder S; S.init(MLAT, NFF2, G, (int)blockIdx.x); EpiSwiGLU<true> E{ZH, (const float*)(ws + WS_RS3), (const float*)(ws + WS_SHW2)};
        pg8::gemm_phase<EpiSwiGLU<true>, pg8::StaticOrder, true, true>(ldsg, g, S, E); } SEAM(12);
    if (IN(13)) { pg8::Gemm g{ZH, (const bf16_t*)(ws + WS_W2B), MLAT, D, DFF}; pg8::StaticOrder S; S.init(MLAT, D, G, (int)blockIdx.x); typedef EpiResid<8, true, false, 0> EpiT; EpiT E{a.out, a.out, a.out, a.out, mod, nullptr, nullptr, nullptr};
        pg8::gemm_phase<EpiT, pg8::StaticOrder, true, true>(ldsg, g, S, E); } SEAM(13);
    if (IN(14)) { final_norm_phase(a.out, a.in[I_FING], gw, NGW, lane); }
#if defined(MK_EXTRA_SYNC) && MK_EXTRA_SYNC
    if (hi - lo > 1) for (int i = 0; i < MK_EXTRA_SYNC; ++i) cg::this_grid().sync();
#endif
#undef IN
#undef SEAM
}


extern "C" void kernel_launch(void* const* d_in, const int* in_sizes, int n_in, void* d_out, int out_size, void* d_ws, size_t ws_size, hipStream_t stream) {
    static int grid = 0;
    if (grid == 0) {
        if (n_in != 25 || out_size != MLAT * D || ws_size < WS_END) { fprintf(stderr, "kernel_launch: unexpected shapes (n_in %d, out %d, ws %zu; need ws >= %zu)\n", n_in, out_size, ws_size, (size_t)WS_END); grid = -1; return; }
        int dev = 0, cus = 0, per_cu = 0;
        (void)hipGetDevice(&dev); (void)hipDeviceGetAttribute(&cus, hipDeviceAttributeMultiprocessorCount, dev);
        if (hipFuncSetAttribute((const void*)fwd_kernel, hipFuncAttributeMaxDynamicSharedMemorySize, LDS_BYTES) != hipSuccess) { fprintf(stderr, "kernel_launch: hipFuncSetAttribute failed\n"); grid = -1; return; }
        if (hipOccupancyMaxActiveBlocksPerMultiprocessor(&per_cu, (const void*)fwd_kernel, 512, LDS_BYTES) != hipSuccess || per_cu < 1) { fprintf(stderr, "kernel_launch: occupancy query says %d\n", per_cu); per_cu = 1; }
        (void)hipGetLastError();
        grid = cus * per_cu;
    }
    if (grid < 0) return;
    (void)hipMemsetAsync((char*)d_ws + WS_CTL, 0, 1 << 20, stream);
    Args a{};
    for (int i = 0; i < 25; ++i) a.in[i] = (const float*)d_in[i];
    a.out = (float*)d_out; a.ws = (unsigned char*)d_ws;
#if MK_ONE_LAUNCH
    a.ph_lo = 0; a.ph_hi = NPHASE;
    void* args[] = {&a};
    hipError_t e = hipLaunchCooperativeKernel((const void*)fwd_kernel, dim3(grid), dim3(512), args, LDS_BYTES, stream);
    if (e != hipSuccess) fprintf(stderr, "cooperative launch failed: %s (grid %d)\n", hipGetErrorString(e), grid);
#if defined(MK_DUP) && MK_DUP
    for (int p = 0; p < NPHASE; ++p) if ((MK_DUP >> p) & 1) { a.ph_lo = p; a.ph_hi = p + 1; hipLaunchKernelGGL(fwd_kernel, dim3(grid), dim3(512), LDS_BYTES, stream, a); }
#endif
#else
    for (int p = 0; p < NPHASE; ++p) { a.ph_lo = p; a.ph_hi = p + 1; hipLaunchKernelGGL(fwd_kernel, dim3(grid), dim3(512), LDS_BYTES, stream, a); }
#endif
}
```

```cpp
#include <hip/hip_runtime.h>
#include <hip/hip_cooperative_groups.h>
#include <cstdio>
#include <cstdint>
namespace cg = cooperative_groups;
#ifndef MK_ONE_LAUNCH
#define MK_ONE_LAUNCH 1
#endif
#ifndef MK_DUP
#define MK_DUP 0
#endif
#ifndef MK_EXTRA_SYNC
#define MK_EXTRA_SYNC 0
#endif
namespace pg8 {
#define PG8_LAS __attribute__((address_space(3)))
typedef unsigned short bf16_t;
typedef short bf16x8 __attribute__((ext_vector_type(8)));
typedef float f32x4 __attribute__((ext_vector_type(4)));
typedef unsigned u32x4 __attribute__((ext_vector_type(4)));
constexpr int BM = 256, BK = 64, HALF = 128, HTB = HALF * BK * 2  , STAGE_BYTES = 8 * HTB, NXCD = 8, WGM = 8;

__host__ __device__ __forceinline__ int lds_byte(int r, int c) { const int st = (r >> 4) * 2 + (c >> 5), rr = r & 15, cc = c & 31, ob = rr * 64 + cc * 2; return st * 1024 + (ob ^ (((ob >> 9) & 1) << 5)); }
__host__ __device__ __forceinline__ void stage_rc(int b, int& R, int& C) { const int st = b / 1024, sb = b % 1024, swz = sb ^ (((sb >> 9) & 1) << 5); R = (st >> 1) * 16 + swz / 64; C = (st & 1) * 32 + (swz % 64) / 2; }
__host__ __device__ __forceinline__ int perm32(int rho) { const int n = rho >> 4, i = rho & 15; return 8 * (i >> 2) + 4 * n + (i & 3); }

struct Unit { int pm, pn; };
struct Gemm { const bf16_t* A; const bf16_t* Bt; int M, N, K; };

struct StaticOrder {
    int nM, nN, nwg, G, c;
    __host__ __device__ void init(int M, int N, int G_, int c_) { nM = M / BM; nN = N / BM; nwg = nM * nN; G = G_; c = c_; }
    __host__ __device__ bool next(int i, Unit& u) const {
        const long L = (long)i * G + c; if (L >= nwg) return false;
        int wgid = (int)L; { const int q = nwg / NXCD, r = nwg % NXCD, xcd = wgid % NXCD, off = wgid / NXCD; wgid = (xcd < r ? xcd * (q + 1) : r * (q + 1) + (xcd - r) * q) + off; }
        const int nig = WGM * nN, gid = wgid / nig, fm = gid * WGM, gsz = (nM - fm) < WGM ? (nM - fm) : WGM;
        u.pm = fm + ((wgid % nig) % gsz); u.pn = (wgid % nig) / gsz; return true;
    }
    __device__ __forceinline__ void a_ready(const Unit&) const {}
    __device__ __forceinline__ void done(const Unit&) const {}
};

typedef float f32x2_t __attribute__((ext_vector_type(2))); typedef __bf16 bf16x2_t __attribute__((ext_vector_type(2)));
__device__ __forceinline__ unsigned cvt_pk_bf16(float lo, float hi) { f32x2_t v = {lo, hi}; bf16x2_t b = __builtin_convertvector(v, bf16x2_t); return __builtin_bit_cast(unsigned, b); }
template <class Epi, class Sched, bool ALIGN_EPI = false, bool SP2 = false>
__device__ __forceinline__ void gemm_phase(PG8_LAS unsigned char* lds, const Gemm g, const Sched& S, const Epi& E) {
    const int tid = threadIdx.x, wid = __builtin_amdgcn_readfirstlane(tid >> 6), lane = tid & 63, wr = wid >> 2, wc = wid & 3, fr = lane & 15, fq = lane >> 4;
    const int K = g.K, nt = K / BK;
    unsigned voffA[2], voffB[2];
#pragma unroll
    for (int i = 0; i < 2; ++i) { int R, C; stage_rc(tid * 16 + i * 8192, R, C); const int Rb = Epi::PERM ? ((R & ~31) + perm32(R & 31)) : R;
        voffA[i] = (unsigned)(R * K + C) * 2u; voffB[i] = (unsigned)(Rb * K + C) * 2u; }
    const size_t kstep = (size_t)(BK * 2);
    const size_t hstep = (size_t)HALF * K * 2;
    const size_t tstep = 2 * hstep;
    const unsigned ldsw = (unsigned)wid * 1024u;
    const int aoff = lds_byte(wr * 64 + fr, fq * 8), boff = lds_byte(wc * 32 + fr, fq * 8);
#define PG8_SA(b, h) (((b) * 2 + (h)) * HTB)
#define PG8_SB(b, h) ((4 + (b) * 2 + (h)) * HTB)
#define PG8_STAGE(bufoff, gbase, voff) do { _Pragma("unroll") for (int _i = 0; _i < 2; ++_i) \
        __builtin_amdgcn_global_load_lds((const unsigned*)((const char*)(gbase) + (voff)[_i]), (PG8_LAS unsigned*)(lds + (bufoff) + ldsw + _i * 8192), 16, 0, 0); } while (0)
#define PG8_LDA(dst, b, h) do { _Pragma("unroll") for (int m = 0; m < 4; ++m) _Pragma("unroll") for (int k = 0; k < 2; ++k) dst[m][k] = *(const PG8_LAS bf16x8*)(lds + PG8_SA(b, h) + aoff + m * 2048 + k * 1024); } while (0)
#define PG8_LDB(dst, b, h) do { _Pragma("unroll") for (int n = 0; n < 2; ++n) _Pragma("unroll") for (int k = 0; k < 2; ++k) dst[n][k] = *(const PG8_LAS bf16x8*)(lds + PG8_SB(b, h) + boff + n * 2048 + k * 1024); } while (0)
#define PG8_MMA(ai, bj, At, Bt) do { __builtin_amdgcn_s_setprio(1); _Pragma("unroll") for (int m = 0; m < 4; ++m) _Pragma("unroll") for (int n = 0; n < 2; ++n) _Pragma("unroll") for (int k = 0; k < 2; ++k) \
        acc[ai][bj][m][n] = __builtin_amdgcn_mfma_f32_16x16x32_bf16(Bt[n][k], At[m][k], acc[ai][bj][m][n], 0, 0, 0); __builtin_amdgcn_s_setprio(0); } while (0)
#define PG8_WAIT_V(n) asm volatile("s_waitcnt vmcnt(" #n ")" ::: "memory")
#define PG8_WAIT_L(n) asm volatile("s_waitcnt lgkmcnt(" #n ")" ::: "memory")
#define PG8_BAR __builtin_amdgcn_s_barrier()
#define PG8_SCHED __builtin_amdgcn_sched_barrier(0)
    Unit cur, nxt; int ui = 0;
    if (!S.next(0, cur)) return;
    f32x4 acc[2][2][4][2];
#pragma unroll
    for (int a = 0; a < 2; ++a)
#pragma unroll
        for (int b = 0; b < 2; ++b)
#pragma unroll
            for (int m = 0; m < 4; ++m)
#pragma unroll
                for (int n = 0; n < 2; ++n) acc[a][b][m][n] = (f32x4){0.f, 0.f, 0.f, 0.f};
    bf16x8 At[4][2], B0[2][2], B1[2][2];
    const char* cA = (const char*)g.A + (size_t)cur.pm * tstep; const char* cB = (const char*)g.Bt + (size_t)cur.pn * tstep;
    S.a_ready(cur);
    if constexpr (SP2) {
        PG8_STAGE(PG8_SB(0, 0), cB, voffB); PG8_STAGE(PG8_SB(0, 1), cB + hstep, voffB); PG8_STAGE(PG8_SA(0, 0), cA, voffA); PG8_STAGE(PG8_SA(0, 1), cA + hstep, voffA);
        if (wr == 1) PG8_BAR;
        PG8_WAIT_V(2); PG8_BAR;
        PG8_STAGE(PG8_SB(1, 0), cB + kstep, voffB); PG8_STAGE(PG8_SA(1, 0), cA + kstep, voffA); PG8_STAGE(PG8_SB(1, 1), cB + hstep + kstep, voffB);
        PG8_WAIT_V(6); PG8_BAR;
    } else {
        PG8_STAGE(PG8_SB(0, 0), cB, voffB); PG8_STAGE(PG8_SA(0, 0), cA, voffA); PG8_STAGE(PG8_SB(0, 1), cB + hstep, voffB); PG8_STAGE(PG8_SA(0, 1), cA + hstep, voffA);
        if (wr == 1) PG8_BAR;
        PG8_WAIT_V(4); PG8_BAR;
        PG8_STAGE(PG8_SB(1, 0), cB + kstep, voffB); PG8_STAGE(PG8_SA(1, 0), cA + kstep, voffA); PG8_STAGE(PG8_SB(1, 1), cB + hstep + kstep, voffB);
        PG8_WAIT_V(6); PG8_BAR;
    }
    for (;;) {
        const bool has_next = S.next(ui + 1, nxt);
        const char* nA = has_next ? (const char*)g.A + (size_t)nxt.pm * tstep : cA; const char* nB = has_next ? (const char*)g.Bt + (size_t)nxt.pn * tstep : cB;
        for (int t = 0; t < nt; t += 2) {
            const bool last = (t == nt - 2);
            const char* a1 = cA + (size_t)(t + 1) * kstep;
            const char* a2 = last ? nA : cA + (size_t)(t + 2) * kstep; const char* b2 = last ? nB : cB + (size_t)(t + 2) * kstep;
            const char* a3 = a2 + kstep; const char* b3 = b2 + kstep;
            if (last && has_next) S.a_ready(nxt);
            if constexpr (SP2) {
            PG8_LDB(B0, 0, 0); PG8_LDB(B1, 0, 1); PG8_SCHED; PG8_LDA(At, 0, 0); PG8_STAGE(PG8_SA(1, 1), a1 + hstep, voffA);
            PG8_WAIT_V(8); PG8_WAIT_L(0); PG8_BAR; PG8_MMA(0, 0, At, B0); PG8_MMA(0, 1, At, B1); PG8_BAR; PG8_SCHED;
            PG8_LDA(At, 0, 1); PG8_STAGE(PG8_SB(0, 0), b2, voffB); PG8_STAGE(PG8_SB(0, 1), b2 + hstep, voffB); PG8_STAGE(PG8_SA(0, 0), a2, voffA);
            PG8_WAIT_V(8); PG8_WAIT_L(0); PG8_BAR; PG8_MMA(1, 0, At, B0); PG8_MMA(1, 1, At, B1); PG8_BAR; PG8_SCHED;
            PG8_LDB(B0, 1, 0); PG8_LDB(B1, 1, 1); PG8_SCHED; PG8_LDA(At, 1, 0); PG8_STAGE(PG8_SA(0, 1), a2 + hstep, voffA);
            PG8_WAIT_V(8); PG8_WAIT_L(0); PG8_BAR; PG8_MMA(0, 0, At, B0); PG8_MMA(0, 1, At, B1); PG8_BAR; PG8_SCHED;
            PG8_LDA(At, 1, 1); PG8_STAGE(PG8_SB(1, 0), b3, voffB); PG8_STAGE(PG8_SB(1, 1), b3 + hstep, voffB); PG8_STAGE(PG8_SA(1, 0), a3, voffA);
            PG8_WAIT_V(8); PG8_WAIT_L(0); PG8_BAR; PG8_MMA(1, 0, At, B0); PG8_MMA(1, 1, At, B1); PG8_BAR; PG8_SCHED;
            } else {
            PG8_LDB(B0, 0, 0); PG8_SCHED; PG8_LDA(At, 0, 0); PG8_STAGE(PG8_SA(1, 1), a1 + hstep, voffA);
            PG8_WAIT_L(8); PG8_BAR; PG8_WAIT_L(0); PG8_MMA(0, 0, At, B0); PG8_BAR; PG8_SCHED;
            PG8_LDB(B1, 0, 1); PG8_STAGE(PG8_SB(0, 0), b2, voffB);
            PG8_BAR; PG8_WAIT_L(0); PG8_MMA(0, 1, At, B1); PG8_BAR;
            PG8_LDA(At, 0, 1); PG8_STAGE(PG8_SA(0, 0), a2, voffA);
            PG8_BAR; PG8_WAIT_L(0); PG8_MMA(1, 0, At, B0); PG8_BAR; PG8_SCHED;
            PG8_STAGE(PG8_SB(0, 1), b2 + hstep, voffB);
            PG8_WAIT_V(6); PG8_BAR; PG8_MMA(1, 1, At, B1); PG8_BAR;
            PG8_LDB(B0, 1, 0); PG8_SCHED; PG8_LDA(At, 1, 0); PG8_STAGE(PG8_SA(0, 1), a2 + hstep, voffA);
            PG8_WAIT_L(8); PG8_BAR; PG8_WAIT_L(0); PG8_MMA(0, 0, At, B0); PG8_BAR; PG8_SCHED;
            PG8_LDB(B1, 1, 1); PG8_STAGE(PG8_SB(1, 0), b3, voffB);
            PG8_BAR; PG8_WAIT_L(0); PG8_MMA(0, 1, At, B1); PG8_BAR;
            PG8_LDA(At, 1, 1); PG8_STAGE(PG8_SA(1, 0), a3, voffA);
            PG8_BAR; PG8_WAIT_L(0); PG8_MMA(1, 0, At, B0); PG8_BAR; PG8_SCHED;
            PG8_STAGE(PG8_SB(1, 1), b3 + hstep, voffB);
            PG8_WAIT_V(6); PG8_BAR; PG8_MMA(1, 1, At, B1); PG8_BAR;
            }
        }
        if constexpr (ALIGN_EPI) { if (wr == 0) PG8_BAR; }
        if constexpr (!Epi::AFTER_DRAIN) { E(acc, cur, wr, wc, fr, fq); S.done(cur); }
        if (!has_next) break;
#pragma unroll
        for (int a = 0; a < 2; ++a)
#pragma unroll
            for (int b = 0; b < 2; ++b)
#pragma unroll
                for (int m = 0; m < 4; ++m)
#pragma unroll
                    for (int n = 0; n < 2; ++n) acc[a][b][m][n] = (f32x4){0.f, 0.f, 0.f, 0.f};
        cur = nxt; cA = nA; cB = nB; ++ui;
        if constexpr (ALIGN_EPI) { if (wr == 1) PG8_BAR; }
    }
    PG8_WAIT_V(0);
    if constexpr (!ALIGN_EPI) { if (wr == 0) PG8_BAR; }
    PG8_BAR;
    if constexpr (Epi::AFTER_DRAIN) { E.fused(acc, cur, wr, wc, fr, fq, lds, wid, lane); S.done(cur); }
#undef PG8_SA
#undef PG8_SB
#undef PG8_STAGE
#undef PG8_LDA
#undef PG8_LDB
#undef PG8_MMA
#undef PG8_WAIT_V
#undef PG8_WAIT_L
#undef PG8_BAR
#undef PG8_SCHED
}
}
using pg8::bf16_t; using pg8::bf16x8; using pg8::f32x4; using pg8::u32x4; using pg8::Unit; using pg8::cvt_pk_bf16;
typedef unsigned u32x2 __attribute__((ext_vector_type(2)));
#define DEV __device__ __forceinline__
constexpr int D = 1024, NB = 16, SEQ = 4096, MLAT = NB * SEQ, CTXL = 256, MCTX = NB * CTXL, MALL = MLAT + MCTX;
constexpr int DFF = 2816, NFF2 = 2 * DFF, ZW = 2816, NMOD = 9 * D;
constexpr int NU_LAT = NB * 64 * 4, NU_CTX = NB * 4 * 4, NU_ALL = NU_LAT + NU_CTX;
constexpr float EPS = 1e-6f;
constexpr int ZC_OG = 1024, ZC_U = 1536, ZC_VS = 2048, ZC_GLR = 2560;
constexpr size_t MiB = 1u << 20;
constexpr size_t WS_CTL = 0, WS_MOD = 64 * 1024;
static_assert(WS_MOD + 17 * 9216 * 4 <= (1u << 20), "MOD inside the zeroed region");
constexpr size_t WS_W1A = 2 * MiB, WS_W1B = 13 * MiB, WS_WIN = 19 * MiB, WS_WOUT = 25 * MiB, WS_W2A = 27 * MiB, WS_W2B = 38 * MiB, WS_WS = 44 * MiB;
constexpr size_t WS_DEC = 45 * MiB, WS_X1C = 48 * MiB, WS_XN = 64 * MiB, WS_ZH = 200 * MiB, WS_QT = 574 * MiB, WS_OI = 638 * MiB, WS_KV = 702 * MiB, WS_SB = 838 * MiB, WS_RSP = 966 * MiB, WS_RS2 = 969 * MiB, WS_RS3 = 974 * MiB, WS_SHW1 = 978 * MiB, WS_SHW2 = 979 * MiB, WS_END = 980 * MiB;
static_assert(WS_MOD + 17 * NMOD * 4 <= 2 * MiB && WS_RSP + (size_t)MALL * 8 * 4 <= WS_RS2 && WS_RS2 + (size_t)MALL * 16 * 4 <= WS_RS3 && WS_RS3 + (size_t)MLAT * 16 * 4 <= WS_SHW1 && WS_SHW1 + 17 * ZW * 4 <= WS_SHW2 && WS_SHW2 + 17 * NFF2 * 4 <= WS_END, "mod / row-stat / shift regions");
static_assert(WS_W1A + (size_t)NFF2 * D * 2 <= WS_W1B && WS_W1B + (size_t)D * DFF * 2 <= WS_WIN && WS_WIN + (size_t)ZW * D * 2 <= WS_WOUT && WS_WOUT + (size_t)D * D * 2 <= WS_W2A, "w map");
static_assert(WS_W2A + (size_t)NFF2 * D * 2 <= WS_W2B && WS_W2B + (size_t)D * DFF * 2 <= WS_WS && WS_WS + 8 * 128 * 128 * 2 <= WS_DEC && WS_DEC + (size_t)NU_ALL * 128 * 4 <= WS_X1C, "w map 2");
static_assert(WS_X1C + (size_t)MCTX * D * 4 <= WS_XN && WS_XN + (size_t)MALL * D * 2 <= WS_ZH && WS_ZH + (size_t)MALL * ZW * 2 <= WS_QT && WS_QT + (size_t)MLAT * 512 * 2 <= WS_OI, "act map");
static_assert(WS_OI + (size_t)MLAT * 512 * 2 <= WS_KV && WS_KV + (size_t)NU_ALL * 2 * 128 * 64 * 2 <= WS_SB && WS_SB + (size_t)NU_LAT * 2 * 128 * 64 * 2 <= WS_RSP, "act map 2");
static_assert(WS_KV + (size_t)MLAT * D * 2 <= WS_SB, "MIX overlays KV");
constexpr int LDS_BYTES = 147456;

DEV float bf_lo(unsigned w) { return __uint_as_float(w << 16); }
DEV float bf_hi(unsigned w) { return __uint_as_float(w & 0xffff0000u); }
DEV float silu_f(float x) { return x * __builtin_amdgcn_rcpf(1.f + __expf(-x)); }
DEV float gelu_f(float x) { const float t = 1.5957691216f * (x + 0.044715f * x * x * x); return x * __builtin_amdgcn_rcpf(1.f + __expf(-t)); }
DEV float wave_sum(float v) {
#pragma unroll
    for (int o = 1; o < 64; o <<= 1) v += __shfl_xor(v, o);
    return v;
}
#define LDS_WAIT() asm volatile("s_waitcnt lgkmcnt(0)" ::: "memory")
#define LBAR() do { asm volatile("s_waitcnt lgkmcnt(0)" ::: "memory"); __builtin_amdgcn_s_barrier(); asm volatile("" ::: "memory"); } while (0)
DEV void unpack8(const u32x4 w, float (&f)[8]) { f[0] = bf_lo(w.x); f[1] = bf_hi(w.x); f[2] = bf_lo(w.y); f[3] = bf_hi(w.y); f[4] = bf_lo(w.z); f[5] = bf_hi(w.z); f[6] = bf_lo(w.w); f[7] = bf_hi(w.w); }
DEV u32x4 pack8(const float (&f)[8]) { u32x4 w; w.x = cvt_pk_bf16(f[0], f[1]); w.y = cvt_pk_bf16(f[2], f[3]); w.z = cvt_pk_bf16(f[4], f[5]); w.w = cvt_pk_bf16(f[6], f[7]); return w; }
DEV f32x4 mfma16(bf16x8 a, bf16x8 b, f32x4 c) { return __builtin_amdgcn_mfma_f32_16x16x32_bf16(a, b, c, 0, 0, 0); }

DEV int prow(int n, int ln) { return 8 * (ln >> 2) + 4 * n + (ln & 3); }
DEV u32x4 pack8v(const f32x4 a, const f32x4 b) { u32x4 w; w.x = cvt_pk_bf16(a[0], a[1]); w.y = cvt_pk_bf16(a[2], a[3]); w.z = cvt_pk_bf16(b[0], b[1]); w.w = cvt_pk_bf16(b[2], b[3]); return w; }
DEV float row_rstd(const float* rs, int row, int fq) {
    const f32x4 p = *(const f32x4*)(rs + (size_t)row * 16 + fq * 4); float s = (p.x + p.y) + (p.z + p.w);
    s += __shfl_xor(s, 16); s += __shfl_xor(s, 32); return rsqrtf(s * (1.f / D) + EPS);
}
DEV void row_rstd8(const float* rs, int row0, int fq, float (&rstd)[8]) {
    f32x4 p[8];
#pragma unroll
    for (int i = 0; i < 8; ++i) p[i] = *(const f32x4*)(rs + (size_t)(row0 + (i >> 2) * 128 + (i & 3) * 16) * 16 + fq * 4);
#pragma unroll
    for (int i = 0; i < 8; ++i) { float s = (p[i].x + p[i].y) + (p[i].z + p[i].w); s += __shfl_xor(s, 16); s += __shfl_xor(s, 32); rstd[i] = rsqrtf(s * (1.f / D) + EPS); }
}
template <bool FUSED> struct EpiSwiGLU {
    static constexpr bool PERM = true, AFTER_DRAIN = false;
    bf16_t* H; const float* rs; const float* shw;
    DEV void operator()(const f32x4 (&acc)[2][2][4][2], const Unit& u, int wr, int wc, int fr, int fq) const {
        asm volatile("" : "+v"(fr), "+v"(fq));
        const int row0 = u.pm * 256 + wr * 64 + fr, col0 = u.pn * 128 + wc * 32 + 8 * fq;
        f32x4 sg[2], su[2];
        if (FUSED) { const int b = u.pm >> 4; const float* sp = shw + (size_t)b * NFF2 + u.pn * 256 + wc * 32 + 8 * fq;
            sg[0] = *(const f32x4*)sp; sg[1] = *(const f32x4*)(sp + 4); su[0] = *(const f32x4*)(sp + 128); su[1] = *(const f32x4*)(sp + 132); }
        float rstd8[8];
        if (FUSED) row_rstd8(rs, row0, fq, rstd8);
#pragma unroll
        for (int ai = 0; ai < 2; ++ai)
#pragma unroll
            for (int m = 0; m < 4; ++m) {
                const int row = row0 + ai * 128 + m * 16;
                const float rstd = FUSED ? rstd8[ai * 4 + m] : 1.f;
                float h[8];
#pragma unroll
                for (int n = 0; n < 2; ++n)
#pragma unroll
                    for (int j = 0; j < 4; ++j) { float g = acc[ai][0][m][n][j], up = acc[ai][1][m][n][j]; if (FUSED) { g = g * rstd + sg[n][j]; up = up * rstd + su[n][j]; } h[4 * n + j] = silu_f(g) * up; }
                *(u32x4*)(H + (size_t)row * DFF + col0) = pack8(h);
            }
    }
};
template <int GATE_I, bool HALF, bool WITH_XN, int SCALE_I> struct EpiResid {
    static constexpr bool PERM = WITH_XN, AFTER_DRAIN = false; static constexpr int NS = PERM ? 4 : 16;
    const float* res_lat; const float* res_ctx; float* out_lat; float* out_ctx; const float* mod;
    bf16_t* xn; const float* g; float* rs;
    static constexpr int gate_i = GATE_I, scale_i = SCALE_I; static constexpr float coef = HALF ? 0.5f : 1.0f; static constexpr bool has_xn = WITH_XN;
    DEV void operator()(const f32x4 (&acc)[2][2][4][2], const Unit& u, int wr, int wc, int fr, int fq) const {
        asm volatile("" : "+v"(fr), "+v"(fq));
        const bool lat = u.pm < MLAT / 256; const int b = lat ? (u.pm >> 4) : 16;
        const float* res = lat ? res_lat : res_ctx; float* out = lat ? out_lat : out_ctx;
        const int grow0 = u.pm * 256 + wr * 64 + fr, row0 = (lat ? grow0 : grow0 - MLAT), col0 = u.pn * 256 + wc * 32 + (PERM ? 8 : 4) * fq;
        float ss[8];
#pragma unroll
        for (int i = 0; i < 8; ++i) ss[i] = 0.f;
#pragma unroll
        for (int bj = 0; bj < 2; ++bj) {
            f32x4 gv[2], gs[2];
#pragma unroll
            for (int n = 0; n < 2; ++n) { gv[n] = *(const f32x4*)(mod + (size_t)b * NMOD + gate_i * D + col0 + bj * 128 + NS * n) * coef;
                if (has_xn) gs[n] = *(const f32x4*)(g + col0 + bj * 128 + 4 * n) * (*(const f32x4*)(mod + (size_t)b * NMOD + scale_i * D + col0 + bj * 128 + 4 * n) + 1.f); }
#pragma unroll
            for (int ai = 0; ai < 2; ++ai)
#pragma unroll
                for (int m = 0; m < 4; ++m) {
                    const size_t p = (size_t)(row0 + ai * 128 + m * 16) * D + col0 + bj * 128;
                    const f32x4 r0 = *(const f32x4*)(res + p), r1 = *(const f32x4*)(res + p + NS);
                    const f32x4 o0 = r0 + gv[0] * acc[ai][bj][m][0], o1 = r1 + gv[1] * acc[ai][bj][m][1];
                    *(f32x4*)(out + p) = o0; *(f32x4*)(out + p + NS) = o1;
                    if (has_xn) { ss[ai * 4 + m] += (o0[0] * o0[0] + o0[1] * o0[1]) + (o0[2] * o0[2] + o0[3] * o0[3]) + (o1[0] * o1[0] + o1[1] * o1[1]) + (o1[2] * o1[2] + o1[3] * o1[3]);
                        *(u32x4*)(xn + (size_t)(grow0 + ai * 128 + m * 16) * D + col0 + bj * 128) = pack8v(o0 * gs[0], o1 * gs[1]); }
                }
        }
        if (has_xn) {
#pragma unroll
            for (int i = 0; i < 8; ++i) { float v = ss[i]; v += __shfl_xor(v, 16); v += __shfl_xor(v, 32); if (fq == 0) rs[(size_t)(grow0 + (i >> 2) * 128 + (i & 3) * 16) * 16 + u.pn * 4 + wc] = v; }
        }
    }
};
struct EpiZ {
    static constexpr bool PERM = true, AFTER_DRAIN = false;
    bf16_t* Z; float* rowss; const float* rs; const float* shw;
    DEV void operator()(const f32x4 (&acc)[2][2][4][2], const Unit& u, int wr, int wc, int fr, int fq) const {
        asm volatile("" : "+v"(fr), "+v"(fq));
        const int pn = u.pn; const int act = (pn < 4 || pn >= 10) ? 0 : (pn < 6 ? 1 : 2); const bool stat = (pn == 8 || pn == 9);
        const int row0 = u.pm * 256 + wr * 64 + fr, col0 = pn * 256 + wc * 32 + 8 * fq; const int b = u.pm < MLAT / 256 ? (u.pm >> 4) : 16;
        f32x4 sw[2][2];
#pragma unroll
        for (int bj = 0; bj < 2; ++bj)
#pragma unroll
            for (int n = 0; n < 2; ++n) sw[bj][n] = *(const f32x4*)(shw + (size_t)b * ZW + col0 + bj * 128 + 4 * n);
        float rstd8[8]; row_rstd8(rs, row0, fq, rstd8);
#pragma unroll
        for (int ai = 0; ai < 2; ++ai)
#pragma unroll
            for (int m = 0; m < 4; ++m) {
                const int row = row0 + ai * 128 + m * 16; float ss = 0.f; const float rstd = rstd8[ai * 4 + m];
#pragma unroll
                for (int bj = 0; bj < 2; ++bj) {
                    float v[8];
#pragma unroll
                    for (int n = 0; n < 2; ++n)
#pragma unroll
                        for (int j = 0; j < 4; ++j) { float x = acc[ai][bj][m][n][j] * rstd + sw[bj][n][j]; if (act == 1) x = silu_f(x); else if (act == 2) x = gelu_f(x); v[4 * n + j] = x; ss += x * x; }
                    *(u32x4*)(Z + (size_t)row * ZW + col0 + bj * 128) = pack8(v);
                }
                if (stat) { ss += __shfl_xor(ss, 16); ss += __shfl_xor(ss, 32); if (fq == 0) rowss[(size_t)row * 8 + (pn - 8) * 4 + wc] = ss; }
            }
    }
};

struct Args { const float* in[25]; float* out; unsigned char* ws; int ph_lo, ph_hi; };
enum { I_X = 0, I_C, I_CTX, I_CCTX, I_WADA, I_BADA, I_N1G, I_FF1IN, I_FF1OUT, I_N2G, I_WIN, I_CONVW, I_WGF, I_BGF, I_WGB, I_BGB, I_GLAG, I_CMG, I_WS, I_BS, I_WOUT, I_N3G, I_FF2IN, I_FF2OUT, I_FING };

DEV void transpose_item(const float* W, int K, int N, bf16_t* WT, int n0, int drow0, int k0, float* scr, int lane) {
    float tv[32];
#pragma unroll
    for (int i = 0; i < 32; ++i) tv[i] = W[(size_t)(k0 + 2 * i + (lane >> 5)) * N + n0 + (lane & 31)];
#pragma unroll
    for (int i = 0; i < 32; ++i) scr[(2 * i + (lane >> 5)) * 33 + (lane & 31)] = tv[i];
    LDS_WAIT();
    const int c = lane & 7;
#pragma unroll
    for (int j = 0; j < 4; ++j) { const int n = (lane >> 3) + 8 * j; const float* s = scr + (8 * c) * 33 + n;
        u32x4 o; o.x = cvt_pk_bf16(s[0 * 33], s[1 * 33]); o.y = cvt_pk_bf16(s[2 * 33], s[3 * 33]); o.z = cvt_pk_bf16(s[4 * 33], s[5 * 33]); o.w = cvt_pk_bf16(s[6 * 33], s[7 * 33]);
        *(u32x4*)(WT + (size_t)(drow0 + n) * K + k0 + 8 * c) = o; }
    LDS_WAIT();
}
DEV int ffin_rowmap(int n0) { const int up = n0 >= DFF, j = up ? n0 - DFF : n0; return (j >> 7) * 256 + up * 128 + (j & 127); }
DEV int win_rowmap(int n0) { return n0 < 1024 ? n0 : (n0 < 1056 ? n0 - 1024 + ZC_GLR : n0 - 1056 + ZC_OG); }
DEV void p0_prep(const Args& a, unsigned char* lds, int gw, int NGW, int wave, int lane) {
    unsigned char* ws = a.ws;
    float* scr = (float*)(lds + wave * 16384);
    constexpr int I_A = (D / 64) * (NFF2 / 32), I_B = (DFF / 64) * (D / 32), I_IN = (D / 64) * (2592 / 32), I_O = (D / 64) * (D / 32), I_ADA = (NMOD / 16) * 8;
    constexpr int NIT = 2 * I_A + 2 * I_B + I_IN + I_O + I_ADA;
    for (int r = gw; r < I_ADA; r += NGW) {
        {
            const int cgi = r % (NMOD / 16), kc = r / (NMOD / 16), n0 = cgi * 16, k0 = kc * 128, col = lane & 15, kq = lane >> 4;
            {
                float cv[34];
#pragma unroll
                for (int i = 0; i < 34; ++i) cv[i] = ((i >> 1) < 16) ? a.in[I_C][(i >> 1) * D + k0 + lane + 64 * (i & 1)] : a.in[I_CCTX][k0 + lane + 64 * (i & 1)];
#pragma unroll
                for (int i = 0; i < 34; ++i) scr[lane + 64 * i] = silu_f(cv[i]);
            }
            const float* wp = a.in[I_WADA] + (size_t)(k0 + kq * 32) * NMOD + n0 + col;
            float acc[17];
#pragma unroll
            for (int b = 0; b < 17; ++b) acc[b] = 0.f;
            LDS_WAIT();
#pragma unroll 1
            for (int kb = 0; kb < 2; ++kb) {
                float wv[16];
#pragma unroll
                for (int kk = 0; kk < 16; ++kk) wv[kk] = wp[(size_t)(kb * 16 + kk) * NMOD];
#pragma unroll
                for (int kk = 0; kk < 16; ++kk) {
#pragma unroll
                    for (int b = 0; b < 17; ++b) acc[b] += scr[b * 128 + kq * 32 + kb * 16 + kk] * wv[kk]; }
            }
            LDS_WAIT();
            float* mod = (float*)(ws + WS_MOD);
            const float bias = (kc == 0) ? a.in[I_BADA][n0 + col] : 0.f;
#pragma unroll
            for (int b = 0; b < 17; ++b) { float v = acc[b]; v += __shfl_xor(v, 16); v += __shfl_xor(v, 32); if (kq == 0) atomicAdd(mod + b * NMOD + n0 + col, v + bias); }
        }
    }
    {
        constexpr int NT = NIT - I_ADA;
        const float* nW = nullptr; bf16_t* nWT = nullptr; int nK = 0, nN = 0, nn0 = 0, nd0 = 0, nk0 = 0; float tvn[32];
#define T_DEC(r_) do { int q_ = (r_); \
        if (q_ < I_A) { nW = a.in[I_FF1IN]; nWT = (bf16_t*)(ws + WS_W1A); nK = D; nN = NFF2; nn0 = (q_ % (NFF2 / 32)) * 32; nd0 = ffin_rowmap(nn0); nk0 = (q_ / (NFF2 / 32)) * 64; } \
        else if ((q_ -= I_A) < I_A) { nW = a.in[I_FF2IN]; nWT = (bf16_t*)(ws + WS_W2A); nK = D; nN = NFF2; nn0 = (q_ % (NFF2 / 32)) * 32; nd0 = ffin_rowmap(nn0); nk0 = (q_ / (NFF2 / 32)) * 64; } \
        else if ((q_ -= I_A) < I_B) { nW = a.in[I_FF1OUT]; nWT = (bf16_t*)(ws + WS_W1B); nK = DFF; nN = D; nn0 = (q_ % (D / 32)) * 32; nd0 = nn0; nk0 = (q_ / (D / 32)) * 64; } \
        else if ((q_ -= I_B) < I_B) { nW = a.in[I_FF2OUT]; nWT = (bf16_t*)(ws + WS_W2B); nK = DFF; nN = D; nn0 = (q_ % (D / 32)) * 32; nd0 = nn0; nk0 = (q_ / (D / 32)) * 64; } \
        else if ((q_ -= I_B) < I_IN) { nW = a.in[I_WIN]; nWT = (bf16_t*)(ws + WS_WIN); nK = D; nN = 2592; nn0 = (q_ % (2592 / 32)) * 32; nd0 = win_rowmap(nn0); nk0 = (q_ / (2592 / 32)) * 64; } \
        else { q_ -= I_IN; nW = a.in[I_WOUT]; nWT = (bf16_t*)(ws + WS_WOUT); nK = D; nN = D; nn0 = (q_ % (D / 32)) * 32; nd0 = nn0; nk0 = (q_ / (D / 32)) * 64; } \
        _Pragma("unroll") for (int i = 0; i < 32; ++i) tvn[i] = nW[(size_t)(nk0 + 2 * i + (lane >> 5)) * nN + nn0 + (lane & 31)]; } while (0)
        if (gw < NT) T_DEC(gw);
        for (int r = gw; r < NT; r += NGW) {
            bf16_t* const cWT = nWT; const int cK = nK, cd0 = nd0, ck0 = nk0;
#pragma unroll
            for (int i = 0; i < 32; ++i) scr[(2 * i + (lane >> 5)) * 33 + (lane & 31)] = tvn[i];
            if (r + NGW < NT) T_DEC(r + NGW);
            LDS_WAIT();
            const int c = lane & 7;
#pragma unroll
            for (int j = 0; j < 4; ++j) { const int n = (lane >> 3) + 8 * j; const float* sp = scr + (8 * c) * 33 + n;
                u32x4 o; o.x = cvt_pk_bf16(sp[0 * 33], sp[1 * 33]); o.y = cvt_pk_bf16(sp[2 * 33], sp[3 * 33]); o.z = cvt_pk_bf16(sp[4 * 33], sp[5 * 33]); o.w = cvt_pk_bf16(sp[6 * 33], sp[7 * 33]);
                *(u32x4*)(cWT + (size_t)(cd0 + n) * cK + ck0 + 8 * c) = o; }
            LDS_WAIT();
        }
#undef T_DEC
    }
    const int gt = gw * 64 + lane, NGT = NGW * 64;
    for (int i = gt; i < 8 * 128 * 128 / 2; i += NGT) { const float2 v = ((const float2*)a.in[I_WS])[i]; ((unsigned*)(ws + WS_WS))[i] = cvt_pk_bf16(v.x, v.y); }
    for (int i = gt; i < (ZW - 2592) * D / 2; i += NGT) ((unsigned*)(ws + WS_WIN + (size_t)2592 * D * 2))[i] = 0u;
}

DEV void norm_mod_phase(const float* src_lat, const float* src_ctx, int nrows, const float* g, const float* mod, int shift_i, int scale_i, bf16_t* XN, int gw, int NGW, int lane) {
    for (int row = 2 * gw; row < nrows; row += 2 * NGW) {
        const bool lat = row < MLAT; const int b = lat ? (row >> 12) : 16;
        const f32x4* xr = (const f32x4*)(lat ? src_lat + (size_t)row * D : src_ctx + (size_t)(row - MLAT) * D) + lane;
        f32x4 v[2][4], gm[4], sh[4];
#pragma unroll
        for (int r = 0; r < 2; ++r)
#pragma unroll
            for (int j = 0; j < 4; ++j) v[r][j] = __builtin_nontemporal_load(&xr[r * 256 + 64 * j]);
        const f32x4* gp = (const f32x4*)g + lane; const f32x4* scp = (const f32x4*)(mod + (size_t)b * NMOD + scale_i * D) + lane; const f32x4* shp = (const f32x4*)(mod + (size_t)b * NMOD + shift_i * D) + lane;
#pragma unroll
        for (int j = 0; j < 4; ++j) { gm[j] = gp[64 * j] * (scp[64 * j] + 1.f); sh[j] = shp[64 * j]; }
#pragma unroll
        for (int r = 0; r < 2; ++r) {
            float s = 0.f;
#pragma unroll
            for (int j = 0; j < 4; ++j) s += (v[r][j].x * v[r][j].x + v[r][j].y * v[r][j].y) + (v[r][j].z * v[r][j].z + v[r][j].w * v[r][j].w);
            const float rstd = rsqrtf(wave_sum(s) * (1.f / D) + EPS);
            u32x2* o8 = (u32x2*)(XN + (size_t)(row + r) * D) + lane;
#pragma unroll
            for (int j = 0; j < 4; ++j) { const f32x4 y = (v[r][j] * rstd) * gm[j] + sh[j]; u32x2 w; w.x = cvt_pk_bf16(y.x, y.y); w.y = cvt_pk_bf16(y.z, y.w); o8[64 * j] = w; }
        }
    }
}
DEV void final_norm_phase(float* xo, const float* g, int gw, int NGW, int lane) {
    const f32x4* gp = (const f32x4*)g + lane;
    f32x4 gm[4];
#pragma unroll
    for (int j = 0; j < 4; ++j) gm[j] = gp[64 * j];
    for (int vr = 2 * gw; vr < MLAT; vr += 2 * NGW) {
        const int rnd = 3 - (vr >> 14), wv = vr & 16383, row = (((wv >> 11) * 32 + rnd * 8 + ((wv >> 8) & 7)) << 8) + (wv & 255);
        f32x4* xr = (f32x4*)(xo + (size_t)row * D) + lane;
        f32x4 v[2][4];
#pragma unroll
        for (int r = 0; r < 2; ++r)
#pragma unroll
            for (int j = 0; j < 4; ++j) v[r][j] = xr[r * 256 + 64 * j];
#pragma unroll
        for (int r = 0; r < 2; ++r) {
            float s = 0.f;
#pragma unroll
            for (int j = 0; j < 4; ++j) s += (v[r][j].x * v[r][j].x + v[r][j].y * v[r][j].y) + (v[r][j].z * v[r][j].z + v[r][j].w * v[r][j].w);
            const float rstd = rsqrtf(wave_sum(s) * (1.f / D) + EPS);
#pragma unroll
            for (int j = 0; j < 4; ++j) __builtin_nontemporal_store((v[r][j] * rstd) * gm[j], &xr[r * 256 + 64 * j]);
        }
    }
}

DEV void shiftw_phase(const bf16_t* Wt, int N, const float* mod, int shift_i, float* shw, int gw, int NGW, int lane, bool with_ctx) {
    const int ln = lane & 15, kg = lane >> 4;
    for (int it = gw; it < N / 16; it += NGW) {
        const int n0 = it * 16;
        f32x4 acc0 = {0.f, 0.f, 0.f, 0.f}, acc1 = {0.f, 0.f, 0.f, 0.f};
        const bf16_t* wrow = Wt + (size_t)(n0 + ln) * D + kg * 8;
        const float* srow = mod + (size_t)ln * NMOD + shift_i * D + kg * 8;
        const float* crow = mod + (size_t)16 * NMOD + shift_i * D + kg * 8;
#pragma unroll 8
        for (int ks = 0; ks < 32; ++ks) {
            const bf16x8 wf = *(const bf16x8*)(wrow + ks * 32);
            const f32x4 s0 = *(const f32x4*)(srow + ks * 32), s1 = *(const f32x4*)(srow + ks * 32 + 4);
            const u32x4 sp = pack8v(s0, s1);
            acc0 = mfma16(wf, __builtin_bit_cast(bf16x8, sp), acc0);
            if (with_ctx) {
                f32x4 c0 = {0.f, 0.f, 0.f, 0.f}, c1 = c0;
                if (ln == 0) { c0 = *(const f32x4*)(crow + ks * 32); c1 = *(const f32x4*)(crow + ks * 32 + 4); }
                const u32x4 cp = pack8v(c0, c1);
                acc1 = mfma16(wf, __builtin_bit_cast(bf16x8, cp), acc1);
            }
        }
        *(f32x4*)(shw + (size_t)ln * N + n0 + kg * 4) = acc0;
        if (with_ctx && ln == 0) *(f32x4*)(shw + (size_t)16 * N + n0 + kg * 4) = acc1;
    }
}

DEV void conv_phase(const bf16_t* Z, const float* cw, bf16_t* QKV, int G) {
    const int gt = blockIdx.x * 512 + threadIdx.x, cgi = gt & 127, ch0 = cgi * 8;
    float w[9][8];
#pragma unroll
    for (int t = 0; t < 9; ++t) { const f32x4 a = *(const f32x4*)(cw + t * 1024 + ch0), b = *(const f32x4*)(cw + t * 1024 + ch0 + 4); w[t][0] = a.x; w[t][1] = a.y; w[t][2] = a.z; w[t][3] = a.w; w[t][4] = b.x; w[t][5] = b.y; w[t][6] = b.z; w[t][7] = b.w; }
    const float qs = (ch0 < 256) ? 0.125f : 1.f;
    const u32x4 zero4 = {0u, 0u, 0u, 0u};
    for (int sid = gt >> 7; sid < NB * 64; sid += (G * 512) >> 7) {
        const int cc = sid & 63, b = sid >> 6; const bool hasL = cc > 0, hasR = cc < 63;
        const bf16_t* zp = Z + (size_t)(b * SEQ + cc) * ZW + ch0;
        bf16_t* op = QKV + (size_t)(b * SEQ + cc) * D + ch0;
        float win[3][3][8];
        u32x4 raw[3];
#define CV_LOAD(r_) do { const bf16_t* q_ = zp + (size_t)(r_) * 64 * ZW; const bool v_ = (r_) < 64; \
        raw[0] = (v_ && hasL) ? *(const u32x4*)(q_ - ZW) : zero4; raw[1] = v_ ? *(const u32x4*)q_ : zero4; raw[2] = (v_ && hasR) ? *(const u32x4*)(q_ + ZW) : zero4; } while (0)
#define CV_UNPACK(slot_) do { unpack8(raw[0], win[slot_][0]); unpack8(raw[1], win[slot_][1]); unpack8(raw[2], win[slot_][2]); } while (0)
#define CV_STEP(r_, top_, mid_, bot_) do { if ((r_) < 64) { float acc[8]; \
        _Pragma("unroll") for (int j = 0; j < 8; ++j) { float s_ = 0.f; \
            _Pragma("unroll") for (int dx = 0; dx < 3; ++dx) s_ += w[dx][j] * win[top_][dx][j] + w[3 + dx][j] * win[mid_][dx][j] + w[6 + dx][j] * win[bot_][dx][j]; \
            acc[j] = silu_f(s_) * qs; } \
        *(u32x4*)(op + (size_t)(r_) * 64 * D) = pack8(acc); \
        CV_UNPACK(top_); CV_LOAD((r_) + 3); } } while (0)
#pragma unroll
        for (int dx = 0; dx < 3; ++dx)
#pragma unroll
            for (int j = 0; j < 8; ++j) win[2][dx][j] = 0.f;
        CV_LOAD(0); CV_UNPACK(0); CV_LOAD(1); CV_UNPACK(1); CV_LOAD(2);
        for (int r = 0; r < 66; r += 3) { CV_STEP(r, 2, 0, 1); CV_STEP(r + 1, 0, 1, 2); CV_STEP(r + 2, 1, 2, 0); }
#undef CV_LOAD
#undef CV_UNPACK
#undef CV_STEP
    }
    for (int row = MLAT + (gt >> 7); row < MALL; row += (G * 512) >> 7) {
        float acc[8];
#pragma unroll
        for (int j = 0; j < 8; ++j) acc[j] = 0.f;
        const int t = (row - MLAT) & 255;
#pragma unroll
        for (int dx = -1; dx <= 1; ++dx) { const int t2 = t + dx;
            if (t2 >= 0 && t2 < 256) { float f[8]; unpack8(*(const u32x4*)(Z + (size_t)(row + dx) * ZW + ch0), f);
#pragma unroll
                for (int j = 0; j < 8; ++j) acc[j] += w[3 + dx + 1][j] * f[j]; } }
#pragma unroll
        for (int j = 0; j < 8; ++j) acc[j] = silu_f(acc[j]) * qs;
        *(u32x4*)(QKV + (size_t)row * D + ch0) = pack8(acc);
    }
}

constexpr int L_GLR = 0, L_B = 8192, BP = 68, L_TOT = L_B + 2 * 64 * BP * 4, L_Q = L_TOT + 2048, QP = 72, L_K = L_Q + 2 * 64 * QP * 2, L_KHT = L_K + 2 * 64 * QP * 2, L_VT = L_KHT + 2 * 64 * QP * 2,
              L_P = L_VT + 128 * QP * 2, PP = 136, L_G1END = L_P + 64 * PP * 2;
static_assert(L_G1END <= LDS_BYTES, "G1 LDS");
DEV void gla_unit_rows(int u, int& b, int& c, int& h, int& row0) {
    if (u < NU_LAT) { b = u >> 8; c = (u >> 2) & 63; h = u & 3; row0 = b * SEQ + c * 64; }
    else { const int v = u - NU_LAT; b = v >> 4; c = (v >> 2) & 3; h = v & 3; row0 = MLAT + b * CTXL + c * 64; }
}
DEV void g1_phase(const Args& a, unsigned char* lds, int G) {
    unsigned char* ws = a.ws;
    const bf16_t* Z = (const bf16_t*)(ws + WS_ZH); const bf16_t* QKV = (const bf16_t*)(ws + WS_XN);
    bf16_t* QT = (bf16_t*)(ws + WS_QT); bf16_t* OI = (bf16_t*)(ws + WS_OI); bf16_t* KV = (bf16_t*)(ws + WS_KV); float* DEC = (float*)(ws + WS_DEC);
    const int t = threadIdx.x, lane = t & 63, w = t >> 6, ln = lane & 15, kg = lane >> 4;
    float* sB = (float*)(lds + L_B);
    bf16_t* sQ = (bf16_t*)(lds + L_Q); bf16_t* sK = (bf16_t*)(lds + L_K); bf16_t* sKhT = (bf16_t*)(lds + L_KHT); bf16_t* sVT = (bf16_t*)(lds + L_VT); bf16_t* sP = (bf16_t*)(lds + L_P);
    const int gdir = w >> 2, dkt = w & 3;
#define G1_LOAD(u_) do { int b_, c_, h_, r_; gla_unit_rows((u_), b_, c_, h_, r_); \
        _Pragma("unroll") for (int pt = 0; pt < 4; ++pt) gfn[pt] = (kg < 2) ? *(const u32x4*)(Z + (size_t)(r_ + pt * 16 + ln) * ZW + ZC_GLR + gdir * 16 + kg * 8) : (u32x4){0u, 0u, 0u, 0u}; \
        const bf16_t* qp_ = QKV + (size_t)(r_ + (t & 63)) * D + (t >> 6) * 8; \
        qn = *(const u32x4*)(qp_ + h_ * 64); kn = *(const u32x4*)(qp_ + 256 + h_ * 64); vn0 = *(const u32x4*)(qp_ + 512 + h_ * 128); vn1 = *(const u32x4*)(qp_ + 512 + h_ * 128 + 64); } while (0)
#define G1_WLOAD(h_) do { const float* wg_ = a.in[gdir ? I_WGB : I_WGF] + (h_) * 64 + dkt * 16 + ln; float wv_[8]; \
        _Pragma("unroll") for (int j = 0; j < 8; ++j) wv_[j] = (kg < 2) ? wg_[(kg * 8 + j) * 256] : 0.f; \
        const u32x4 wp_ = pack8(wv_); wfrag = __builtin_bit_cast(bf16x8, wp_); bias4 = *(const f32x4*)(a.in[gdir ? I_BGB : I_BGF] + (h_) * 64 + dkt * 16 + kg * 4); } while (0)
#define DPP_SHR(x_, n_) __builtin_bit_cast(float, __builtin_amdgcn_update_dpp(0, __builtin_bit_cast(int, (x_)), 0x110 | (n_), 0xf, 0xf, true))
    u32x4 qn, kn, vn0, vn1, gfn[4];
    if ((int)blockIdx.x < NU_ALL) G1_LOAD((int)blockIdx.x);
    bf16x8 wfrag; f32x4 bias4; int hcur = blockIdx.x & 3;
    G1_WLOAD(hcur);
    for (int u = blockIdx.x; u < NU_ALL; u += G) {
        int b, c, h, row0; gla_unit_rows(u, b, c, h, row0); const bool lat = u < NU_LAT;
        if (h != hcur) { hcur = h; G1_WLOAD(h); }
        const int pos = t & 63, g8 = t >> 6;
        const u32x4 qraw = qn, kraw = kn, vraw0 = vn0, vraw1 = vn1;
        u32x4 gf[4];
#pragma unroll
        for (int pt = 0; pt < 4; ++pt) gf[pt] = gfn[pt];
        if (u + G < NU_ALL) G1_LOAD(u + G);
        {
            float gl[4][4], cs[4][4], tot[4];
#pragma unroll
            for (int pt = 0; pt < 4; ++pt) {
                f32x4 pre = mfma16(wfrag, __builtin_bit_cast(bf16x8, gf[pt]), bias4);
#pragma unroll
                for (int r = 0; r < 4; ++r) { const float x = pre[r]; const float ls = (fminf(x, 0.f) - __logf(1.f + __expf(-fabsf(x)))) * (1.f / 16.f); gl[pt][r] = ls;
                    float sc = ls; sc += DPP_SHR(sc, 1); sc += DPP_SHR(sc, 2); sc += DPP_SHR(sc, 4); sc += DPP_SHR(sc, 8); cs[pt][r] = sc; }
            }
#pragma unroll
            for (int r = 0; r < 4; ++r) { float off = 0.f;
#pragma unroll
                for (int pt = 0; pt < 4; ++pt) { const float tt = __shfl(cs[pt][r], (lane & 48) | 15); cs[pt][r] += off; off += tt; }
                tot[r] = off; }
            if (gdir) {
#pragma unroll
                for (int pt = 0; pt < 4; ++pt)
#pragma unroll
                    for (int r = 0; r < 4; ++r) cs[pt][r] = tot[r] - cs[pt][r] + gl[pt][r];
            }
#pragma unroll
            for (int pt = 0; pt < 4; ++pt) *(f32x4*)(sB + (gdir * 64 + pt * 16 + ln) * BP + dkt * 16 + kg * 4) = (f32x4){cs[pt][0], cs[pt][1], cs[pt][2], cs[pt][3]};
            if (ln == 15) *(f32x4*)(DEC + ((size_t)u * 2 + gdir) * 64 + dkt * 16 + kg * 4) = (f32x4){__expf(tot[0]), __expf(tot[1]), __expf(tot[2]), __expf(tot[3])};
        }
        LBAR();
        {
            float q[8], k[8]; unpack8(qraw, q); unpack8(kraw, k);
            const unsigned tsel = (lane & 1) ? 0x03020706u : 0x05040100u;
#pragma unroll
            for (int dir = 0; dir < 2; ++dir) {
                const float* bp = sB + (dir * 64 + pos) * BP + g8 * 8; const float* bl = sB + (dir * 64 + (dir ? 0 : 63)) * BP + g8 * 8;
                const f32x4 b0 = *(const f32x4*)bp, b1 = *(const f32x4*)(bp + 4), l0 = *(const f32x4*)bl, l1 = *(const f32x4*)(bl + 4);
                float qt[8], kt[8], kh[8];
#pragma unroll
                for (int j = 0; j < 8; ++j) { const float bb = j < 4 ? b0[j] : b1[j - 4], ll = j < 4 ? l0[j] : l1[j - 4]; qt[j] = q[j] * __expf(bb); kt[j] = k[j] * __expf(-bb); kh[j] = k[j] * __expf(ll - bb); }
                const u32x4 qw = pack8(qt), kw = pack8(kt), hw = pack8(kh);
                *(u32x4*)(sQ + (dir * 64 + pos) * QP + g8 * 8) = qw;
                *(u32x4*)(sK + (dir * 64 + pos) * QP + g8 * 8) = kw;
                { unsigned* kp = (unsigned*)(sKhT + (dir * 64 + g8 * 8 + (lane & 1)) * QP + (pos & ~1));
#pragma unroll
                  for (int d = 0; d < 4; ++d) { const unsigned own = hw[d], oth = (unsigned)__builtin_amdgcn_update_dpp(0, (int)own, 0xB1, 0xf, 0xf, true);
                      kp[d * QP] = __builtin_amdgcn_perm(oth, own, tsel); } }
            }
#pragma unroll
            for (int i = 0; i < 2; ++i) { const u32x4 vw = i ? vraw1 : vraw0; unsigned* vp = (unsigned*)(sVT + ((g8 + 8 * i) * 8 + (lane & 1)) * QP + (pos & ~1));
#pragma unroll
                for (int d = 0; d < 4; ++d) { const unsigned own = vw[d], oth = (unsigned)__builtin_amdgcn_update_dpp(0, (int)own, 0xB1, 0xf, 0xf, true);
                    vp[d * QP] = __builtin_amdgcn_perm(oth, own, tsel); } }
        }
        LBAR();
        if (lat) {
            const int p2 = t >> 3, g2 = (t & 7) * 8;
#pragma unroll
            for (int dir = 0; dir < 2; ++dir) *(u32x4*)(QT + (size_t)(row0 + p2) * 512 + dir * 256 + h * 64 + g2) = *(const u32x4*)(sQ + (dir * 64 + p2) * QP + g2);
        }
        {
            const int dir = w >> 2, it = w & 3;
            bf16x8 qf[2];
#pragma unroll
            for (int ks = 0; ks < 2; ++ks) qf[ks] = *(const bf16x8*)(sQ + (dir * 64 + it * 16 + ln) * QP + ks * 32 + kg * 8);
#pragma unroll
            for (int jt = 0; jt < 4; ++jt) {
                f32x4 acc = {0.f, 0.f, 0.f, 0.f};
                const bool live = dir ? (jt >= it) : (jt <= it);
                if (live) {
#pragma unroll
                    for (int ks = 0; ks < 2; ++ks) { const bf16x8 kf = *(const bf16x8*)(sK + (dir * 64 + jt * 16 + ln) * QP + ks * 32 + kg * 8); acc = mfma16(kf, qf[ks], acc); }
                }
                const int i = it * 16 + ln, j0 = jt * 16 + kg * 4;
                float pv[4];
#pragma unroll
                for (int r = 0; r < 4; ++r) { const int j = j0 + r; const bool keep = dir ? (j >= i) : (j <= i); pv[r] = keep ? acc[r] : 0.f; }
                u32x2 pw; pw.x = cvt_pk_bf16(pv[0], pv[1]); pw.y = cvt_pk_bf16(pv[2], pv[3]);
                *(u32x2*)(sP + i * PP + dir * 64 + j0) = pw;
            }
        }
        LBAR();
        if (lat) {
            const int it = w & 3, half = w >> 2;
            f32x4 acc[4];
#pragma unroll
            for (int d = 0; d < 4; ++d) acc[d] = (f32x4){0.f, 0.f, 0.f, 0.f};
#pragma unroll
            for (int ks = 0; ks < 4; ++ks) {
                const bf16x8 pf = *(const bf16x8*)(sP + (it * 16 + ln) * PP + ks * 32 + kg * 8);
#pragma unroll
                for (int d = 0; d < 4; ++d) { const bf16x8 vf = *(const bf16x8*)(sVT + (half * 64 + (d >> 1) * 32 + prow(d & 1, ln)) * QP + (ks & 1) * 32 + kg * 8); acc[d] = mfma16(vf, pf, acc[d]); }
            }
#pragma unroll
            for (int p = 0; p < 2; ++p) *(u32x4*)(OI + (size_t)(row0 + it * 16 + ln) * 512 + h * 128 + half * 64 + p * 32 + kg * 8) = pack8v(acc[2 * p], acc[2 * p + 1]);
        }
        {
            const int dir = w >> 2;
#pragma unroll
            for (int e = 0; e < 2; ++e) {
                const int dvt = (w & 3) * 2 + e;
                bf16x8 vf[2];
#pragma unroll
                for (int ks = 0; ks < 2; ++ks) vf[ks] = *(const bf16x8*)(sVT + (dvt * 16 + ln) * QP + ks * 32 + kg * 8);
#pragma unroll
                for (int p = 0; p < 2; ++p) {
                    f32x4 acc[2];
#pragma unroll
                    for (int n = 0; n < 2; ++n) { acc[n] = (f32x4){0.f, 0.f, 0.f, 0.f};
#pragma unroll
                        for (int ks = 0; ks < 2; ++ks) { const bf16x8 kf = *(const bf16x8*)(sKhT + (dir * 64 + p * 32 + prow(n, ln)) * QP + ks * 32 + kg * 8); acc[n] = mfma16(kf, vf[ks], acc[n]); } }
                    *(u32x4*)(KV + (((size_t)u * 2 + dir) * 128 + dvt * 16 + ln) * 64 + p * 32 + kg * 8) = pack8v(acc[0], acc[1]);
                }
            }
        }
        LBAR();
    }
}

DEV void g2_phase(const Args& a, int G) {
    unsigned char* ws = a.ws;
    const bf16_t* KV = (const bf16_t*)(ws + WS_KV); const float* DEC = (const float*)(ws + WS_DEC); bf16_t* SB = (bf16_t*)(ws + WS_SB);
    for (int gt = blockIdx.x * 512 + threadIdx.x; gt < 128 * 1024; gt += G * 512) {
        const int s = gt >> 10, rem = gt & 1023, dv = rem >> 3, k8 = (rem & 7) * 8;
        const int b = s >> 3, h = (s >> 1) & 3, dir = s & 1;
        float S[8];
#pragma unroll
        for (int j = 0; j < 8; ++j) S[j] = 0.f;
        u32x4 kvA[4], kvB[4]; f32x4 d0A[4], d1A[4], d0B[4], d1B[4]; size_t ofA[4], ofB[4];
#define G2_LOAD(blk_, kv_, d0_, d1_, of_) do { _Pragma("unroll") for (int i = 0; i < 4; ++i) { const int step = (blk_) * 4 + i; int u; \
            if (step < 4) { const int c = dir ? 3 - step : step; u = NU_LAT + b * 16 + c * 4 + h; } else { const int c = dir ? 67 - step : step - 4; u = b * 256 + c * 4 + h; } \
            of_[i] = (((size_t)u * 2 + dir) * 128 + dv) * 64 + k8; kv_[i] = *(const u32x4*)(KV + of_[i]); \
            const float* dp = DEC + ((size_t)u * 2 + dir) * 64 + k8; d0_[i] = *(const f32x4*)dp; d1_[i] = *(const f32x4*)(dp + 4); } } while (0)
#define G2_FOLD(blk_, kv_, d0_, d1_, of_) do { _Pragma("unroll") for (int i = 0; i < 4; ++i) { if ((blk_) > 0) *(u32x4*)(SB + of_[i]) = pack8(S); \
            float kv[8]; unpack8(kv_[i], kv); _Pragma("unroll") for (int j = 0; j < 8; ++j) S[j] = (j < 4 ? d0_[i][j] : d1_[i][j - 4]) * S[j] + kv[j]; } } while (0)
        G2_LOAD(0, kvA, d0A, d1A, ofA);
#pragma unroll 1
        for (int blk = 0; blk < 17; blk += 2) {
            if (blk + 1 < 17) G2_LOAD(blk + 1, kvB, d0B, d1B, ofB);
            G2_FOLD(blk, kvA, d0A, d1A, ofA);
            if (blk + 2 < 17) G2_LOAD(blk + 2, kvA, d0A, d1A, ofA);
            if (blk + 1 < 17) G2_FOLD(blk + 1, kvB, d0B, d1B, ofB);
        }
#undef G2_LOAD
#undef G2_FOLD
    }
}

DEV void g3c1_phase(const Args& a, unsigned char* lds, int G) {
    unsigned char* ws = a.ws;
    const bf16_t* Z = (const bf16_t*)(ws + WS_ZH); const bf16_t* QT = (const bf16_t*)(ws + WS_QT); const bf16_t* OI = (const bf16_t*)(ws + WS_OI); const bf16_t* SB = (const bf16_t*)(ws + WS_SB);
    const bf16_t* WSB = (const bf16_t*)(ws + WS_WS); const float* rowss = (const float*)(ws + WS_RSP); bf16_t* MIX = (bf16_t*)(ws + WS_KV);
    const int t = threadIdx.x, lane = t & 63, w = t >> 6, ln = lane & 15, kg = lane >> 4;
    unsigned* sV = (unsigned*)lds;
    {
        bf16x8 nqf[4]; u32x4 noi[4], nog[4];
        f32x4 glag[4][2];
#pragma unroll
        for (int p = 0; p < 4; ++p) { glag[p][0] = *(const f32x4*)(a.in[I_GLAG] + p * 32 + kg * 8); glag[p][1] = *(const f32x4*)(a.in[I_GLAG] + p * 32 + kg * 8 + 4); }
#define G3_ROW(pu_) ({ const int u_ = 2 * (pu_) + (w >> 2); (u_ >> 8) * SEQ + ((u_ >> 2) & 63) * 64 + (w & 3) * 16 + ln; })
#define G3_LOAD(pu_) do { const int u_ = 2 * (pu_) + (w >> 2), h_ = u_ & 3; const size_t r_ = (size_t)G3_ROW(pu_); \
        _Pragma("unroll") for (int ks = 0; ks < 4; ++ks) { const int k = ks * 32 + kg * 8; nqf[ks] = *(const bf16x8*)(QT + r_ * 512 + (k >> 6) * 256 + h_ * 64 + (k & 63)); } \
        _Pragma("unroll") for (int p = 0; p < 4; ++p) { noi[p] = *(const u32x4*)(OI + r_ * 512 + h_ * 128 + p * 32 + kg * 8); nog[p] = *(const u32x4*)(Z + r_ * ZW + ZC_OG + h_ * 128 + p * 32 + kg * 8); } } while (0)
        if ((int)blockIdx.x < NU_LAT / 2) G3_LOAD((int)blockIdx.x);
        for (int pu = blockIdx.x; pu < NU_LAT / 2; pu += G) {
            const int u = 2 * pu + (w >> 2), h = u & 3, row = G3_ROW(pu);
            bf16x8 qf[4]; u32x4 oi[4], og[4];
#pragma unroll
            for (int i = 0; i < 4; ++i) { qf[i] = nqf[i]; oi[i] = noi[i]; og[i] = nog[i]; }
            f32x4 acc[8];
#pragma unroll
            for (int d = 0; d < 8; ++d) acc[d] = (f32x4){0.f, 0.f, 0.f, 0.f};
#pragma unroll
            for (int ks = 0; ks < 4; ++ks) {
                const int k = ks * 32 + kg * 8, dir = k >> 6, kk = k & 63;
                bf16x8 sf[8];
#pragma unroll
                for (int d = 0; d < 8; ++d) sf[d] = *(const bf16x8*)(SB + (((size_t)u * 2 + dir) * 128 + (d >> 1) * 32 + prow(d & 1, ln)) * 64 + kk);
#pragma unroll
                for (int d = 0; d < 8; ++d) acc[d] = mfma16(sf[d], qf[ks], acc[d]);
            }
            if (pu + G < NU_LAT / 2) G3_LOAD(pu + G);
            float ss = 0.f;
#pragma unroll
            for (int p = 0; p < 4; ++p) { float f[8]; unpack8(oi[p], f);
#pragma unroll
                for (int j = 0; j < 4; ++j) { acc[2 * p][j] += f[j]; acc[2 * p + 1][j] += f[4 + j]; ss += acc[2 * p][j] * acc[2 * p][j] + acc[2 * p + 1][j] * acc[2 * p + 1][j]; } }
            ss += __shfl_xor(ss, 16); ss += __shfl_xor(ss, 32);
            const float rstd = rsqrtf(ss * (1.f / 128.f) + EPS);
#pragma unroll
            for (int p = 0; p < 4; ++p) { const int dv = p * 32 + kg * 8; float f[8], o[8]; unpack8(og[p], f);
#pragma unroll
                for (int j = 0; j < 4; ++j) { o[j] = acc[2 * p][j] * rstd * glag[p][0][j] * f[j]; o[4 + j] = acc[2 * p + 1][j] * rstd * glag[p][1][j] * f[4 + j]; }
                *(u32x4*)(MIX + (size_t)row * D + h * 128 + dv) = pack8(o); }
        }
#undef G3_ROW
#undef G3_LOAD
    }
    {
        const int cgi = t & 7, pp = t >> 3;
        int hcur = -1; bf16x8 wf[4]; float bs = 0.f; f32x4 g0 = {0.f, 0.f, 0.f, 0.f}, g1 = g0;
        u32x4 nva, nvb, ngu[2]; f32x4 npa, npb, npc, npd;
#define C1_LOAD(v_) do { const int b_ = (v_) >> 8, n_ = ((v_) >> 3) & 31, hd_ = (v_) & 7, r0_ = b_ * SEQ + n_ * 128; \
        nva = *(const u32x4*)(Z + (size_t)(r0_ + 2 * pp) * ZW + ZC_VS + hd_ * 64 + cgi * 8); nvb = *(const u32x4*)(Z + (size_t)(r0_ + 2 * pp + 1) * ZW + ZC_VS + hd_ * 64 + cgi * 8); \
        const float* rp_ = rowss + (size_t)(r0_ + 2 * pp) * 8; npa = *(const f32x4*)rp_; npb = *(const f32x4*)(rp_ + 4); npc = *(const f32x4*)(rp_ + 8); npd = *(const f32x4*)(rp_ + 12); \
        _Pragma("unroll") for (int p = 0; p < 2; ++p) ngu[p] = *(const u32x4*)(Z + (size_t)(r0_ + w * 16 + ln) * ZW + ZC_U + hd_ * 64 + p * 32 + kg * 8); } while (0)
        if ((int)blockIdx.x < NU_LAT) C1_LOAD((int)blockIdx.x);
        for (int v = blockIdx.x; v < NU_LAT; v += G) {
            const int b = v >> 8, n = (v >> 3) & 31, hd = v & 7, r0 = b * SEQ + n * 128;
            if (hd != hcur) { hcur = hd;
#pragma unroll
                for (int ks = 0; ks < 4; ++ks) wf[ks] = *(const bf16x8*)(WSB + ((size_t)hd * 128 + w * 16 + ln) * 128 + ks * 32 + kg * 8);
                bs = a.in[I_BS][hd * 128 + w * 16 + ln];
                g0 = *(const f32x4*)(a.in[I_CMG] + hd * 64 + cgi * 8); g1 = *(const f32x4*)(a.in[I_CMG] + hd * 64 + cgi * 8 + 4); }
            const u32x4 va = nva, vb = nvb; const f32x4 pa = npa, pb = npb, pc = npc, pd = npd; u32x4 gu[2]; gu[0] = ngu[0]; gu[1] = ngu[1];
            if (v + G < NU_LAT) C1_LOAD(v + G);
            {
                float f0[8], f1[8]; unpack8(va, f0); unpack8(vb, f1);
                const float rs0 = rsqrtf((((pa.x + pa.y) + (pa.z + pa.w)) + ((pb.x + pb.y) + (pb.z + pb.w))) * (1.f / 512.f) + EPS), rs1 = rsqrtf((((pc.x + pc.y) + (pc.z + pc.w)) + ((pd.x + pd.y) + (pd.z + pd.w))) * (1.f / 512.f) + EPS);
#pragma unroll
                for (int j = 0; j < 8; ++j) { const float gj = j < 4 ? g0[j] : g1[j - 4]; const int ch = cgi * 8 + j, fsw = (ch ^ (ch >> 3)) & 15;
                    sV[ch * 64 + (((pp >> 2) ^ fsw) << 2) + (pp & 3)] = cvt_pk_bf16(f0[j] * rs0 * gj, f1[j] * rs1 * gj); }
            }
            LBAR();
            {
                f32x4 acc[4];
#pragma unroll
                for (int d = 0; d < 4; ++d) acc[d] = (f32x4){0.f, 0.f, 0.f, 0.f};
#pragma unroll
                for (int ks = 0; ks < 4; ++ks) {
#pragma unroll
                    for (int d = 0; d < 4; ++d) { const int ch = (d >> 1) * 32 + prow(d & 1, ln), fsw = (ch ^ (ch >> 3)) & 15; const bf16x8 vf = *(const bf16x8*)(sV + ch * 64 + (((ks * 4 + kg) ^ fsw) << 2)); acc[d] = mfma16(vf, wf[ks], acc[d]); }
                }
#pragma unroll
                for (int p = 0; p < 2; ++p) { const int ch = hd * 64 + p * 32 + kg * 8; float f[8], o[8]; unpack8(gu[p], f);
#pragma unroll
                    for (int j = 0; j < 4; ++j) { o[j] = (acc[2 * p][j] + bs) * f[j]; o[4 + j] = (acc[2 * p + 1][j] + bs) * f[4 + j]; }
                    *(u32x4*)(MIX + (size_t)(r0 + w * 16 + ln) * D + 512 + ch) = pack8(o); }
            }
            LBAR();
        }
#undef C1_LOAD
    }
}

#define LAS __attribute__((address_space(3)))
#define XB_TMO      128
#define XB_XCNT(j)  (256  + 64 * (j))
#define XB_XSUB(j)  (1280 + 64 * (j))
#define XB_XGEN(j)  (2304 + 64 * (j))
#define XB_TOP      3328
#define XB_TOPGEN   3392
#define XCD_BAR_WORDS 3456
#define XB_SPIN_CAP (1u << 18)

__device__ __forceinline__ unsigned xb_ld(unsigned* p)              { return __hip_atomic_load(p, __ATOMIC_RELAXED, __HIP_MEMORY_SCOPE_AGENT); }
__device__ __forceinline__ unsigned xb_add(unsigned* p, unsigned v) { return __hip_atomic_fetch_add(p, v, __ATOMIC_RELAXED, __HIP_MEMORY_SCOPE_AGENT); }
__device__ __forceinline__ unsigned xb_xcc_id() { return (unsigned)__builtin_amdgcn_s_getreg((3 << 11) | 20) & 0xFu; }
#define XB_SPIN(cond, bar) do { unsigned _sp = 0; while (cond) { __builtin_amdgcn_s_sleep(1); \
    if ((++_sp & 255u) == 0u) { if (xb_ld(&(bar)[XB_TMO])) break; if (_sp > XB_SPIN_CAP) { atomicAdd(&(bar)[XB_TMO], 1u); break; } } } } while (0)

struct XcdBarrier {
    unsigned* bar; unsigned x;
    volatile LAS unsigned* st;
};

__device__ __forceinline__ XcdBarrier xcd_barrier_post(unsigned* bar, volatile LAS unsigned* st) {
    XcdBarrier b; b.bar = bar; b.x = xb_xcc_id(); b.st = st;
    if (threadIdx.x == 0) (void)xb_add(&bar[XB_XCNT(b.x)], 1u);
    return b;
}
__device__ __forceinline__ void xcd_barrier_complete(unsigned* bar, unsigned x, unsigned& nloc, unsigned& nx) {
    const unsigned G = gridDim.x * gridDim.y * gridDim.z;
    unsigned sum, cnt, mine, sp = 0u;
    for (;;) {
        sum = 0u; cnt = 0u; mine = 0u;
#pragma unroll
        for (unsigned j = 0; j < 16; ++j) { const unsigned c = xb_ld(&bar[XB_XCNT(j)]); sum += c; cnt += (c > 0u) ? 1u : 0u; mine = (j == x) ? c : mine; }
        if (sum == G) break;
        __builtin_amdgcn_s_sleep(1);
        if ((++sp & 255u) == 0u) { if (xb_ld(&bar[XB_TMO])) break; if (sp > XB_SPIN_CAP) { atomicAdd(&bar[XB_TMO], 1u); break; } }
    }
    nloc = mine > 0u ? mine : 1u; nx = cnt > 0u ? cnt : 1u;
}

__device__ __forceinline__ void xcd_barrier(const XcdBarrier& b) {
    asm volatile("s_waitcnt vmcnt(0)" ::: "memory");
    __syncthreads();
    if (threadIdx.x == 0) {
        unsigned* bar = b.bar;
        __builtin_amdgcn_s_waitcnt(0);
        unsigned nloc = b.st[0], nx = b.st[1];
        if (nloc == 0u) { xcd_barrier_complete(bar, b.x, nloc, nx); b.st[0] = nloc; b.st[1] = nx; }
        const unsigned old = xb_add(&bar[XB_XSUB(b.x)], 1u);
        const unsigned gen = old / nloc;
        if (old + 1u == (gen + 1u) * nloc) {
            __builtin_amdgcn_fence(__ATOMIC_RELEASE, "agent");
            asm volatile("s_waitcnt vmcnt(0)" ::: "memory");
            const unsigned og = xb_add(&bar[XB_TOP], 1u);
            const unsigned tg = og / nx;
            if (og + 1u == (tg + 1u) * nx) xb_add(&bar[XB_TOPGEN], 1u);
            else XB_SPIN(xb_ld(&bar[XB_TOPGEN]) == tg, bar);
            __builtin_amdgcn_fence(__ATOMIC_ACQUIRE, "agent");
            xb_add(&bar[XB_XGEN(b.x)], 1u);
            asm volatile("s_waitcnt vmcnt(0)" ::: "memory");
        } else {
            XB_SPIN(xb_ld(&bar[XB_XGEN(b.x)]) == gen, bar);
            __builtin_amdgcn_fence(__ATOMIC_ACQUIRE, "agent");
            asm volatile("s_waitcnt vmcnt(0)" ::: "memory");
        }
    }
    __syncthreads();
}


constexpr int NPHASE = 15;
__global__ void __launch_bounds__(512, 2) fwd_kernel(Args a) {
    extern __shared__ __attribute__((aligned(16))) unsigned char lds[];
    const int G = gridDim.x, tid = threadIdx.x, lane = tid & 63, wave = __builtin_amdgcn_readfirstlane(tid >> 6);
    const int gw = blockIdx.x * 8 + wave, NGW = G * 8;
    unsigned char* ws = a.ws;
    const float* mod = (const float*)(ws + WS_MOD);
    bf16_t* XN = (bf16_t*)(ws + WS_XN); bf16_t* ZH = (bf16_t*)(ws + WS_ZH); float* X1C = (float*)(ws + WS_X1C);
    PG8_LAS unsigned char* ldsg = (PG8_LAS unsigned char*)lds;
    const int lo = a.ph_lo, hi = a.ph_hi;
    volatile LAS unsigned* bst = (volatile LAS unsigned*)(ldsg + (LDS_BYTES - 64));
    if (tid == 0) { bst[0] = 0u; bst[1] = 0u; }
    __syncthreads();
    XcdBarrier xbar; xbar.bar = (unsigned*)(ws + WS_CTL); xbar.x = 0; xbar.st = bst;
    if (hi - lo > 1) xbar = xcd_barrier_post((unsigned*)(ws + WS_CTL), bst);
#define IN(k) (lo <= (k) && (k) < hi)
#define SEAM(k) do { if (IN(k) && IN((k) + 1)) { if (a.ph_hi > 4096) cg::this_grid().sync(); else xcd_barrier(xbar); } } while (0)
    if (IN(0)) { p0_prep(a, lds, gw, NGW, wave, lane); } SEAM(0);
    if (IN(1)) { norm_mod_phase(a.in[I_X], a.in[I_CTX], MALL, a.in[I_N1G], mod, 0, 1, XN, gw, NGW, lane);
        shiftw_phase((const bf16_t*)(ws + WS_WIN), ZW, mod, 3, (float*)(ws + WS_SHW1), gw, NGW, lane, true); shiftw_phase((const bf16_t*)(ws + WS_W2A), NFF2, mod, 6, (float*)(ws + WS_SHW2), NGW - 1 - gw, NGW, lane, false); } SEAM(1);
    if (IN(2)) { pg8::Gemm g{XN, (const bf16_t*)(ws + WS_W1A), MALL, NFF2, D}; pg8::StaticOrder S; S.init(MALL, NFF2, G, (int)blockIdx.x); EpiSwiGLU<false> E{ZH, nullptr, nullptr};
        pg8::gemm_phase<EpiSwiGLU<false>, pg8::StaticOrder, true, true>(ldsg, g, S, E); } SEAM(2);
    if (IN(3)) { pg8::Gemm g{ZH, (const bf16_t*)(ws + WS_W1B), MALL, D, DFF}; pg8::StaticOrder S; S.init(MALL, D, G, (int)blockIdx.x); typedef EpiResid<2, true, true, 4> EpiT; EpiT E{a.in[I_X], a.in[I_CTX], a.out, X1C, mod, XN, a.in[I_N2G], (float*)(ws + WS_RS2)};
        pg8::gemm_phase<EpiT, pg8::StaticOrder, true, true>(ldsg, g, S, E); } SEAM(3);
    if (IN(5)) { pg8::Gemm g{XN, (const bf16_t*)(ws + WS_WIN), MALL, ZW, D}; pg8::StaticOrder S; S.init(MALL, ZW, G, (int)blockIdx.x); EpiZ E{ZH, (float*)(ws + WS_RSP), (const float*)(ws + WS_RS2), (const float*)(ws + WS_SHW1)};
        pg8::gemm_phase<EpiZ, pg8::StaticOrder, true, true>(ldsg, g, S, E); } SEAM(5);
    if (IN(6)) { conv_phase(ZH, a.in[I_CONVW], XN, G); } SEAM(6);
    if (IN(7)) { g1_phase(a, lds, G); } SEAM(7);
    if (IN(8)) { g2_phase(a, G); } SEAM(8);
    if (IN(9)) { g3c1_phase(a, lds, G); } SEAM(9);
    if (IN(10)) { pg8::Gemm g{(const bf16_t*)(ws + WS_KV), (const bf16_t*)(ws + WS_WOUT), MLAT, D, D}; pg8::StaticOrder S; S.init(MLAT, D, G, (int)blockIdx.x); typedef EpiResid<5, false, true, 7> EpiT; EpiT E{a.out, a.out, a.out, a.out, mod, XN, a.in[I_N3G], (float*)(ws + WS_RS3)};
        pg8::gemm_phase<EpiT, pg8::StaticOrder, true, true>(ldsg, g, S, E); } SEAM(10);
    if (IN(12)) { pg8::Gemm g{XN, (const bf16_t*)(ws + WS_W2A), MLAT, NFF2, D}; pg8::StaticOrder S; S.init(MLAT, NFF2, G, (int)blockIdx.x); EpiSwiGLU<true> E{ZH, (const float*)(ws + WS_RS3), (const float*)(ws + WS_SHW2)};
        pg8::gemm_phase<EpiSwiGLU<true>, pg8::StaticOrder, true, true>(ldsg, g, S, E); } SEAM(12);
    if (IN(13)) { pg8::Gemm g{ZH, (const bf16_t*)(ws + WS_W2B), MLAT, D, DFF}; pg8::StaticOrder S; S.init(MLAT, D, G, (int)blockIdx.x); typedef EpiResid<8, true, false, 0> EpiT; EpiT E{a.out, a.out, a.out, a.out, mod, nullptr, nullptr, nullptr};
        pg8::gemm_phase<EpiT, pg8::StaticOrder, true, true>(ldsg, g, S, E); } SEAM(13);
    if (IN(14)) { final_norm_phase(a.out, a.in[I_FING], gw, NGW, lane); }
#if defined(MK_EXTRA_SYNC) && MK_EXTRA_SYNC
    if (hi - lo > 1) for (int i = 0; i < MK_EXTRA_SYNC; ++i) cg::this_grid().sync();
#endif
#undef IN
#undef SEAM
}


extern "C" void kernel_launch(void* const* d_in, const int* in_sizes, int n_in, void* d_out, int out_size, void* d_ws, size_t ws_size, hipStream_t stream) {
    static int grid = 0;
    if (grid == 0) {
        if (n_in != 25 || out_size != MLAT * D || ws_size < WS_END) { fprintf(stderr, "kernel_launch: unexpected shapes (n_in %d, out %d, ws %zu; need ws >= %zu)\n", n_in, out_size, ws_size, (size_t)WS_END); grid = -1; return; }
        int dev = 0, cus = 0, per_cu = 0;
        (void)hipGetDevice(&dev); (void)hipDeviceGetAttribute(&cus, hipDeviceAttributeMultiprocessorCount, dev);
        if (hipFuncSetAttribute((const void*)fwd_kernel, hipFuncAttributeMaxDynamicSharedMemorySize, LDS_BYTES) != hipSuccess) { fprintf(stderr, "kernel_launch: hipFuncSetAttribute failed\n"); grid = -1; return; }
        if (hipOccupancyMaxActiveBlocksPerMultiprocessor(&per_cu, (const void*)fwd_kernel, 512, LDS_BYTES) != hipSuccess || per_cu < 1) { fprintf(stderr, "kernel_launch: occupancy query says %d\n", per_cu); per_cu = 1; }
        (void)hipGetLastError();
        grid = cus * per_cu;
    }
    if (grid < 0) return;
    (void)hipMemsetAsync((char*)d_ws + WS_CTL, 0, 1 << 20, stream);
    Args a{};
    for (int i = 0; i < 25; ++i) a.in[i] = (const float*)d_in[i];
    a.out = (float*)d_out; a.ws = (unsigned char*)d_ws;
#if MK_ONE_LAUNCH
    a.ph_lo = 0; a.ph_hi = NPHASE;
    void* args[] = {&a};
    hipError_t e = hipLaunchCooperativeKernel((const void*)fwd_kernel, dim3(grid), dim3(512), args, LDS_BYTES, stream);
    if (e != hipSuccess) fprintf(stderr, "cooperative launch failed: %s (grid %d)\n", hipGetErrorString(e), grid);
#if defined(MK_DUP) && MK_DUP
    for (int p = 0; p < NPHASE; ++p) if ((MK_DUP >> p) & 1) { a.ph_lo = p; a.ph_hi = p + 1; hipLaunchKernelGGL(fwd_kernel, dim3(grid), dim3(512), LDS_BYTES, stream, a); }
#endif
#else
    for (int p = 0; p < NPHASE; ++p) { a.ph_lo = p; a.ph_hi = p + 1; hipLaunchKernelGGL(fwd_kernel, dim3(grid), dim3(512), LDS_BYTES, stream, a); }
#endif
}
```
